# Optimizing an MI355X kernel written in HIP

```python
import jax, jax.numpy as jnp
from jax import lax
import numpy as np

D_MODEL = 1024
BATCH = 16
SEQ = 2048
DEPTH = 2

CHUNK = 64
Q_BLOCK = 128
N_BRANCH = 3
ATTN_HEADS = 8
ATTN_HEAD_DIM = 64
ATTN_WIDTH = ATTN_HEADS * ATTN_HEAD_DIM
POOL_WINDOWS = (2, 4, 8, 16)
POOL_GROUPS = 4
POOL_WIDTH = 512
POOL_GROUP_DIM = POOL_WIDTH // POOL_GROUPS
CONV_WIDTH = 512
CONV_K = 3
FFN_HIDDEN = -(-(8 * D_MODEL) // (3 * 256)) * 256
RMS_EPS = 1e-6
NEG_INF = -1e30

IN_SPLITS = (ATTN_WIDTH, ATTN_WIDTH, ATTN_WIDTH, ATTN_HEADS, POOL_WIDTH,
             CONV_WIDTH, CONV_WIDTH, CONV_WIDTH, N_BRANCH * D_MODEL)
IN_COLS = sum(IN_SPLITS)
IN_SPLIT_POINTS = tuple(int(p) for p in np.cumsum(IN_SPLITS)[:-1])

kernel_name = "hybrid_fox_pool_shortconv_gated_block"


def rms_norm(x, g):
    xf = x.astype(jnp.float32)
    y = xf * lax.rsqrt(jnp.mean(xf * xf, axis=-1, keepdims=True) + RMS_EPS)
    return (y * g.astype(jnp.float32)).astype(x.dtype)


def forgetting_attention(q, k, v, f_logit, b_f):
    B, S, H, Dh = q.shape
    log_f = jax.nn.log_sigmoid((f_logit + b_f).astype(jnp.float32))
    F = jnp.cumsum(log_f, axis=1)
    F_k = F.transpose(0, 2, 1)
    nblk = S // Q_BLOCK
    q_blocks = q.reshape(B, nblk, Q_BLOCK, H, Dh).swapaxes(0, 1)
    F_q_blocks = F.reshape(B, nblk, Q_BLOCK, H).swapaxes(0, 1)
    q_pos_blocks = jnp.arange(S, dtype=jnp.int32).reshape(nblk, Q_BLOCK)
    k_pos = jnp.arange(S, dtype=jnp.int32)
    scale = Dh ** -0.5

    def one_block(args):
        q_i, F_q_i, pos_i = args
        logits = jnp.einsum('bqhd,bkhd->bhqk', q_i, k).astype(jnp.float32) * scale
        decay = F_q_i.transpose(0, 2, 1)[..., :, None] - F_k[..., None, :]
        mask = k_pos[None, :] <= pos_i[:, None]
        logits = jnp.where(mask, logits + decay, NEG_INF)
        p = jax.nn.softmax(logits, axis=-1)
        return jnp.einsum('bhqk,bkhd->bqhd', p.astype(v.dtype), v)

    out = lax.map(one_block, (q_blocks, F_q_blocks, q_pos_blocks))
    return out.swapaxes(0, 1).reshape(B, S, H * Dh)


def multiscale_pool(u, pool_w, pool_scale):
    B, S, C = u.shape
    uf = u.astype(jnp.float32)
    c0 = jnp.pad(jnp.cumsum(uf, axis=1), ((0, 0), (1, 0), (0, 0)))
    n_avail = jnp.arange(1, S + 1, dtype=jnp.float32)[:, None]
    outs = []
    for g, w in enumerate(POOL_WINDOWS):
        sl = slice(g * POOL_GROUP_DIM, (g + 1) * POOL_GROUP_DIM)
        cg = c0[..., sl]
        lag = jnp.pad(cg, ((0, 0), (w, 0), (0, 0)))[:, :S + 1]
        mean = (cg - lag)[:, 1:] / jnp.minimum(n_avail, float(w))
        outs.append(mean - uf[..., sl])
    d = jnp.stack(outs, axis=2).astype(u.dtype)
    y = jnp.einsum('bsgc,gcd->bsgd', d, pool_w).reshape(B, S, C)
    return y * pool_scale


def short_gated_conv(v, gate_b, gate_c, conv_w):
    C = v.shape[-1]
    z = gate_c * v
    y = lax.conv_general_dilated(z, conv_w[:, None, :], window_strides=(1,),
                                 padding=[(CONV_K - 1, 0)],
                                 dimension_numbers=('NWC', 'WIO', 'NWC'),
                                 feature_group_count=C)
    return gate_b * y


def setup_inputs(seed: int = 0) -> dict:
    key = jax.random.key(seed)
    ks = jax.random.split(key, 18)
    f32 = jnp.float32

    def nrm(k, shape, fan_in):
        return jax.random.normal(k, shape, f32) * (fan_in ** -0.5)

    return {
        "x": jax.random.normal(ks[0], (BATCH, SEQ, D_MODEL), f32),
        "attn_norm": 1.0 + 0.05 * jax.random.normal(ks[1], (DEPTH, D_MODEL), f32),
        "w_in": nrm(ks[2], (DEPTH, D_MODEL, IN_COLS), D_MODEL),
        "b_forget": jax.random.uniform(ks[3], (DEPTH, ATTN_HEADS), f32, 1.0, 4.0),
        "b_gate": 0.1 * jax.random.normal(ks[4], (DEPTH, N_BRANCH * D_MODEL), f32),
        "w_proj_attn": nrm(ks[5], (DEPTH, ATTN_WIDTH, D_MODEL), ATTN_WIDTH),
        "pool_w": nrm(ks[6], (DEPTH, POOL_GROUPS, POOL_GROUP_DIM, POOL_GROUP_DIM), POOL_GROUP_DIM),
        "pool_scale": 1.0 + 0.1 * jax.random.normal(ks[7], (DEPTH, POOL_WIDTH), f32),
        "w_proj_pool": nrm(ks[8], (DEPTH, POOL_WIDTH, D_MODEL), POOL_WIDTH),
        "conv_w": nrm(ks[9], (DEPTH, CONV_K, CONV_WIDTH), CONV_K),
        "w_proj_conv": nrm(ks[10], (DEPTH, CONV_WIDTH, D_MODEL), CONV_WIDTH),
        "w_out": nrm(ks[11], (DEPTH, D_MODEL, D_MODEL), D_MODEL),
        "ffn_norm": 1.0 + 0.05 * jax.random.normal(ks[12], (DEPTH, D_MODEL), f32),
        "w_gate_up": nrm(ks[13], (DEPTH, D_MODEL, 2 * FFN_HIDDEN), D_MODEL),
        "w_down": nrm(ks[14], (DEPTH, FFN_HIDDEN, D_MODEL), FFN_HIDDEN),
        "final_norm": 1.0 + 0.05 * jax.random.normal(ks[15], (D_MODEL,), f32),
    }


def reference(x, attn_norm, w_in, b_forget, b_gate, w_proj_attn, pool_w, pool_scale,
              w_proj_pool, conv_w, w_proj_conv, w_out, ffn_norm, w_gate_up, w_down,
              final_norm):
    B, S, D = x.shape
    for l in range(DEPTH):
        h = rms_norm(x, attn_norm[l])
        proj = h @ w_in[l]
        q, k, v, f_logit, u, cv, cb, cc, g = jnp.split(proj, IN_SPLIT_POINTS, axis=-1)
        heads = (B, S, ATTN_HEADS, ATTN_HEAD_DIM)
        y_a = forgetting_attention(q.reshape(heads), k.reshape(heads), v.reshape(heads),
                                   f_logit, b_forget[l]) @ w_proj_attn[l]
        y_b = multiscale_pool(u, pool_w[l], pool_scale[l]) @ w_proj_pool[l]
        y_c = short_gated_conv(cv, cb, cc, conv_w[l]) @ w_proj_conv[l]
        gates = jax.nn.sigmoid(g + b_gate[l]).reshape(B, S, N_BRANCH, D)
        mixed = gates[..., 0, :] * y_a + gates[..., 1, :] * y_b + gates[..., 2, :] * y_c
        x = x + mixed @ w_out[l]
        h = rms_norm(x, ffn_norm[l])
        a, b = jnp.split(h @ w_gate_up[l], 2, axis=-1)
        x = x + (jax.nn.silu(a) * b) @ w_down[l]
    return rms_norm(x, final_norm)
```

```cpp
#define MK_LAUNCHES 1
#include <hip/hip_runtime.h>
#include <hip/hip_cooperative_groups.h>
#include <cstdio>
#include <cstdint>
namespace pg8 {
#define PG8_LAS __attribute__((address_space(3)))
typedef unsigned short bf16_t;
typedef short bf16x8 __attribute__((ext_vector_type(8)));
typedef float f32x4 __attribute__((ext_vector_type(4)));
typedef unsigned u32x4 __attribute__((ext_vector_type(4)));
constexpr int BM = 256, BK = 64, HALF = 128, HTB = HALF * BK * 2  , STAGE_BYTES = 8 * HTB, NXCD = 8, WGM = 8;

__host__ __device__ __forceinline__ int lds_byte(int r, int c) { const int st = (r >> 4) * 2 + (c >> 5), rr = r & 15, cc = c & 31, ob = rr * 64 + cc * 2; return st * 1024 + (ob ^ (((ob >> 9) & 1) << 5)); }
__host__ __device__ __forceinline__ void stage_rc(int b, int& R, int& C) { const int st = b / 1024, sb = b % 1024, swz = sb ^ (((sb >> 9) & 1) << 5); R = (st >> 1) * 16 + swz / 64; C = (st & 1) * 32 + (swz % 64) / 2; }
__host__ __device__ __forceinline__ int perm32(int rho) { const int n = rho >> 4, i = rho & 15; return 8 * (i >> 2) + 4 * n + (i & 3); }

struct Unit { int pm, pn, sub; };
struct Gemm { const bf16_t *A0, *A1, *A2, *B0, *B1, *B2; int M, N, K; };

struct StaticOrder {
    int nM, nN, nwg, G, c;
    __host__ __device__ void init(int M, int N, int G_, int c_) { nM = M / BM; nN = N / BM; nwg = nM * nN; G = G_; c = c_; }
    __host__ __device__ bool next(int i, Unit& u) const {
        const long L = (long)i * G + c; if (L >= nwg) return false;
        int wgid = (int)L; { const int q = nwg / NXCD, r = nwg % NXCD, xcd = wgid % NXCD, off = wgid / NXCD; wgid = (xcd < r ? xcd * (q + 1) : r * (q + 1) + (xcd - r) * q) + off; }
        const int nig = WGM * nN, gid = wgid / nig, fm = gid * WGM, gsz = (nM - fm) < WGM ? (nM - fm) : WGM;
        u.pm = fm + ((wgid % nig) % gsz); u.pn = (wgid % nig) / gsz; u.sub = 0; return true;
    }
    __device__ __forceinline__ void a_ready(const Unit&) const {}
    __device__ __forceinline__ void done(const Unit&) const {}
};

struct StaticOrder3 {
    StaticOrder b;
    __host__ __device__ void init(int M, int N, int G_, int c_) { b.init(M, N, G_, c_); }
    __host__ __device__ bool next(int i, Unit& u) const { if (!b.next(i / 3, u)) return false; u.sub = i % 3; return true; }
    __device__ __forceinline__ void a_ready(const Unit&) const {}
    __device__ __forceinline__ void done(const Unit&) const {}
};
typedef float f32x2c_t __attribute__((ext_vector_type(2))); typedef __bf16 bf16x2c_t __attribute__((ext_vector_type(2)));
__device__ __forceinline__ unsigned cvt_pk_bf16(float lo, float hi) { const f32x2c_t v = {lo, hi}; const bf16x2c_t b = __builtin_convertvector(v, bf16x2c_t); return __builtin_bit_cast(unsigned, b); }
typedef float f32x2 __attribute__((ext_vector_type(2)));
__device__ __forceinline__ float rstd_of(const float* ssq, int row) { const float s0 = ssq[row], s1 = ssq[32768 + row], s2 = ssq[2 * 32768 + row], s3 = ssq[3 * 32768 + row]; return __builtin_amdgcn_rsqf(((s0 + s1) + (s2 + s3)) * (1.0f / 1024.0f) + 1e-6f); }
__device__ __forceinline__ float sigm(float v) { return __builtin_amdgcn_rcpf(1.0f + __builtin_amdgcn_exp2f(-1.4426950408889634f * v)); }
__device__ __forceinline__ u32x4 pack8(const f32x4 a, const f32x4 b) { u32x4 w; w.x = cvt_pk_bf16(a[0], a[1]); w.y = cvt_pk_bf16(a[2], a[3]); w.z = cvt_pk_bf16(b[0], b[1]); w.w = cvt_pk_bf16(b[2], b[3]); return w; }
__device__ __forceinline__ void unpack8(const u32x4 w, f32x4& a, f32x4& b) {
    a[0] = __uint_as_float(w.x << 16); a[1] = __uint_as_float(w.x & 0xffff0000u); a[2] = __uint_as_float(w.y << 16); a[3] = __uint_as_float(w.y & 0xffff0000u);
    b[0] = __uint_as_float(w.z << 16); b[1] = __uint_as_float(w.z & 0xffff0000u); b[2] = __uint_as_float(w.w << 16); b[3] = __uint_as_float(w.w & 0xffff0000u); }

struct EpiIn {
    static constexpr bool PERM = true, AFTER_DRAIN = false;
    const float* ssq; const float* bgate; bf16_t *Q, *K, *V, *U, *Z, *CB, *G; float* FLOG; float qscale;
    __device__ __forceinline__ void operator()(const f32x4 (&acc)[2][2][4][2], const Unit& u, int wr, int wc, int fr, int fq) const {
        const int row0 = u.pm * BM + wr * 64 + fr, pn = u.pn, cw = wc * 32 + 8 * fq;
        if (pn < 8 || pn == 12 || pn == 13) {
            bf16_t* base; int colt; float sc = 1.f;
            if (pn < 2) { base = Q; colt = pn * 256; sc = qscale; } else if (pn < 4) { base = K; colt = (pn - 2) * 256; } else if (pn < 6) { base = V; colt = (pn - 4) * 256; }
            else if (pn < 8) { base = U; colt = (pn - 6) * 256; } else { base = CB; colt = (pn - 12) * 256; }
#pragma unroll
            for (int ai = 0; ai < 2; ++ai)
#pragma unroll
                for (int m = 0; m < 4; ++m) { const int row = row0 + ai * HALF + m * 16; const float rs = rstd_of(ssq, row) * sc; bf16_t* rowp = base + (size_t)row * 512 + colt + cw;
#pragma unroll
                    for (int bj = 0; bj < 2; ++bj) *(u32x4*)(rowp + bj * HALF) = pack8(acc[ai][bj][m][0] * rs, acc[ai][bj][m][1] * rs); }
        } else if (pn < 12) {
            const int colz = (pn - 8) * 128 + cw;
#pragma unroll
            for (int ai = 0; ai < 2; ++ai)
#pragma unroll
                for (int m = 0; m < 4; ++m) { const int row = row0 + ai * HALF + m * 16; const float rs = rstd_of(ssq, row), rs2 = rs * rs;
                    *(u32x4*)(Z + (size_t)row * 512 + colz) = pack8(acc[ai][0][m][0] * acc[ai][1][m][0] * rs2, acc[ai][0][m][1] * acc[ai][1][m][1] * rs2); }
        } else if (pn < 26) {
            const int colg = (pn - 14) * 256 + cw;
            f32x4 bv[2][2];
#pragma unroll
            for (int bj = 0; bj < 2; ++bj)
#pragma unroll
                for (int n = 0; n < 2; ++n) bv[bj][n] = *(const f32x4*)(bgate + colg + bj * HALF + 4 * n);
#pragma unroll
            for (int ai = 0; ai < 2; ++ai)
#pragma unroll
                for (int m = 0; m < 4; ++m) { const int row = row0 + ai * HALF + m * 16; const float rs = rstd_of(ssq, row); bf16_t* rowp = G + (size_t)row * 3072 + colg;
#pragma unroll
                    for (int bj = 0; bj < 2; ++bj) { f32x4 v0 = acc[ai][bj][m][0] * rs + bv[bj][0], v1 = acc[ai][bj][m][1] * rs + bv[bj][1];
#pragma unroll
                        for (int i = 0; i < 4; ++i) { v0[i] = sigm(v0[i]); v1[i] = sigm(v1[i]); }
                        *(u32x4*)(rowp + bj * HALF) = pack8(v0, v1); } }
        } else {
            if (wc == 0 && fq == 0) {
#pragma unroll
                for (int ai = 0; ai < 2; ++ai)
#pragma unroll
                    for (int m = 0; m < 4; ++m) { const int row = row0 + ai * HALF + m * 16; const float rs = rstd_of(ssq, row);
                        *(f32x4*)(FLOG + (size_t)row * 8) = acc[ai][0][m][0] * rs; *(f32x4*)(FLOG + (size_t)row * 8 + 4) = acc[ai][0][m][1] * rs; }
            }
        }
    }
};

struct EpiResid {
    static constexpr bool PERM = true, AFTER_DRAIN = false;
    const float* xin; float* xout; bf16_t* xb; float* ssq;
    __device__ __forceinline__ void operator()(const f32x4 (&acc)[2][2][4][2], const Unit& u, int wr, int wc, int fr, int fq) const {
        const int row0 = u.pm * BM + wr * 64 + fr, col0 = u.pn * BM + wc * 32 + 8 * fq;
#pragma unroll
        for (int ai = 0; ai < 2; ++ai)
#pragma unroll
            for (int m = 0; m < 4; ++m) { const int row = row0 + ai * HALF + m * 16; const size_t off = (size_t)row * 1024 + col0; float ss = 0.f;
#pragma unroll
                for (int bj = 0; bj < 2; ++bj) { f32x4 a = *(const f32x4*)(xin + off + bj * HALF), b = *(const f32x4*)(xin + off + bj * HALF + 4);
                    a = a + acc[ai][bj][m][0]; b = b + acc[ai][bj][m][1];
                    *(f32x4*)(xout + off + bj * HALF) = a; *(f32x4*)(xout + off + bj * HALF + 4) = b;
                    ss += ((a[0] * a[0] + a[1] * a[1]) + (a[2] * a[2] + a[3] * a[3])) + ((b[0] * b[0] + b[1] * b[1]) + (b[2] * b[2] + b[3] * b[3]));
                    *(u32x4*)(xb + off + bj * HALF) = pack8(a, b); }
                ss += __shfl_xor(ss, 16); ss += __shfl_xor(ss, 32);
                if (fq == 0) atomicAdd(ssq + (size_t)u.pn * 32768 + row, ss); }
    }
};

__device__ __forceinline__ u32x4 ld16_sc1(const bf16_t* p) {
    const unsigned long long* q = (const unsigned long long*)p;
    const unsigned long long lo = __hip_atomic_load(q, __ATOMIC_RELAXED, __HIP_MEMORY_SCOPE_AGENT), hi = __hip_atomic_load(q + 1, __ATOMIC_RELAXED, __HIP_MEMORY_SCOPE_AGENT);
    u32x4 w; w.x = (unsigned)lo; w.y = (unsigned)(lo >> 32); w.z = (unsigned)hi; w.w = (unsigned)(hi >> 32); return w; }
struct EpiMix {
    static constexpr bool PERM = true, AFTER_DRAIN = false;
    const bf16_t* G; bf16_t* MIX; bf16_t* P1;
    __device__ __forceinline__ void operator()(const f32x4 (&acc)[2][2][4][2], const Unit& u, int wr, int wc, int fr, int fq) const {
        const int row0 = u.pm * BM + wr * 64 + fr, col0 = u.pn * BM + wc * 32 + 8 * fq, sub = u.sub;
#pragma unroll
        for (int ai = 0; ai < 2; ++ai)
#pragma unroll
            for (int m = 0; m < 4; ++m) { const int row = row0 + ai * HALF + m * 16;
#pragma unroll
                for (int bj = 0; bj < 2; ++bj) { const int c = col0 + bj * HALF; f32x4 g0, g1; unpack8(*(const u32x4*)(G + (size_t)row * 3072 + sub * 1024 + c), g0, g1);
                    f32x4 v0 = acc[ai][bj][m][0] * g0, v1 = acc[ai][bj][m][1] * g1; const size_t off = (size_t)row * 1024 + c;
                    if (sub == 2) { f32x4 p0, p1; unpack8(ld16_sc1(MIX + off), p0, p1); v0 = v0 + p0; v1 = v1 + p1; unpack8(ld16_sc1(P1 + off), p0, p1); v0 = v0 + p0; v1 = v1 + p1; }
                    *(u32x4*)((sub == 1 ? P1 : MIX) + off) = pack8(v0, v1); } }
    }
};

struct EpiSwiglu {
    static constexpr bool PERM = true, AFTER_DRAIN = false;
    const float* ssq; bf16_t* ACT;
    __device__ __forceinline__ void operator()(const f32x4 (&acc)[2][2][4][2], const Unit& u, int wr, int wc, int fr, int fq) const {
        const int row0 = u.pm * BM + wr * 64 + fr, colh = u.pn * 128 + wc * 32 + 8 * fq;
#pragma unroll
        for (int ai = 0; ai < 2; ++ai)
#pragma unroll
            for (int m = 0; m < 4; ++m) { const int row = row0 + ai * HALF + m * 16; const float rs = rstd_of(ssq, row);
                f32x4 h[2];
#pragma unroll
                for (int n = 0; n < 2; ++n) { const f32x4 a = acc[ai][0][m][n] * rs, b = acc[ai][1][m][n] * rs;
#pragma unroll
                    for (int i = 0; i < 4; ++i) h[n][i] = a[i] * sigm(a[i]) * b[i]; }
                *(u32x4*)(ACT + (size_t)row * 2816 + colh) = pack8(h[0], h[1]); }
    }
};

template <class Epi, class Sched, bool ALIGN_EPI = false, bool SP2 = false>
__device__ __forceinline__ void gemm_phase(PG8_LAS unsigned char* lds, const Gemm g, const Sched& S, const Epi& E) {
    int tid_ = threadIdx.x; asm volatile("" : "+v"(tid_));
    const int tid = tid_, wid = __builtin_amdgcn_readfirstlane(tid >> 6), lane = tid & 63, wr = wid >> 2, wc = wid & 3, fr = lane & 15, fq = lane >> 4;
    const int K = g.K, nt = K / BK;
    unsigned voffA[2], voffB[2];
#pragma unroll
    for (int i = 0; i < 2; ++i) { int R, C; stage_rc(tid * 16 + i * 8192, R, C); const int Rb = Epi::PERM ? ((R & ~31) + perm32(R & 31)) : R;
        voffA[i] = (unsigned)(R * K + C) * 2u; voffB[i] = (unsigned)(Rb * K + C) * 2u; }
    const size_t kstep = (size_t)(BK * 2);
    const size_t hstep = (size_t)HALF * K * 2;
    const size_t tstep = 2 * hstep;
    const unsigned ldsw = (unsigned)wid * 1024u;
    const int aoff = lds_byte(wr * 64 + fr, fq * 8), boff = lds_byte(wc * 32 + fr, fq * 8);
#define PG8_SELA(s) ((const char*)((s) == 0 ? g.A0 : ((s) == 1 ? g.A1 : g.A2)))
#define PG8_SELB(s) ((const char*)((s) == 0 ? g.B0 : ((s) == 1 ? g.B1 : g.B2)))
#define PG8_SA(b, h) (((b) * 2 + (h)) * HTB)
#define PG8_SB(b, h) ((4 + (b) * 2 + (h)) * HTB)
#define PG8_STAGE(bufoff, gbase, voff) do { _Pragma("unroll") for (int _i = 0; _i < 2; ++_i) \
        __builtin_amdgcn_global_load_lds((const unsigned*)((const char*)(gbase) + (voff)[_i]), (PG8_LAS unsigned*)(lds + (bufoff) + ldsw + _i * 8192), 16, 0, 0); } while (0)
#define PG8_LDA(dst, b, h) do { _Pragma("unroll") for (int m = 0; m < 4; ++m) _Pragma("unroll") for (int k = 0; k < 2; ++k) dst[m][k] = *(const PG8_LAS bf16x8*)(lds + PG8_SA(b, h) + aoff + m * 2048 + k * 1024); } while (0)
#define PG8_LDB(dst, b, h) do { _Pragma("unroll") for (int n = 0; n < 2; ++n) _Pragma("unroll") for (int k = 0; k < 2; ++k) dst[n][k] = *(const PG8_LAS bf16x8*)(lds + PG8_SB(b, h) + boff + n * 2048 + k * 1024); } while (0)
#define PG8_MMA(ai, bj, At, Bt) do { __builtin_amdgcn_s_setprio(1); _Pragma("unroll") for (int m = 0; m < 4; ++m) _Pragma("unroll") for (int n = 0; n < 2; ++n) _Pragma("unroll") for (int k = 0; k < 2; ++k) \
        acc[ai][bj][m][n] = __builtin_amdgcn_mfma_f32_16x16x32_bf16(Bt[n][k], At[m][k], acc[ai][bj][m][n], 0, 0, 0); __builtin_amdgcn_s_setprio(0); } while (0)
#define PG8_WAIT_V(n) asm volatile("s_waitcnt vmcnt(" #n ")" ::: "memory")
#define PG8_WAIT_L(n) asm volatile("s_waitcnt lgkmcnt(" #n ")" ::: "memory")
#define PG8_BAR __builtin_amdgcn_s_barrier()
#define PG8_SCHED __builtin_amdgcn_sched_barrier(0)
    Unit cur, nxt; int ui = 0;
    if (!S.next(0, cur)) return;
    f32x4 acc[2][2][4][2];
#pragma unroll
    for (int a = 0; a < 2; ++a)
#pragma unroll
        for (int b = 0; b < 2; ++b)
#pragma unroll
            for (int m = 0; m < 4; ++m)
#pragma unroll
                for (int n = 0; n < 2; ++n) acc[a][b][m][n] = (f32x4){0.f, 0.f, 0.f, 0.f};
    bf16x8 At[4][2], B0[2][2], B1[2][2];
    const char* cA = PG8_SELA(cur.sub) + (size_t)cur.pm * tstep; const char* cB = PG8_SELB(cur.sub) + (size_t)cur.pn * tstep;
    S.a_ready(cur);
    if constexpr (SP2) {
        PG8_STAGE(PG8_SB(0, 0), cB, voffB); PG8_STAGE(PG8_SB(0, 1), cB + hstep, voffB); PG8_STAGE(PG8_SA(0, 0), cA, voffA); PG8_STAGE(PG8_SA(0, 1), cA + hstep, voffA);
        if (wr == 1) PG8_BAR;
        PG8_WAIT_V(2); PG8_BAR;
        PG8_STAGE(PG8_SB(1, 0), cB + kstep, voffB); PG8_STAGE(PG8_SA(1, 0), cA + kstep, voffA); PG8_STAGE(PG8_SB(1, 1), cB + hstep + kstep, voffB);
        PG8_WAIT_V(6); PG8_BAR;
    } else {
        PG8_STAGE(PG8_SB(0, 0), cB, voffB); PG8_STAGE(PG8_SA(0, 0), cA, voffA); PG8_STAGE(PG8_SB(0, 1), cB + hstep, voffB); PG8_STAGE(PG8_SA(0, 1), cA + hstep, voffA);
        if (wr == 1) PG8_BAR;
        PG8_WAIT_V(4); PG8_BAR;
        PG8_STAGE(PG8_SB(1, 0), cB + kstep, voffB); PG8_STAGE(PG8_SA(1, 0), cA + kstep, voffA); PG8_STAGE(PG8_SB(1, 1), cB + hstep + kstep, voffB);
        PG8_WAIT_V(6); PG8_BAR;
    }
    for (;;) {
        const bool has_next = S.next(ui + 1, nxt);
        const char* nA = has_next ? PG8_SELA(nxt.sub) + (size_t)nxt.pm * tstep : cA; const char* nB = has_next ? PG8_SELB(nxt.sub) + (size_t)nxt.pn * tstep : cB;
        for (int t = 0; t < nt; t += 2) {
            const bool last = (t == nt - 2);
            const char* a1 = cA + (size_t)(t + 1) * kstep;
            const char* a2 = last ? nA : cA + (size_t)(t + 2) * kstep; const char* b2 = last ? nB : cB + (size_t)(t + 2) * kstep;
            const char* a3 = a2 + kstep; const char* b3 = b2 + kstep;
            if (last && has_next) S.a_ready(nxt);
            if constexpr (SP2) {
            PG8_LDB(B0, 0, 0); PG8_LDB(B1, 0, 1); PG8_SCHED; PG8_LDA(At, 0, 0); PG8_STAGE(PG8_SA(1, 1), a1 + hstep, voffA);
            PG8_WAIT_V(8); PG8_WAIT_L(0); PG8_BAR; PG8_MMA(0, 0, At, B0); PG8_MMA(0, 1, At, B1); PG8_BAR; PG8_SCHED;
            PG8_LDA(At, 0, 1); PG8_STAGE(PG8_SB(0, 0), b2, voffB); PG8_STAGE(PG8_SB(0, 1), b2 + hstep, voffB); PG8_STAGE(PG8_SA(0, 0), a2, voffA);
            PG8_WAIT_V(8); PG8_WAIT_L(0); PG8_BAR; PG8_MMA(1, 0, At, B0); PG8_MMA(1, 1, At, B1); PG8_BAR; PG8_SCHED;
            PG8_LDB(B0, 1, 0); PG8_LDB(B1, 1, 1); PG8_SCHED; PG8_LDA(At, 1, 0); PG8_STAGE(PG8_SA(0, 1), a2 + hstep, voffA);
            PG8_WAIT_V(8); PG8_WAIT_L(0); PG8_BAR; PG8_MMA(0, 0, At, B0); PG8_MMA(0, 1, At, B1); PG8_BAR; PG8_SCHED;
            PG8_LDA(At, 1, 1); PG8_STAGE(PG8_SB(1, 0), b3, voffB); PG8_STAGE(PG8_SB(1, 1), b3 + hstep, voffB); PG8_STAGE(PG8_SA(1, 0), a3, voffA);
            PG8_WAIT_V(8); PG8_WAIT_L(0); PG8_BAR; PG8_MMA(1, 0, At, B0); PG8_MMA(1, 1, At, B1); PG8_BAR; PG8_SCHED;
            } else {
            PG8_LDB(B0, 0, 0); PG8_SCHED; PG8_LDA(At, 0, 0); PG8_STAGE(PG8_SA(1, 1), a1 + hstep, voffA);
            PG8_WAIT_L(8); PG8_BAR; PG8_WAIT_L(0); PG8_MMA(0, 0, At, B0); PG8_BAR; PG8_SCHED;
            PG8_LDB(B1, 0, 1); PG8_STAGE(PG8_SB(0, 0), b2, voffB);
            PG8_BAR; PG8_WAIT_L(0); PG8_MMA(0, 1, At, B1); PG8_BAR;
            PG8_LDA(At, 0, 1); PG8_STAGE(PG8_SA(0, 0), a2, voffA);
            PG8_BAR; PG8_WAIT_L(0); PG8_MMA(1, 0, At, B0); PG8_BAR; PG8_SCHED;
            PG8_STAGE(PG8_SB(0, 1), b2 + hstep, voffB);
            PG8_WAIT_V(6); PG8_BAR; PG8_MMA(1, 1, At, B1); PG8_BAR;
            PG8_LDB(B0, 1, 0); PG8_SCHED; PG8_LDA(At, 1, 0); PG8_STAGE(PG8_SA(0, 1), a2 + hstep, voffA);
            PG8_WAIT_L(8); PG8_BAR; PG8_WAIT_L(0); PG8_MMA(0, 0, At, B0); PG8_BAR; PG8_SCHED;
            PG8_LDB(B1, 1, 1); PG8_STAGE(PG8_SB(1, 0), b3, voffB);
            PG8_BAR; PG8_WAIT_L(0); PG8_MMA(0, 1, At, B1); PG8_BAR;
            PG8_LDA(At, 1, 1); PG8_STAGE(PG8_SA(1, 0), a3, voffA);
            PG8_BAR; PG8_WAIT_L(0); PG8_MMA(1, 0, At, B0); PG8_BAR; PG8_SCHED;
            PG8_STAGE(PG8_SB(1, 1), b3 + hstep, voffB);
            PG8_WAIT_V(6); PG8_BAR; PG8_MMA(1, 1, At, B1); PG8_BAR;
            }
        }
        if constexpr (ALIGN_EPI) { if (wr == 0) PG8_BAR; }
        if constexpr (!Epi::AFTER_DRAIN) { E(acc, cur, wr, wc, fr, fq); S.done(cur); }
        if (!has_next) break;
#pragma unroll
        for (int a = 0; a < 2; ++a)
#pragma unroll
            for (int b = 0; b < 2; ++b)
#pragma unroll
                for (int m = 0; m < 4; ++m)
#pragma unroll
                    for (int n = 0; n < 2; ++n) acc[a][b][m][n] = (f32x4){0.f, 0.f, 0.f, 0.f};
        cur = nxt; cA = nA; cB = nB; ++ui;
        if constexpr (ALIGN_EPI) { if (wr == 1) PG8_BAR; }
    }
    PG8_WAIT_V(0);
    if constexpr (!ALIGN_EPI) { if (wr == 0) PG8_BAR; }
    PG8_BAR;
    if constexpr (Epi::AFTER_DRAIN) { E.fused(acc, cur, wr, wc, fr, fq, lds, wid, lane); S.done(cur); }
#undef PG8_SA
#undef PG8_SELA
#undef PG8_SELB
#undef PG8_SB
#undef PG8_STAGE
#undef PG8_LDA
#undef PG8_LDB
#undef PG8_MMA
#undef PG8_WAIT_V
#undef PG8_WAIT_L
#undef PG8_BAR
#undef PG8_SCHED
}
}

#include <hip/hip_bf16.h>
#include <cmath>
namespace attn_body {
using bf16=__hip_bfloat16;
using bf16x8=__attribute__((ext_vector_type(8)))short;
using s16x4=__attribute__((ext_vector_type(4)))short;
using f32x16=__attribute__((ext_vector_type(16)))float;
using u32x4=__attribute__((ext_vector_type(4)))unsigned;
constexpr int BATCH=16,NHEAD=8,SEQ=2048,D=64,DM=NHEAD*D;
constexpr int NW=8,QBLK=32,QB=QBLK*NW,KVBLK=64,NQB=SEQ/QB;
constexpr int ATTN_PITCH=DM, ATTN_UNIT_ROWS=QB;
__device__ __forceinline__ int crow(int r,int hi){return (r&3)+8*(r>>2)+4*hi;}
#define SBAR() __builtin_amdgcn_sched_barrier(0)
__device__ __forceinline__ void cmask(f32x16&p0,f32x16&p1,int jb,int qrel,int hi){
  const float NEG=-INFINITY; int kb=64*jb+4*hi;
  #pragma unroll
  for(int r=0;r<16;++r){int kv=kb+(r&3)+8*(r>>2); if(kv>qrel)p0[r]=NEG; if(kv+32>qrel)p1[r]=NEG;}
}

constexpr int NSLOT=3, SLOTB=8192;
constexpr int LDS_K=0, LDS_V=NSLOT*SLOTB, LDS_WS=2*NSLOT*SLOTB, LDS_OST=LDS_WS+NW*64*4, LDS_F=LDS_OST+NW*4096, LDS_FW=LDS_F+SEQ*4, LDS_BYTES=LDS_FW+64;
constexpr float C2=0.125f*1.4426950408889634f;
__device__ __forceinline__ void glds16(const void*gsrc,unsigned lds_dst){unsigned keep;
  asm volatile("s_mov_b32 %0, m0\n\ts_mov_b32 m0, %2\n\ts_nop 0\n\tglobal_load_lds_dwordx4 %1, off\n\ts_mov_b32 m0, %0":"=&s"(keep):"v"(gsrc),"s"(lds_dst):"memory");}
__device__ __forceinline__ float max3f(float a,float b,float c){float r;asm("v_max3_f32 %0, %1, %2, %3":"=v"(r):"v"(a),"v"(b),"v"(c));return r;}
__device__ __forceinline__ float max2f(float a,float b){float r;asm("v_max_f32_e32 %0, %1, %2":"=v"(r):"v"(a),"v"(b));return r;}
__device__ __forceinline__ float fadd_s(float a,float b){float r;asm("v_add_f32_e32 %0, %1, %2":"=v"(r):"v"(a),"v"(b));return r;}
__device__ __forceinline__ float fsub_s(float a,float b){float r;asm("v_sub_f32_e32 %0, %1, %2":"=v"(r):"v"(a),"v"(b));return r;}
typedef float f32x2_t __attribute__((ext_vector_type(2))); typedef __bf16 bf16x2_t __attribute__((ext_vector_type(2)));
__device__ __forceinline__ unsigned cvtpk_s(float lo,float hi){f32x2_t v={lo,hi};bf16x2_t b=__builtin_convertvector(v,bf16x2_t);return __builtin_bit_cast(unsigned,b);}
#define WAIT_BAR(N) asm volatile("s_waitcnt vmcnt(" #N ") lgkmcnt(0)\n\ts_barrier":::"memory")

__device__ __forceinline__ void qkt(f32x16&p0,f32x16&p1,const char*Kslot,const bf16x8*qr,const f32x16&negm,int r32,int hi){
  const char*kb=Kslot+hi*1024+r32*16;
  #pragma unroll
  for(int d0=0;d0<4;++d0){
    const bf16x8 b0=*reinterpret_cast<const bf16x8*>(kb+d0*2048);
    const bf16x8 b1=*reinterpret_cast<const bf16x8*>(kb+d0*2048+512);
    if(d0==0){p0=__builtin_amdgcn_mfma_f32_32x32x16_bf16(b0,qr[0],negm,0,0,0);p1=__builtin_amdgcn_mfma_f32_32x32x16_bf16(b1,qr[0],negm,0,0,0);}
    else{p0=__builtin_amdgcn_mfma_f32_32x32x16_bf16(b0,qr[d0],p0,0,0,0);p1=__builtin_amdgcn_mfma_f32_32x32x16_bf16(b1,qr[d0],p1,0,0,0);}}
}
typedef __attribute__((address_space(3))) const char* lds_cptr;
typedef short v4i16_t __attribute__((ext_vector_type(4)));
__device__ __forceinline__ void kload8(bf16x8*kf,lds_cptr kp){
  kf[0]=*(const __attribute__((address_space(3))) bf16x8*)(kp);      kf[1]=*(const __attribute__((address_space(3))) bf16x8*)(kp+512);
  kf[2]=*(const __attribute__((address_space(3))) bf16x8*)(kp+2048); kf[3]=*(const __attribute__((address_space(3))) bf16x8*)(kp+2560);
  kf[4]=*(const __attribute__((address_space(3))) bf16x8*)(kp+4096); kf[5]=*(const __attribute__((address_space(3))) bf16x8*)(kp+4608);
  kf[6]=*(const __attribute__((address_space(3))) bf16x8*)(kp+6144); kf[7]=*(const __attribute__((address_space(3))) bf16x8*)(kp+6656);
}
__device__ __forceinline__ void kload2(bf16x8*kf,lds_cptr kp,int j){ kf[2*j]=*(const __attribute__((address_space(3))) bf16x8*)(kp+j*2048); kf[2*j+1]=*(const __attribute__((address_space(3))) bf16x8*)(kp+j*2048+512); }
__device__ __forceinline__ s16x4 vtr(lds_cptr p){ return __builtin_bit_cast(s16x4,__builtin_amdgcn_ds_read_tr16_b64_v4i16((__attribute__((address_space(3))) v4i16_t*)p)); }
__device__ __forceinline__ float rowmax(const f32x16&p0,const f32x16&p1){
  float a=max3f(p0[0],p0[1],p1[0]),b=max3f(p0[2],p0[3],p1[1]);a=max3f(a,p1[2],p1[3]);
  #pragma unroll
  for(int r=4;r<16;r+=4){a=max3f(a,p0[r],p0[r+1]);b=max3f(b,p0[r+2],p0[r+3]);a=max3f(a,p1[r],p1[r+1]);b=max3f(b,p1[r+2],p1[r+3]);}
  const float m=max2f(a,b);
  auto rr=__builtin_amdgcn_permlane32_swap(__float_as_uint(m),__float_as_uint(m),false,false);
  return max2f(__uint_as_float(rr[0]),__uint_as_float(rr[1]));
}
__device__ __forceinline__ void pv(f32x16*o,int vb,bf16x8 pa0,bf16x8 pa1,bf16x8 pa2,bf16x8 pa3){
  #pragma unroll
  for(int d0=0;d0<2;++d0){s16x4 lo[4],hi[4];
    #pragma unroll
    for(int ks=0;ks<4;++ks){
      asm volatile("ds_read_b64_tr_b16 %0,%1 offset:%c2":"=&v"(lo[ks]):"v"(vb),"i"(d0*4096+ks*1024):"memory");
      asm volatile("ds_read_b64_tr_b16 %0,%1 offset:%c2":"=&v"(hi[ks]):"v"(vb),"i"(d0*4096+ks*1024+512):"memory");}
    asm volatile("s_waitcnt lgkmcnt(0)":::"memory");SBAR();
    #define PK(k) (bf16x8){lo[k][0],lo[k][1],lo[k][2],lo[k][3],hi[k][0],hi[k][1],hi[k][2],hi[k][3]}
    o[d0]=__builtin_amdgcn_mfma_f32_32x32x16_bf16(pa0,PK(0),o[d0],0,0,0);
    o[d0]=__builtin_amdgcn_mfma_f32_32x32x16_bf16(pa1,PK(1),o[d0],0,0,0);
    o[d0]=__builtin_amdgcn_mfma_f32_32x32x16_bf16(pa2,PK(2),o[d0],0,0,0);
    o[d0]=__builtin_amdgcn_mfma_f32_32x32x16_bf16(pa3,PK(3),o[d0],0,0,0);
    #undef PK
  }
}

#ifndef ATTN_STORE16
#define ATTN_STORE16(p,v) (*(u32x4*)(p)=(v))
#endif
typedef float f32x4v __attribute__((ext_vector_type(4)));
__device__ __forceinline__ float logsig(float x){ return fminf(x,0.f)-log1pf(__expf(-fabsf(x))); }
template<int THRL> __device__ __forceinline__ void attn_unit(int b,int h,int qb,const bf16*Q,const bf16*__restrict__ K,const bf16*__restrict__ V,bf16*O,char*shm,const float*__restrict__ flog,float bfh){
  int tid_=threadIdx.x; asm volatile("":"+v"(tid_)); const int tid=tid_,lane=tid&63,r32=lane&31,hi=lane>>5; const int wid=__builtin_amdgcn_readfirstlane(tid>>6);
  const long rowbase=(long)b*SEQ; const int q0=qb*QB;
  const bf16*Qw=Q+(rowbase+q0+wid*QBLK)*DM+h*D;
  const bf16*Kh=K+rowbase*DM+h*D,*Vh=V+rowbase*DM+h*D;
  const unsigned lds0=(unsigned)(uintptr_t)shm;
  float*wsf=(float*)(shm+LDS_WS)+wid*64;
  const bf16*ksrc=Kh+(long)lane*DM+wid*8;
  const bf16*vsrc=Vh+(long)(16*(wid&3)+(lane>>2))*DM+(wid>>2)*32+(lane&3)*8;
  const unsigned kdst=lds0+LDS_K+wid*1024, vdst=lds0+LDS_V+wid*1024;
  #define DMA_K(t,slot) glds16(ksrc+(long)(t)*KVBLK*DM,(unsigned)__builtin_amdgcn_readfirstlane(kdst+(slot)))
  #define DMA_V(t,slot) glds16(vsrc+(long)(t)*KVBLK*DM,(unsigned)__builtin_amdgcn_readfirstlane(vdst+(slot)))
  const int vb0=(int)(lds0+LDS_V)+((lane>>4)&1)*32+(lane&3)*8+(4*hi+((lane&15)>>2))*64;
  const char*Kbase=shm+LDS_K; bf16x8 kf[8];
  const lds_cptr shm3=(lds_cptr)shm; const lds_cptr kp0=shm3+LDS_K+hi*1024+r32*16; const lds_cptr vp0=shm3+LDS_V+((lane>>4)&1)*32+(lane&3)*8+(4*hi+((lane&15)>>2))*64;
  const int NT=(q0+QB)/KVBLK;
  typedef __attribute__((address_space(3))) float* lds_fptr;
  const lds_fptr fs3=(lds_fptr)(shm3+LDS_F); const lds_fptr fw3=(lds_fptr)(shm3+LDS_FW);
  { float v0=0.f,v1=0.f,v2=0.f,v3=0.f; const int t0=4*tid;
    if(t0<NT*KVBLK){ const float*fp=flog+(rowbase+t0)*NHEAD+h; v0=logsig(fp[0]+bfh); v1=logsig(fp[NHEAD]+bfh); v2=logsig(fp[2*NHEAD]+bfh); v3=logsig(fp[3*NHEAD]+bfh); }
    v1+=v0; v2+=v1; v3+=v2; float inc=v3;
    #pragma unroll
    for(int o=1;o<64;o<<=1){ const float nb=__shfl_up(inc,o); if(lane>=o)inc+=nb; }
    if(lane==63)fw3[wid]=inc;
    asm volatile("s_waitcnt lgkmcnt(0)\n\ts_barrier":::"memory");
    float woff=0.f;
    #pragma unroll
    for(int w_=0;w_<NW;++w_){ const float tw=fw3[w_]; if(w_<wid)woff+=tw; }
    const float ex=woff+(inc-v3); const float L2E=1.4426950408889634f;
    *(__attribute__((address_space(3))) f32x4v*)(fs3+t0)=(f32x4v){(v0+ex)*L2E,(v1+ex)*L2E,(v2+ex)*L2E,(v3+ex)*L2E};
    asm volatile("s_waitcnt lgkmcnt(0)\n\ts_barrier":::"memory"); }
  const float fq2=fs3[q0+wid*QBLK+r32];
  #define FKSUB(P0,P1,t) do{ const lds_fptr fk_=fs3+(t)*KVBLK+4*hi; \
    _Pragma("unroll") for(int r_=0;r_<16;++r_){ P0[r_]+=nq; P1[r_]+=nq; } \
    _Pragma("unroll") for(int j_=0;j_<4;++j_){ { const f32x4v a_=*(const __attribute__((address_space(3))) f32x4v*)(fk_+8*j_); \
      _Pragma("unroll") for(int i_=0;i_<4;++i_) P0[4*j_+i_]-=a_[i_]; } SBAR(); \
      { const f32x4v b_=*(const __attribute__((address_space(3))) f32x4v*)(fk_+32+8*j_); \
      _Pragma("unroll") for(int i_=0;i_<4;++i_) P1[4*j_+i_]-=b_[i_]; } SBAR(); } }while(0)
  DMA_K(0,0);DMA_V(0,0);DMA_K(1,SLOTB);
  bf16x8 qr[4];
  #pragma unroll
  for(int d0=0;d0<4;++d0)qr[d0]=*reinterpret_cast<const bf16x8*>(&Qw[(long)r32*DM+d0*16+hi*8]);
  float mhat=0.f,l_reg=0.f;f32x16 o[2];o[0]=f32x16{};o[1]=f32x16{};const f32x16 negm=f32x16{}; float nq=fq2;
  const int qrel=wid*QBLK+r32;
  #define CMASK(P0,P1,t) do{int jb_=(t)-(NT-4); if(jb_>=0)cmask(P0,P1,jb_,qrel,hi);}while(0)
  bool resc=false;
  #define START(P0,P1) do{ const float rm=rowmax(P0,P1); resc=false; \
    { const float dl=rm; mhat=fadd_s(mhat,dl); \
      _Pragma("unroll") for(int r=0;r<16;++r){P0[r]=fsub_s(P0[r],dl);P1[r]=fsub_s(P1[r],dl);} \
      nq=fq2-mhat; } \
    _Pragma("unroll") for(int r=0;r<16;++r)P0[r]=__builtin_amdgcn_exp2f(P0[r]); }while(0)
  #define RESC() do{ if(resc){ asm volatile("s_waitcnt lgkmcnt(0)":::"memory"); \
      _Pragma("unroll") for(int d_=0;d_<2;++d_) _Pragma("unroll") for(int r=0;r<16;++r)o[d_][r]*=wsf[crow(r,hi)]; } }while(0)
  f32x16 pA0,pA1,pB0,pB1;
  int sl_prev=0,sl_cur=0,sl_next=SLOTB;
  #define ROT() do{sl_prev=sl_cur;sl_cur=sl_next;sl_next=(sl_next==(NSLOT-1)*SLOTB)?0:sl_next+SLOTB;}while(0)
  DMA_K(2,2*SLOTB);
  WAIT_BAR(3);
  qkt(pA0,pA1,Kbase,qr,negm,r32,hi);asm volatile("s_nop 15\n\ts_nop 7":"+v"(pA0),"+v"(pA1));FKSUB(pA0,pA1,0);CMASK(pA0,pA1,0);
  START(pA0,pA1);
  _Pragma("unroll") for(int r=0;r<16;++r)pA1[r]=__builtin_amdgcn_exp2f(pA1[r]);
  WAIT_BAR(0);
  DMA_K(3,0);DMA_V(1,SLOTB);
  ROT();
  kload8(kf,kp0+sl_cur);
  WAIT_BAR(2);
  s16x4 vlo[8],vhi[8]; u32x4 pw0,pw1,pw2,pw3;
  #define PKW(P,B) cvtpk_s(P[B],P[B+1])
  #define PAF(k) __builtin_bit_cast(bf16x8,pw##k)
  #define VFR(i) (bf16x8){vlo[i][0],vlo[i][1],vlo[i][2],vlo[i][3],vhi[i][0],vhi[i][1],vhi[i][2],vhi[i][3]}
  #define PIN(x) asm volatile("":"+v"(x))
  #define MX3(a,b,c) __builtin_fmaxf(__builtin_fmaxf((a),(b)),(c))
  #define GAPA(MF,A0,A1,A2,A3,W0,W1,PW) do{ MF; sacc+=A0; sacc+=A1; sacc+=A2; sacc+=A3; PIN(sacc); W0; W1; PIN(PW); SBAR(); }while(0)
  #define EX(v) __builtin_amdgcn_exp2f(v)
  #define GAPB(MF,X,B) do{ MF; X[B]=EX(X[B]); X[B+1]=EX(X[B+1]); X[B+2]=EX(X[B+2]); X[B+3]=EX(X[B+3]); PIN(X); SBAR(); }while(0)
  #define VRD(i) do{ vlo[i]=vtr(vp_+(((i)>>2)*4096+((i)&3)*1024)); vhi[i]=vtr(vp_+(((i)>>2)*4096+((i)&3)*1024+512)); }while(0)
  #define KRD(G,j) do{ if(G){ kload2(kf,kp0+sl_next,j); SBAR(); } }while(0)
  #define STEP(C0,C1,P0,P1,t,GK,GV,GL) do{ SBAR(); \
    const lds_cptr vp_=vp0+sl_prev; \
    VRD(0); SBAR(); float sacc=(P0[0]+P0[1]); \
    GAPA(C0=__builtin_amdgcn_mfma_f32_32x32x16_bf16(kf[0],qr[0],negm,0,0,0), P0[2],P0[3],P0[4],P0[5],     pw0[0]=PKW(P0,0), pw0[1]=PKW(P0,2), pw0); \
    VRD(4); SBAR(); GAPA(C1=__builtin_amdgcn_mfma_f32_32x32x16_bf16(kf[1],qr[0],negm,0,0,0), P0[6],P0[7],P0[8],P0[9],     pw0[2]=PKW(P0,4), pw0[3]=PKW(P0,6), pw0); \
    VRD(1); SBAR(); GAPA(C0=__builtin_amdgcn_mfma_f32_32x32x16_bf16(kf[2],qr[1],C0,0,0,0),   P0[10],P0[11],P0[12],P0[13], pw1[0]=PKW(P0,8), pw1[1]=PKW(P0,10), pw1); \
    VRD(5); SBAR(); GAPA(C1=__builtin_amdgcn_mfma_f32_32x32x16_bf16(kf[3],qr[1],C1,0,0,0),   P0[14],P0[15],P1[0],P1[1],   pw1[2]=PKW(P0,12),pw1[3]=PKW(P0,14), pw1); \
    VRD(2); SBAR(); GAPA(C0=__builtin_amdgcn_mfma_f32_32x32x16_bf16(kf[4],qr[2],C0,0,0,0),   P1[2],P1[3],P1[4],P1[5],     pw2[0]=PKW(P1,0), pw2[1]=PKW(P1,2), pw2); \
    VRD(6); SBAR(); GAPA(C1=__builtin_amdgcn_mfma_f32_32x32x16_bf16(kf[5],qr[2],C1,0,0,0),   P1[6],P1[7],P1[8],P1[9],     pw2[2]=PKW(P1,4), pw2[3]=PKW(P1,6), pw2); \
    VRD(3); SBAR(); GAPA(C0=__builtin_amdgcn_mfma_f32_32x32x16_bf16(kf[6],qr[3],C0,0,0,0),   P1[10],P1[11],P1[12],P1[13], pw3[0]=PKW(P1,8), pw3[1]=PKW(P1,10), pw3); \
    VRD(7); SBAR(); GAPA(C1=__builtin_amdgcn_mfma_f32_32x32x16_bf16(kf[7],qr[3],C1,0,0,0),   P1[14],P1[15],0.f,0.f,       pw3[2]=PKW(P1,12),pw3[3]=PKW(P1,14), pw3); \
    l_reg+=sacc; \
    if(GK){DMA_K((t)+3,sl_cur);} if(GV){DMA_V((t)+1,sl_next);} \
    FKSUB(C0,C1,t); CMASK(C0,C1,t); \
    { float a=MX3(C0[0],C0[1],C1[0]),b=MX3(C0[2],C0[3],C1[1]); a=MX3(a,C1[2],C1[3]); \
      _Pragma("unroll") for(int r=4;r<16;r+=4){a=MX3(a,C0[r],C0[r+1]);b=MX3(b,C0[r+2],C0[r+3]);a=MX3(a,C1[r],C1[r+1]);b=MX3(b,C1[r+2],C1[r+3]);} \
      float rm=__builtin_fmaxf(a,b); { auto rr=__builtin_amdgcn_permlane32_swap(__float_as_uint(rm),__float_as_uint(rm),false,false); rm=__builtin_fmaxf(__uint_as_float(rr[0]),__uint_as_float(rr[1])); } \
      resc=false; \
      if(__builtin_expect(__any(rm>(float)THRL),0)){ const float dl=__builtin_fmaxf(rm,0.f); mhat+=dl; \
        _Pragma("unroll") for(int r=0;r<16;++r){C0[r]-=dl;C1[r]-=dl;} \
        nq=fq2-mhat; \
        const float f=__builtin_amdgcn_exp2f(-dl); l_reg*=f; if(hi==0)wsf[r32]=f; resc=true; } } \
    SBAR(); \
    GAPB(o[0]=__builtin_amdgcn_mfma_f32_32x32x16_bf16(PAF(0),VFR(0),o[0],0,0,0), C0,0); \
    GAPB(o[1]=__builtin_amdgcn_mfma_f32_32x32x16_bf16(PAF(0),VFR(4),o[1],0,0,0), C0,4); \
    KRD(GL,0); GAPB(o[0]=__builtin_amdgcn_mfma_f32_32x32x16_bf16(PAF(1),VFR(1),o[0],0,0,0), C0,8); \
    KRD(GL,1); GAPB(o[1]=__builtin_amdgcn_mfma_f32_32x32x16_bf16(PAF(1),VFR(5),o[1],0,0,0), C0,12); \
    KRD(GL,2); GAPB(o[0]=__builtin_amdgcn_mfma_f32_32x32x16_bf16(PAF(2),VFR(2),o[0],0,0,0), C1,0); \
    KRD(GL,3); GAPB(o[1]=__builtin_amdgcn_mfma_f32_32x32x16_bf16(PAF(2),VFR(6),o[1],0,0,0), C1,4); \
    GAPB(o[0]=__builtin_amdgcn_mfma_f32_32x32x16_bf16(PAF(3),VFR(3),o[0],0,0,0), C1,8); \
    GAPB(o[1]=__builtin_amdgcn_mfma_f32_32x32x16_bf16(PAF(3),VFR(7),o[1],0,0,0), C1,12); \
    }while(0)
  int t=1;
  #undef CMASK
  #define CMASK(P0,P1,t) do{}while(0)
  for(;t+5<NT;t+=2){
    STEP(pB0,pB1,pA0,pA1,t,true,true,true);     WAIT_BAR(2); RESC(); ROT();
    STEP(pA0,pA1,pB0,pB1,t+1,true,true,true);   WAIT_BAR(2); RESC(); ROT();
  }
  #undef CMASK
  #define CMASK(P0,P1,t) do{int jb_=(t)-(NT-4); if(jb_>=0)cmask(P0,P1,jb_,qrel,hi);}while(0)
  #define ENDW(tt) do{ if((tt)+3<NT){WAIT_BAR(2);} else if((tt)+2<NT){WAIT_BAR(1);} else {WAIT_BAR(0);} }while(0)
  for(;t+1<NT;t+=2){
    STEP(pB0,pB1,pA0,pA1,t,(t+3<NT),(t+1<NT),(t+1<NT));       ENDW(t);   RESC(); ROT();
    STEP(pA0,pA1,pB0,pB1,t+1,(t+4<NT),(t+2<NT),(t+2<NT));     ENDW(t+1); RESC(); ROT();
  }
  STEP(pB0,pB1,pA0,pA1,NT-1,false,false,false); RESC();
  { float sacc=pB0[0]+pB0[1]; _Pragma("unroll") for(int r=2;r<16;++r)sacc+=pB0[r]; _Pragma("unroll") for(int r=0;r<16;++r)sacc+=pB1[r]; l_reg+=sacc;
    pw0=(u32x4){PKW(pB0,0),PKW(pB0,2),PKW(pB0,4),PKW(pB0,6)};pw1=(u32x4){PKW(pB0,8),PKW(pB0,10),PKW(pB0,12),PKW(pB0,14)};pw2=(u32x4){PKW(pB1,0),PKW(pB1,2),PKW(pB1,4),PKW(pB1,6)};pw3=(u32x4){PKW(pB1,8),PKW(pB1,10),PKW(pB1,12),PKW(pB1,14)};
    SBAR(); pv(o,vb0+sl_cur,PAF(0),PAF(1),PAF(2),PAF(3)); }
  #undef PKW
  #undef PAF
  #undef VFR
  #undef PIN
  #undef MX3
  #undef GAPA
  #undef GAPB
  #undef EX
  #undef VRD
  #undef KRD
  #undef STEP
  #undef ENDW
  {auto rr=__builtin_amdgcn_permlane32_swap(__float_as_uint(l_reg),__float_as_uint(l_reg),false,false);l_reg=__uint_as_float(rr[0])+__uint_as_float(rr[1]);}
  if(hi==0)wsf[32+r32]=l_reg;asm volatile("s_waitcnt lgkmcnt(0)":::"memory");
  float rli[16];
  #pragma unroll
  for(int r=0;r<16;++r)rli[r]=__builtin_amdgcn_rcpf(wsf[32+crow(r,hi)]);
  bf16*Ow=O+(rowbase+q0+wid*QBLK)*DM+h*D;
  { bf16*stg=(bf16*)(shm+LDS_OST)+wid*2048;
    #pragma unroll
    for(int r=0;r<16;++r){const int orow=crow(r,hi);
      #pragma unroll
      for(int d0=0;d0<2;++d0)stg[orow*64+d0*32+r32]=__float2bfloat16(o[d0][r]*rli[r]);}
    asm volatile("s_waitcnt lgkmcnt(0)":::"memory");
    #pragma unroll
    for(int i=0;i<4;++i){const int row=i*8+(lane>>3),ch=lane&7; const u32x4 v=*(const u32x4*)(stg+row*64+ch*8); ATTN_STORE16(Ow+(long)row*DM+ch*8,v);} }
  asm volatile("s_waitcnt lgkmcnt(0)\n\ts_barrier":::"memory");
  #undef FKSUB
  #undef DMA_K
  #undef DMA_V
  #undef CMASK
  #undef START
  #undef RESC
  #undef ROT
}
constexpr int ATTN_LDS_BYTES=LDS_BYTES;
struct AttnTensors { const bf16* Q; const bf16* K; const bf16* V; bf16* O; const float* flog; const float* bf; };
struct AttnUnit { int bh; int qb; };
struct StaticOrder {
  int vcu,G;
  __device__ __forceinline__ explicit StaticOrder(int grid,int v):vcu(v),G(grid){}
  __device__ __forceinline__ bool next(int i,AttnUnit&u)const{
    if(G==256){ if(i>=4)return false; const int s=vcu&1; u.bh=vcu>>1; u.qb=(i==0)?7-s:(i==1)?4+s:(i==2)?3-s:s; return true; }
    const int idx=i*G+vcu; if(idx>=BATCH*NHEAD*NQB)return false; u.bh=idx>>3; u.qb=7-(idx&7); return true; }
  __device__ __forceinline__ void a_ready(const AttnUnit&)const{}
  __device__ __forceinline__ void done(const AttnUnit&)const{}
};
template<class Sched,int THRL=8> __device__ __forceinline__ void attn_phase(char*lds,const AttnTensors&T,const Sched&S){
  AttnUnit u;
  for(int i=0;S.next(i,u);++i){ S.a_ready(u); attn_unit<THRL>(u.bh/NHEAD,u.bh%NHEAD,u.qb,T.Q,T.K,T.V,T.O,lds,T.flog,T.bf[u.bh%NHEAD]); S.done(u); }
}
#undef SBAR
#undef WAIT_BAR
}
namespace cg = cooperative_groups;
constexpr int NWAVES = 8;
constexpr int BATCH = 16, SEQ = 2048, DMODEL = 1024, MROWS = BATCH * SEQ, NHEADS = 8, AW = 512, FFH = 2816, NIN = 6912, NINSRC = 6664, DEPTH = 2;
constexpr size_t MiB = 1u << 20, KiB512 = 512u << 10;
constexpr size_t WS_SSQ = 0;
constexpr size_t WS_FLOG = 3 * MiB;
constexpr size_t WS_WIN = 4 * MiB;
constexpr size_t WS_WL = 18 * MiB, WL_STRIDE = 21 * MiB + MiB / 2;
constexpr size_t WL_A = 0, WL_B = 1 * MiB, WL_C = 2 * MiB, WL_OUT = 3 * MiB, WL_GU = 5 * MiB, WL_DN = 16 * MiB;
constexpr size_t WS_XB = 61 * MiB, WS_D = 61 * MiB, WS_YC = 93 * MiB;
constexpr size_t WS_QA = 125 * MiB, WS_K = 157 * MiB, WS_V = 189 * MiB, WS_MIX = 157 * MiB;
constexpr size_t WS_U = 221 * MiB, WS_Z = 253 * MiB, WS_CB = 285 * MiB, WS_G = 317 * MiB;
constexpr size_t WS_ACT = 125 * MiB;
constexpr size_t WS_END = 509 * MiB;
static_assert(WS_WL + 2 * WL_STRIDE <= WS_XB && WS_G + (size_t)MROWS * 3072 * 2 <= WS_END && WS_ACT + (size_t)MROWS * FFH * 2 <= WS_G, "d_ws map");
constexpr int RING_BYTES = 131072, LDS_BYTES = 147456;

#define GAS __attribute__((address_space(1)))
#define LAS __attribute__((address_space(3)))
typedef unsigned short bf16;
typedef unsigned v4u __attribute__((ext_vector_type(4)));
typedef float f32x4 __attribute__((ext_vector_type(4)));
#define LDS_WAIT() asm volatile("s_waitcnt lgkmcnt(0)" ::: "memory")
__device__ __forceinline__ unsigned f2bf(float f) { unsigned u = __builtin_bit_cast(unsigned, f); return (u + 0x7fffu + ((u >> 16) & 1u)) >> 16; }
__device__ __forceinline__ unsigned pk2(float lo, float hi) { return f2bf(lo) | (f2bf(hi) << 16); }
__device__ __forceinline__ float wave_sum(float v) {
#pragma unroll
    for (int o = 1; o < 64; o <<= 1) v += __shfl_xor(v, o);
    return v;
}
struct CmId { __device__ __forceinline__ int operator()(int n) const { return n; } };
struct CmIn { __device__ __forceinline__ int operator()(int n) const {
    if (n < 1536) return n;
    if (n < 2048) return n + 8;
    if (n < 3072) { const int j = (n - 2048) >> 8, w = (n - 2048) & 255; return w < 128 ? 2056 + 128 * j + w : 3080 + 128 * j + (w - 128); }
    if (n < 3584) return 2568 + (n - 3072);
    if (n < 6656) return n + 8;
    if (n < 6664) return 1536 + (n - 6656);
    return -1; } };
struct CmGU { __device__ __forceinline__ int operator()(int n) const { const int j = n >> 8, w = n & 255; return w < 128 ? 128 * j + w : FFH + 128 * j + (w - 128); } };
template <class CM> __device__ __forceinline__ void tr_item(const float* W, int ldw, int K, bf16* WT, LAS float* scr, int item, int nblk, int lane, const float* kscale, CM cm) {
    const int kb = item / nblk, nb = item % nblk, k0 = 64 * kb, n0 = 32 * nb;
    const int sc = cm(n0 + (lane & 31));
#pragma unroll 8
    for (int i = 0; i < 32; ++i) { const int kk = 2 * i + (lane >> 5); float v = 0.f; if (sc >= 0) v = W[(size_t)(k0 + kk) * ldw + sc]; if (kscale) v *= kscale[k0 + kk]; scr[kk * 33 + (lane & 31)] = v; }
    LDS_WAIT(); asm volatile("" ::: "memory");
    const int c = lane & 7;
#pragma unroll
    for (int j = 0; j < 4; ++j) { const int n = (lane >> 3) + 8 * j; const LAS float* s = scr + (8 * c) * 33 + n;
        v4u o; o.x = pk2(s[0 * 33], s[1 * 33]); o.y = pk2(s[2 * 33], s[3 * 33]); o.z = pk2(s[4 * 33], s[5 * 33]); o.w = pk2(s[6 * 33], s[7 * 33]);
        *(GAS v4u*)(WT + (size_t)(n0 + n) * K + k0 + 8 * c) = o; }
    LDS_WAIT(); asm volatile("" ::: "memory");
}
__device__ __forceinline__ void wb_item(const float* pool_w, const float* pscale, const float* wpp, bf16* WBt, int item, int lane) {
    const int nb = (item >> 3) & 15, c8 = (item & 7) + 8 * (item >> 7), n = 64 * nb + lane, c0 = 8 * c8, g = c0 >> 7, cl = c0 & 127;
    float a0 = 0.f, a1 = 0.f, a2 = 0.f, a3 = 0.f, a4 = 0.f, a5 = 0.f, a6 = 0.f, a7 = 0.f;
    const float* pw = pool_w + ((size_t)g * 128 + cl) * 128;
    for (int d = 0; d < 128; ++d) { const float w = wpp[(size_t)(g * 128 + d) * 1024 + n] * pscale[g * 128 + d];
        a0 += pw[0 * 128 + d] * w; a1 += pw[1 * 128 + d] * w; a2 += pw[2 * 128 + d] * w; a3 += pw[3 * 128 + d] * w;
        a4 += pw[4 * 128 + d] * w; a5 += pw[5 * 128 + d] * w; a6 += pw[6 * 128 + d] * w; a7 += pw[7 * 128 + d] * w; }
    v4u o; o.x = pk2(a0, a1); o.y = pk2(a2, a3); o.z = pk2(a4, a5); o.w = pk2(a6, a7);
    *(GAS v4u*)(WBt + (size_t)n * 512 + c0) = o;
}

struct Args { const float* in[16]; float* out; unsigned char* ws; int ph_lo, ph_hi; };
#define GRID_SEAM() do { asm volatile("s_waitcnt vmcnt(0)" ::: "memory"); grid.sync(); __builtin_amdgcn_fence(__ATOMIC_ACQUIRE, "agent"); asm volatile("s_waitcnt vmcnt(0)" ::: "memory"); } while (0)

__device__ __forceinline__ void convert_weights(const Args& a, int l, int which, LAS float* scr, int gw, int NGW, int lane) {
    unsigned char* ws = a.ws;
    bf16* WIN = (bf16*)(ws + WS_WIN); unsigned char* wl = ws + WS_WL + (size_t)l * WL_STRIDE;
    constexpr int I_IN = 16 * (NIN / 32), I_A = 8 * 32, I_OUT = 16 * 32, I_GU = 16 * (2 * FFH / 32), I_DN = (FFH / 64) * 32, I_WB = 1024;
    if (which & 1) for (int it = gw; it < I_IN; it += NGW) tr_item(a.in[2] + (size_t)l * 1024 * NINSRC, NINSRC, 1024, WIN, scr, it, NIN / 32, lane, a.in[1] + l * 1024, CmIn());
    if (which & 2) {
        for (int it = gw; it < I_A + I_A + I_OUT + I_GU + I_DN + I_WB; it += NGW) {
            int r = it;
            if (r < I_A) { tr_item(a.in[5] + (size_t)l * 512 * 1024, 1024, 512, (bf16*)(wl + WL_A), scr, r, 32, lane, nullptr, CmId()); continue; } r -= I_A;
            if (r < I_A) { tr_item(a.in[10] + (size_t)l * 512 * 1024, 1024, 512, (bf16*)(wl + WL_C), scr, r, 32, lane, nullptr, CmId()); continue; } r -= I_A;
            if (r < I_OUT) { tr_item(a.in[11] + (size_t)l * 1024 * 1024, 1024, 1024, (bf16*)(wl + WL_OUT), scr, r, 32, lane, nullptr, CmId()); continue; } r -= I_OUT;
            if (r < I_GU) { tr_item(a.in[13] + (size_t)l * 1024 * 2 * FFH, 2 * FFH, 1024, (bf16*)(wl + WL_GU), scr, r, 2 * FFH / 32, lane, a.in[12] + l * 1024, CmGU()); continue; } r -= I_GU;
            if (r < I_DN) { tr_item(a.in[14] + (size_t)l * FFH * 1024, 1024, FFH, (bf16*)(wl + WL_DN), scr, r, 32, lane, nullptr, CmId()); continue; } r -= I_DN;
            wb_item(a.in[6] + (size_t)l * 4 * 128 * 128, a.in[7] + l * 512, a.in[8] + (size_t)l * 512 * 1024, (bf16*)(wl + WL_B), r, lane);
        }
    }
}

__device__ __forceinline__ void x_to_bf16(const Args& a, int gw, int NGW, int lane) {
    const float* x = a.in[0]; bf16* XB = (bf16*)(a.ws + WS_XB);
    const int per = (MROWS + NGW - 1) / NGW;
    for (int m = gw * per; m < MROWS && m < (gw + 1) * per; ++m) {
        const GAS f32x4* xr = (const GAS f32x4*)(x + (size_t)m * 1024) + lane; f32x4 v[4]; float s = 0.f;
#pragma unroll
        for (int j = 0; j < 4; ++j) { v[j] = xr[64 * j]; s += (v[j].x * v[j].x + v[j].y * v[j].y) + (v[j].z * v[j].z + v[j].w * v[j].w); }
        s = wave_sum(s);
        GAS unsigned long long* o8 = (GAS unsigned long long*)(XB + (size_t)m * 1024) + lane;
#pragma unroll
        for (int j = 0; j < 4; ++j) o8[64 * j] = (unsigned long long)pk2(v[j].x, v[j].y) | ((unsigned long long)pk2(v[j].z, v[j].w) << 32);
        if (lane < 20) { const int bufi = lane >> 2, slot = lane & 3; *(GAS float*)(a.ws + WS_SSQ + (size_t)bufi * KiB512 + ((size_t)slot * MROWS + m) * 4) = (lane == 0) ? s : 0.f; }
    }
}

__device__ __forceinline__ void unpk8(const v4u w, float (&f)[8]) {
    f[0] = __uint_as_float(w.x << 16); f[1] = __uint_as_float(w.x & 0xffff0000u); f[2] = __uint_as_float(w.y << 16); f[3] = __uint_as_float(w.y & 0xffff0000u);
    f[4] = __uint_as_float(w.z << 16); f[5] = __uint_as_float(w.z & 0xffff0000u); f[6] = __uint_as_float(w.w << 16); f[7] = __uint_as_float(w.w & 0xffff0000u); }
__device__ __forceinline__ v4u pk8(const float (&f)[8]) { v4u o; o.x = pk2(f[0], f[1]); o.y = pk2(f[2], f[3]); o.z = pk2(f[4], f[5]); o.w = pk2(f[6], f[7]); return o; }

__device__ __forceinline__ void pool_conv_phase(const Args& a, int l, int vcu, int G, int tid) {
    const bf16* U = (const bf16*)(a.ws + WS_U); const bf16* Z = (const bf16*)(a.ws + WS_Z); const bf16* CB = (const bf16*)(a.ws + WS_CB);
    bf16* Dp = (bf16*)(a.ws + WS_D); bf16* YC = (bf16*)(a.ws + WS_YC);
    const float* cw = a.in[9] + (size_t)l * 3 * 512;
    const int cgp = tid & 63, seg = tid >> 6, ch = 8 * cgp, w = 2 << (cgp >> 4);
    float w0[8], w1[8], w2[8];
#pragma unroll
    for (int j = 0; j < 8; ++j) { w0[j] = cw[ch + j]; w1[j] = cw[512 + ch + j]; w2[j] = cw[1024 + ch + j]; }
    for (int chunk = vcu; chunk < MROWS / 128; chunk += G) {
        const int first = chunk * 128 + seg * 16, tb = first & (SEQ - 1);
        { float sum[8], uc[8], t8[8];
#pragma unroll
          for (int j = 0; j < 8; ++j) sum[j] = 0.f;
          for (int j = 1; j < w; ++j) if (tb - j >= 0) { unpk8(*(const GAS v4u*)(U + (size_t)(first - j) * 512 + ch), t8);
#pragma unroll
              for (int q = 0; q < 8; ++q) sum[q] += t8[q]; }
          for (int i = 0; i < 16; ++i) { const int row = first + i, t = tb + i;
              unpk8(*(const GAS v4u*)(U + (size_t)row * 512 + ch), uc);
              const float inv = 1.0f / (float)((t + 1) < w ? (t + 1) : w);
#pragma unroll
              for (int q = 0; q < 8; ++q) { sum[q] += uc[q]; t8[q] = sum[q] * inv - uc[q]; }
              *(GAS v4u*)(Dp + (size_t)row * 512 + ch) = pk8(t8);
              if (t - w + 1 >= 0) { unpk8(*(const GAS v4u*)(U + (size_t)(row - w + 1) * 512 + ch), t8);
#pragma unroll
                  for (int q = 0; q < 8; ++q) sum[q] -= t8[q]; } } }
        { float z2[8], z1[8], z0[8], cb[8], y[8];
#pragma unroll
          for (int q = 0; q < 8; ++q) { z2[q] = 0.f; z1[q] = 0.f; }
          if (tb >= 2) unpk8(*(const GAS v4u*)(Z + (size_t)(first - 2) * 512 + ch), z2);
          if (tb >= 1) unpk8(*(const GAS v4u*)(Z + (size_t)(first - 1) * 512 + ch), z1);
          for (int i = 0; i < 16; ++i) { const int row = first + i;
              unpk8(*(const GAS v4u*)(Z + (size_t)row * 512 + ch), z0); unpk8(*(const GAS v4u*)(CB + (size_t)row * 512 + ch), cb);
#pragma unroll
              for (int q = 0; q < 8; ++q) { y[q] = cb[q] * (w0[q] * z2[q] + w1[q] * z1[q] + w2[q] * z0[q]); z2[q] = z1[q]; z1[q] = z0[q]; }
              *(GAS v4u*)(YC + (size_t)row * 512 + ch) = pk8(y); } }
    }
}

__device__ __forceinline__ void final_norm_phase(const Args& a, int gw, int NGW, int lane) {
    float* out = a.out; const float* ssq = (const float*)(a.ws + WS_SSQ + 4 * KiB512); const float* gn = a.in[15];
    f32x4 g4[4];
#pragma unroll
    for (int j = 0; j < 4; ++j) g4[j] = *((const GAS f32x4*)gn + lane + 64 * j);
    for (int m = gw; m < MROWS; m += NGW) {
        const float rs = __builtin_amdgcn_rsqf(((ssq[m] + ssq[MROWS + m]) + (ssq[2 * MROWS + m] + ssq[3 * MROWS + m])) * (1.0f / 1024.0f) + 1e-6f);
        GAS f32x4* xr = (GAS f32x4*)(out + (size_t)m * 1024) + lane;
#pragma unroll
        for (int j = 0; j < 4; ++j) { const f32x4 v = xr[64 * j]; xr[64 * j] = v * rs * g4[j]; }
    }
}

__global__ void __launch_bounds__(NWAVES * 64, 2) fwd_megakernel(Args a) {
    extern __shared__ __attribute__((aligned(16))) unsigned char lds[];
    cg::grid_group grid = cg::this_grid();
    LAS unsigned char* ldsl = (LAS unsigned char*)lds;
    const int G = gridDim.x, bx = blockIdx.x, vcu = (G % 8 == 0) ? (bx % 8) * (G / 8) + bx / 8 : bx, NGW = G * NWAVES;
#define FRESH_IDS() int tid_ = threadIdx.x; asm volatile("" : "+v"(tid_)); const int tid = tid_, lane = tid & 63, wave = __builtin_amdgcn_readfirstlane(tid >> 6), gw = vcu * NWAVES + wave; LAS float* scr = (LAS float*)(ldsl + wave * 16384); (void)tid; (void)lane; (void)gw; (void)scr
    unsigned char* ws = a.ws;
    bf16* XB = (bf16*)(ws + WS_XB); bf16* WIN = (bf16*)(ws + WS_WIN);

#define IN(k) (a.ph_lo <= (k) && (k) < a.ph_hi)
#define BOTH(k) (IN(k) && IN((k) + 1))
#ifndef NO_PRO
    if (IN(0)) { FRESH_IDS();
    convert_weights(a, 0, 3, scr, gw, NGW, lane);
    convert_weights(a, 1, 2, scr, gw, NGW, lane);
    x_to_bf16(a, gw, NGW, lane); }
#endif
    if (BOTH(0)) GRID_SEAM();

#pragma unroll 1
    for (int l = 0; l < DEPTH; ++l) {
        unsigned char* wl = ws + WS_WL + (size_t)l * WL_STRIDE; const int p0 = 1 + 6 * l;
        const float* ssq_in = (const float*)(ws + WS_SSQ + (size_t)(2 * l) * KiB512);
        float* ssq_mid = (float*)(ws + WS_SSQ + (size_t)(2 * l + 1) * KiB512);
        float* ssq_end = (float*)(ws + WS_SSQ + (size_t)(2 * l + 2) * KiB512);
#ifndef NO_IN
        if (IN(p0)) { pg8::Gemm g{XB, XB, XB, WIN, WIN, WIN, MROWS, NIN, 1024}; pg8::StaticOrder S; S.init(MROWS, NIN, G, bx);
          pg8::EpiIn E{ssq_in, a.in[4] + (size_t)l * 3072, (bf16*)(ws + WS_QA), (bf16*)(ws + WS_K), (bf16*)(ws + WS_V), (bf16*)(ws + WS_U), (bf16*)(ws + WS_Z), (bf16*)(ws + WS_CB), (bf16*)(ws + WS_G),
                       (float*)(ws + WS_FLOG), attn_body::C2};
          pg8::gemm_phase<pg8::EpiIn, pg8::StaticOrder, true, true>(ldsl, g, S, E); }
#endif
        if (BOTH(p0 + 0)) GRID_SEAM();
#ifndef NO_PRO
        if (l == 0 && IN(p0 + 1)) { FRESH_IDS(); convert_weights(a, 1, 1, scr, gw, NGW, lane); __syncthreads(); }
#endif
#ifndef NO_ATT
        if (IN(p0 + 1)) { const attn_body::AttnTensors AT{(const attn_body::bf16*)(ws + WS_QA), (const attn_body::bf16*)(ws + WS_K), (const attn_body::bf16*)(ws + WS_V), (attn_body::bf16*)(ws + WS_QA),
                                          (const float*)(ws + WS_FLOG), a.in[3] + l * NHEADS};
          const attn_body::StaticOrder S(G, vcu);
          attn_body::attn_phase<attn_body::StaticOrder>((char*)lds, AT, S); }
#endif
#ifndef NO_PC
        if (IN(p0 + 1)) { FRESH_IDS(); pool_conv_phase(a, l, vcu, G, tid); }
#endif
        if (BOTH(p0 + 1)) GRID_SEAM();
#ifndef NO_MIX
        if (IN(p0 + 2)) { pg8::Gemm g{(const bf16*)(ws + WS_QA), (const bf16*)(ws + WS_D), (const bf16*)(ws + WS_YC), (const bf16*)(wl + WL_A), (const bf16*)(wl + WL_B), (const bf16*)(wl + WL_C), MROWS, 1024, 512};
          pg8::StaticOrder3 S; S.init(MROWS, 1024, G, bx);
          pg8::EpiMix E{(const bf16*)(ws + WS_G), (bf16*)(ws + WS_MIX), (bf16*)(ws + WS_U)};
          pg8::gemm_phase<pg8::EpiMix, pg8::StaticOrder3, true, true>(ldsl, g, S, E); }
#endif
        if (BOTH(p0 + 2)) GRID_SEAM();
#ifndef NO_OUT
        if (IN(p0 + 3)) { const bf16* A = (const bf16*)(ws + WS_MIX); const bf16* B = (const bf16*)(wl + WL_OUT);
          pg8::Gemm g{A, A, A, B, B, B, MROWS, 1024, 1024}; pg8::StaticOrder S; S.init(MROWS, 1024, G, bx);
          pg8::EpiResid E{l == 0 ? a.in[0] : a.out, a.out, XB, ssq_mid};
          pg8::gemm_phase<pg8::EpiResid, pg8::StaticOrder, true, true>(ldsl, g, S, E); }
#endif
        if (BOTH(p0 + 3)) GRID_SEAM();
#ifndef NO_GU
        if (IN(p0 + 4)) { const bf16* B = (const bf16*)(wl + WL_GU);
          pg8::Gemm g{XB, XB, XB, B, B, B, MROWS, 2 * FFH, 1024}; pg8::StaticOrder S; S.init(MROWS, 2 * FFH, G, bx);
          pg8::EpiSwiglu E{ssq_mid, (bf16*)(ws + WS_ACT)};
          pg8::gemm_phase<pg8::EpiSwiglu, pg8::StaticOrder, true, true>(ldsl, g, S, E); }
#endif
        if (BOTH(p0 + 4)) GRID_SEAM();
#ifndef NO_DN
        if (IN(p0 + 5)) { const bf16* A = (const bf16*)(ws + WS_ACT); const bf16* B = (const bf16*)(wl + WL_DN);
          pg8::Gemm g{A, A, A, B, B, B, MROWS, 1024, FFH}; pg8::StaticOrder S; S.init(MROWS, 1024, G, bx);
          pg8::EpiResid E{a.out, a.out, XB, ssq_end};
          pg8::gemm_phase<pg8::EpiResid, pg8::StaticOrder, true, true>(ldsl, g, S, E); }
#endif
        if (BOTH(p0 + 5)) GRID_SEAM();
    }
    if (IN(13)) { FRESH_IDS(); final_norm_phase(a, gw, NGW, lane); }
}

template <bool F32> __global__ void dump_fold(const void* buf, int pitch, int ncols, float scale, float* out, int colofs, int W) {
    const long idx = (long)blockIdx.x * blockDim.x + threadIdx.x; if (idx >= (long)MROWS * W) return;
    const int row = (int)(idx / W), j = (int)(idx % W); float v = 0.f;
    for (int c = j; c < ncols; c += W) v += F32 ? ((const float*)buf)[(size_t)row * pitch + c] : __uint_as_float((unsigned)((const bf16*)buf)[(size_t)row * pitch + c] << 16);
    out[(size_t)row * 1024 + colofs + j] = scale * v;
}
__global__ void ws_too_small_fill(float* out, int n) { for (int i = blockIdx.x * blockDim.x + threadIdx.x; i < n; i += gridDim.x * blockDim.x) out[i] = 7777.f; }

extern "C" void kernel_launch(void* const* d_in, const int* in_sizes, int n_in, void* d_out, int out_size, void* d_ws, size_t ws_size, hipStream_t stream) {
    static int grid = 0;
    if (grid == 0) {
        int dev = 0, cus = 0, per_cu = 0;
        if (hipGetDevice(&dev) != hipSuccess || hipDeviceGetAttribute(&cus, hipDeviceAttributeMultiprocessorCount, dev) != hipSuccess) { fprintf(stderr, "kernel_launch: device query failed\n"); grid = -1; return; }
        if (hipFuncSetAttribute((const void*)fwd_megakernel, hipFuncAttributeMaxDynamicSharedMemorySize, LDS_BYTES) != hipSuccess) { fprintf(stderr, "kernel_launch: hipFuncSetAttribute failed\n"); grid = -1; return; }
        if (hipOccupancyMaxActiveBlocksPerMultiprocessor(&per_cu, (const void*)fwd_megakernel, NWAVES * 64, LDS_BYTES) != hipSuccess || per_cu < 1) per_cu = 1;
        (void)hipGetLastError();
        grid = cus;
    }
    if (grid < 0) return;
    if (n_in != 16 || out_size != MROWS * DMODEL || ws_size < WS_END) { ws_too_small_fill<<<256, 256, 0, stream>>>((float*)d_out, out_size); return; }
    Args a{};
    for (int i = 0; i < 16; ++i) a.in[i] = (const float*)d_in[i];
    a.out = (float*)d_out; a.ws = (unsigned char*)d_ws;
#ifndef MK_LAUNCHES
#define MK_LAUNCHES 1
#endif
#if MK_LAUNCHES >= 90
    { float* real_out = (float*)d_out; unsigned char* ws = (unsigned char*)d_ws; a.out = (float*)(ws + WS_G);
      const int LASTP = (MK_LAUNCHES >= 97) ? 1 : MK_LAUNCHES - 90;
      for (int p = 0; p <= LASTP; ++p) { a.ph_lo = p; a.ph_hi = p + 1; hipLaunchKernelGGL(fwd_megakernel, dim3(grid), dim3(NWAVES * 64), LDS_BYTES, stream, a); }
#define DUMP(F32, ptr, pitch, ncols, colofs, W) dump_fold<F32><<<(MROWS * (W) + 255) / 256, 256, 0, stream>>>(ws + (ptr), pitch, ncols, 1.f, real_out, colofs, W)
      if (LASTP == 0) { DUMP(false, WS_XB, 1024, 1024, 0, 512); DUMP(false, WS_WIN, 912, 912, 512, 512); }
      if (MK_LAUNCHES == 91) { DUMP(false, WS_QA, 3072, 3072, 0, 512); DUMP(false, WS_G, 3072, 3072, 512, 504); DUMP(true, WS_FLOG, 8, 8, 1016, 8); }
      if (MK_LAUNCHES == 97) { DUMP(false, WS_G, 3072, 3072, 0, 1024); }
      if (MK_LAUNCHES == 98) { DUMP(false, WS_QA, 3072, 3072, 0, 1016); DUMP(true, WS_FLOG, 8, 8, 1016, 8); }
      if (LASTP == 2) { DUMP(false, WS_QA, 512, 512, 0, 512); DUMP(false, WS_D, 512, 512, 512, 256); DUMP(false, WS_YC, 512, 512, 768, 256); }
      if (LASTP == 3) { DUMP(false, WS_MIX, 1024, 1024, 0, 1024); }
      if (LASTP == 4) { DUMP(true, WS_G, 1024, 1024, 0, 1024); }
      if (LASTP == 5) { DUMP(false, WS_ACT, 2816, 2816, 0, 1024); }
    }
#elif MK_LAUNCHES == 1
    a.ph_lo = 0; a.ph_hi = 14;
    void* args[] = {&a};
    hipError_t e = hipLaunchCooperativeKernel((const void*)fwd_megakernel, dim3(grid), dim3(NWAVES * 64), args, LDS_BYTES, stream);
    if (e != hipSuccess) fprintf(stderr, "kernel_launch: cooperative launch failed: %s (grid %d)\n", hipGetErrorString(e), grid);
#else
    for (int p = 0; p < 14; ++p) { a.ph_lo = p; a.ph_hi = p + 1; hipLaunchKernelGGL(fwd_megakernel, dim3(grid), dim3(NWAVES * 64), LDS_BYTES, stream, a); }
#endif
}
```

```cpp
#define MK_LAUNCHES 1
#include <hip/hip_runtime.h>
#include <hip/hip_cooperative_groups.h>
#include <cstdio>
#include <cstdint>
namespace pg8 {
#define PG8_LAS __attribute__((address_space(3)))
typedef unsigned short bf16_t;
typedef short bf16x8 __attribute__((ext_vector_type(8)));
typedef float f32x4 __attribute__((ext_vector_type(4)));
typedef unsigned u32x4 __attribute__((ext_vector_type(4)));
constexpr int BM = 256, BK = 64, HALF = 128, HTB = HALF * BK * 2  , STAGE_BYTES = 8 * HTB, NXCD = 8, WGM = 8;

__host__ __device__ __forceinline__ int lds_byte(int r, int c) { const int st = (r >> 4) * 2 + (c >> 5), rr = r & 15, cc = c & 31, ob = rr * 64 + cc * 2; return st * 1024 + (ob ^ (((ob >> 9) & 1) << 5)); }
__host__ __device__ __forceinline__ void stage_rc(int b, int& R, int& C) { const int st = b / 1024, sb = b % 1024, swz = sb ^ (((sb >> 9) & 1) << 5); R = (st >> 1) * 16 + swz / 64; C = (st & 1) * 32 + (swz % 64) / 2; }
__host__ __device__ __forceinline__ int perm32(int rho) { const int n = rho >> 4, i = rho & 15; return 8 * (i >> 2) + 4 * n + (i & 3); }

struct Unit { int pm, pn, sub; };
struct Gemm { const bf16_t *A0, *A1, *A2, *B0, *B1, *B2; int M, N, K; };

struct StaticOrder {
    int nM, nN, nwg, G, c;
    __host__ __device__ void init(int M, int N, int G_, int c_) { nM = M / BM; nN = N / BM; nwg = nM * nN; G = G_; c = c_; }
    __host__ __device__ bool next(int i, Unit& u) const {
        const long L = (long)i * G + c; if (L >= nwg) return false;
        int wgid = (int)L; { const int q = nwg / NXCD, r = nwg % NXCD, xcd = wgid % NXCD, off = wgid / NXCD; wgid = (xcd < r ? xcd * (q + 1) : r * (q + 1) + (xcd - r) * q) + off; }
        const int nig = WGM * nN, gid = wgid / nig, fm = gid * WGM, gsz = (nM - fm) < WGM ? (nM - fm) : WGM;
        u.pm = fm + ((wgid % nig) % gsz); u.pn = (wgid % nig) / gsz; u.sub = 0; return true;
    }
    __device__ __forceinline__ void a_ready(const Unit&) const {}
    __device__ __forceinline__ void done(const Unit&) const {}
};

struct StaticOrder3 {
    StaticOrder b;
    __host__ __device__ void init(int M, int N, int G_, int c_) { b.init(M, N, G_, c_); }
    __host__ __device__ bool next(int i, Unit& u) const { if (!b.next(i / 3, u)) return false; u.sub = i % 3; return true; }
    __device__ __forceinline__ void a_ready(const Unit&) const {}
    __device__ __forceinline__ void done(const Unit&) const {}
};
typedef float f32x2c_t __attribute__((ext_vector_type(2))); typedef __bf16 bf16x2c_t __attribute__((ext_vector_type(2)));
__device__ __forceinline__ unsigned cvt_pk_bf16(float lo, float hi) { const f32x2c_t v = {lo, hi}; const bf16x2c_t b = __builtin_convertvector(v, bf16x2c_t); return __builtin_bit_cast(unsigned, b); }
typedef float f32x2 __attribute__((ext_vector_type(2)));
__device__ __forceinline__ float rstd_of(const float* ssq, int row) { const float s0 = ssq[row], s1 = ssq[32768 + row], s2 = ssq[2 * 32768 + row], s3 = ssq[3 * 32768 + row]; return __builtin_amdgcn_rsqf(((s0 + s1) + (s2 + s3)) * (1.0f / 1024.0f) + 1e-6f); }
__device__ __forceinline__ float sigm(float v) { return __builtin_amdgcn_rcpf(1.0f + __builtin_amdgcn_exp2f(-1.4426950408889634f * v)); }
__device__ __forceinline__ u32x4 pack8(const f32x4 a, const f32x4 b) { u32x4 w; w.x = cvt_pk_bf16(a[0], a[1]); w.y = cvt_pk_bf16(a[2], a[3]); w.z = cvt_pk_bf16(b[0], b[1]); w.w = cvt_pk_bf16(b[2], b[3]); return w; }
__device__ __forceinline__ void unpack8(const u32x4 w, f32x4& a, f32x4& b) {
    a[0] = __uint_as_float(w.x << 16); a[1] = __uint_as_float(w.x & 0xffff0000u); a[2] = __uint_as_float(w.y << 16); a[3] = __uint_as_float(w.y & 0xffff0000u);
    b[0] = __uint_as_float(w.z << 16); b[1] = __uint_as_float(w.z & 0xffff0000u); b[2] = __uint_as_float(w.w << 16); b[3] = __uint_as_float(w.w & 0xffff0000u); }

struct EpiIn {
    static constexpr bool PERM = true, AFTER_DRAIN = false;
    const float* ssq; const float* bgate; bf16_t *Q, *K, *V, *U, *Z, *CB, *G; float* FLOG; float qscale;
    __device__ __forceinline__ void operator()(const f32x4 (&acc)[2][2][4][2], const Unit& u, int wr, int wc, int fr, int fq) const {
        const int row0 = u.pm * BM + wr * 64 + fr, pn = u.pn, cw = wc * 32 + 8 * fq;
        if (pn < 8 || pn == 12 || pn == 13) {
            bf16_t* base; int colt; float sc = 1.f;
            if (pn < 2) { base = Q; colt = pn * 256; sc = qscale; } else if (pn < 4) { base = K; colt = (pn - 2) * 256; } else if (pn < 6) { base = V; colt = (pn - 4) * 256; }
            else if (pn < 8) { base = U; colt = (pn - 6) * 256; } else { base = CB; colt = (pn - 12) * 256; }
#pragma unroll
            for (int ai = 0; ai < 2; ++ai)
#pragma unroll
                for (int m = 0; m < 4; ++m) { const int row = row0 + ai * HALF + m * 16; const float rs = rstd_of(ssq, row) * sc; bf16_t* rowp = base + (size_t)row * 512 + colt + cw;
#pragma unroll
                    for (int bj = 0; bj < 2; ++bj) *(u32x4*)(rowp + bj * HALF) = pack8(acc[ai][bj][m][0] * rs, acc[ai][bj][m][1] * rs); }
        } else if (pn < 12) {
            const int colz = (pn - 8) * 128 + cw;
#pragma unroll
            for (int ai = 0; ai < 2; ++ai)
#pragma unroll
                for (int m = 0; m < 4; ++m) { const int row = row0 + ai * HALF + m * 16; const float rs = rstd_of(ssq, row), rs2 = rs * rs;
                    *(u32x4*)(Z + (size_t)row * 512 + colz) = pack8(acc[ai][0][m][0] * acc[ai][1][m][0] * rs2, acc[ai][0][m][1] * acc[ai][1][m][1] * rs2); }
        } else if (pn < 26) {
            const int colg = (pn - 14) * 256 + cw;
            f32x4 bv[2][2];
#pragma unroll
            for (int bj = 0; bj < 2; ++bj)
#pragma unroll
                for (int n = 0; n < 2; ++n) bv[bj][n] = *(const f32x4*)(bgate + colg + bj * HALF + 4 * n);
#pragma unroll
            for (int ai = 0; ai < 2; ++ai)
#pragma unroll
                for (int m = 0; m < 4; ++m) { const int row = row0 + ai * HALF + m * 16; const float rs = rstd_of(ssq, row); bf16_t* rowp = G + (size_t)row * 3072 + colg;
#pragma unroll
                    for (int bj = 0; bj < 2; ++bj) { f32x4 v0 = acc[ai][bj][m][0] * rs + bv[bj][0], v1 = acc[ai][bj][m][1] * rs + bv[bj][1];
#pragma unroll
                        for (int i = 0; i < 4; ++i) { v0[i] = sigm(v0[i]); v1[i] = sigm(v1[i]); }
                        *(u32x4*)(rowp + bj * HALF) = pack8(v0, v1); } }
        } else {
            if (wc == 0 && fq == 0) {
#pragma unroll
                for (int ai = 0; ai < 2; ++ai)
#pragma unroll
                    for (int m = 0; m < 4; ++m) { const int row = row0 + ai * HALF + m * 16; const float rs = rstd_of(ssq, row);
                        *(f32x4*)(FLOG + (size_t)row * 8) = acc[ai][0][m][0] * rs; *(f32x4*)(FLOG + (size_t)row * 8 + 4) = acc[ai][0][m][1] * rs; }
            }
        }
    }
};

struct EpiResid {
    static constexpr bool PERM = true, AFTER_DRAIN = false;
    bf16_t* xb; float* ssq;
    __device__ __forceinline__ void operator()(const f32x4 (&acc)[2][2][4][2], const Unit& u, int wr, int wc, int fr, int fq) const {
        const int row0 = u.pm * BM + wr * 64 + fr, col0 = u.pn * BM + wc * 32 + 8 * fq;
#pragma unroll
        for (int ai = 0; ai < 2; ++ai)
#pragma unroll
            for (int m = 0; m < 4; ++m) { const int row = row0 + ai * HALF + m * 16; bf16_t* p = xb + (size_t)row * 1024 + col0; float ss = 0.f;
#pragma unroll
                for (int bj = 0; bj < 2; ++bj) { f32x4 a, b; unpack8(*(const u32x4*)(p + bj * HALF), a, b);
                    a = a + acc[ai][bj][m][0]; b = b + acc[ai][bj][m][1];
                    ss += ((a[0] * a[0] + a[1] * a[1]) + (a[2] * a[2] + a[3] * a[3])) + ((b[0] * b[0] + b[1] * b[1]) + (b[2] * b[2] + b[3] * b[3]));
                    *(u32x4*)(p + bj * HALF) = pack8(a, b); }
                ss += __shfl_xor(ss, 16); ss += __shfl_xor(ss, 32);
                if (fq == 0) atomicAdd(ssq + (size_t)u.pn * 32768 + row, ss); }
    }
};

__device__ __forceinline__ u32x4 ld16_sc1(const bf16_t* p) {
    const unsigned long long* q = (const unsigned long long*)p;
    const unsigned long long lo = __hip_atomic_load(q, __ATOMIC_RELAXED, __HIP_MEMORY_SCOPE_AGENT), hi = __hip_atomic_load(q + 1, __ATOMIC_RELAXED, __HIP_MEMORY_SCOPE_AGENT);
    u32x4 w; w.x = (unsigned)lo; w.y = (unsigned)(lo >> 32); w.z = (unsigned)hi; w.w = (unsigned)(hi >> 32); return w; }
struct EpiMix {
    static constexpr bool PERM = true, AFTER_DRAIN = false;
    const bf16_t* G; bf16_t* MIX; bf16_t* P1;
    __device__ __forceinline__ void operator()(const f32x4 (&acc)[2][2][4][2], const Unit& u, int wr, int wc, int fr, int fq) const {
        const int row0 = u.pm * BM + wr * 64 + fr, col0 = u.pn * BM + wc * 32 + 8 * fq, sub = u.sub;
#pragma unroll
        for (int ai = 0; ai < 2; ++ai)
#pragma unroll
            for (int m = 0; m < 4; ++m) { const int row = row0 + ai * HALF + m * 16;
#pragma unroll
                for (int bj = 0; bj < 2; ++bj) { const int c = col0 + bj * HALF; f32x4 g0, g1; unpack8(*(const u32x4*)(G + (size_t)row * 3072 + sub * 1024 + c), g0, g1);
                    f32x4 v0 = acc[ai][bj][m][0] * g0, v1 = acc[ai][bj][m][1] * g1; const size_t off = (size_t)row * 1024 + c;
                    if (sub == 2) { f32x4 p0, p1; unpack8(*(const u32x4*)(MIX + off), p0, p1); v0 = v0 + p0; v1 = v1 + p1; unpack8(*(const u32x4*)(P1 + off), p0, p1); v0 = v0 + p0; v1 = v1 + p1; }
                    *(u32x4*)((sub == 1 ? P1 : MIX) + off) = pack8(v0, v1); } }
    }
};

struct EpiSwiglu {
    static constexpr bool PERM = true, AFTER_DRAIN = false;
    const float* ssq; bf16_t* ACT;
    __device__ __forceinline__ void operator()(const f32x4 (&acc)[2][2][4][2], const Unit& u, int wr, int wc, int fr, int fq) const {
        const int row0 = u.pm * BM + wr * 64 + fr, colh = u.pn * 128 + wc * 32 + 8 * fq;
#pragma unroll
        for (int ai = 0; ai < 2; ++ai)
#pragma unroll
            for (int m = 0; m < 4; ++m) { const int row = row0 + ai * HALF + m * 16; const float rs = rstd_of(ssq, row);
                f32x4 h[2];
#pragma unroll
                for (int n = 0; n < 2; ++n) { const f32x4 a = acc[ai][0][m][n] * rs, b = acc[ai][1][m][n] * rs;
#pragma unroll
                    for (int i = 0; i < 4; ++i) h[n][i] = a[i] * sigm(a[i]) * b[i]; }
                *(u32x4*)(ACT + (size_t)row * 2816 + colh) = pack8(h[0], h[1]); }
    }
};

template <class Epi, class Sched, bool ALIGN_EPI = false, bool SP2 = false>
__device__ __forceinline__ void gemm_phase(PG8_LAS unsigned char* lds, const Gemm g, const Sched& S, const Epi& E) {
    int tid_ = threadIdx.x; asm volatile("" : "+v"(tid_));
    const int tid = tid_, wid = __builtin_amdgcn_readfirstlane(tid >> 6), lane = tid & 63, wr = wid >> 2, wc = wid & 3, fr = lane & 15, fq = lane >> 4;
    const int K = g.K, nt = K / BK;
    unsigned voffA[2], voffB[2];
#pragma unroll
    for (int i = 0; i < 2; ++i) { int R, C; stage_rc(tid * 16 + i * 8192, R, C); const int Rb = Epi::PERM ? ((R & ~31) + perm32(R & 31)) : R;
        voffA[i] = (unsigned)(R * K + C) * 2u; voffB[i] = (unsigned)(Rb * K + C) * 2u; }
    const size_t kstep = (size_t)(BK * 2);
    const size_t hstep = (size_t)HALF * K * 2;
    const size_t tstep = 2 * hstep;
    const unsigned ldsw = (unsigned)wid * 1024u;
    const int aoff = lds_byte(wr * 64 + fr, fq * 8), boff = lds_byte(wc * 32 + fr, fq * 8);
#define PG8_SELA(s) ((const char*)((s) == 0 ? g.A0 : ((s) == 1 ? g.A1 : g.A2)))
#define PG8_SELB(s) ((const char*)((s) == 0 ? g.B0 : ((s) == 1 ? g.B1 : g.B2)))
#define PG8_SA(b, h) (((b) * 2 + (h)) * HTB)
#define PG8_SB(b, h) ((4 + (b) * 2 + (h)) * HTB)
#define PG8_STAGE(bufoff, gbase, voff) do { _Pragma("unroll") for (int _i = 0; _i < 2; ++_i) \
        __builtin_amdgcn_global_load_lds((const unsigned*)((const char*)(gbase) + (voff)[_i]), (PG8_LAS unsigned*)(lds + (bufoff) + ldsw + _i * 8192), 16, 0, 0); } while (0)
#define PG8_LDA(dst, b, h) do { _Pragma("unroll") for (int m = 0; m < 4; ++m) _Pragma("unroll") for (int k = 0; k < 2; ++k) dst[m][k] = *(const PG8_LAS bf16x8*)(lds + PG8_SA(b, h) + aoff + m * 2048 + k * 1024); } while (0)
#define PG8_LDB(dst, b, h) do { _Pragma("unroll") for (int n = 0; n < 2; ++n) _Pragma("unroll") for (int k = 0; k < 2; ++k) dst[n][k] = *(const PG8_LAS bf16x8*)(lds + PG8_SB(b, h) + boff + n * 2048 + k * 1024); } while (0)
#define PG8_MMA(ai, bj, At, Bt) do { __builtin_amdgcn_s_setprio(1); _Pragma("unroll") for (int m = 0; m < 4; ++m) _Pragma("unroll") for (int n = 0; n < 2; ++n) _Pragma("unroll") for (int k = 0; k < 2; ++k) \
        acc[ai][bj][m][n] = __builtin_amdgcn_mfma_f32_16x16x32_bf16(Bt[n][k], At[m][k], acc[ai][bj][m][n], 0, 0, 0); __builtin_amdgcn_s_setprio(0); } while (0)
#define PG8_WAIT_V(n) asm volatile("s_waitcnt vmcnt(" #n ")" ::: "memory")
#define PG8_WAIT_L(n) asm volatile("s_waitcnt lgkmcnt(" #n ")" ::: "memory")
#define PG8_BAR __builtin_amdgcn_s_barrier()
#define PG8_SCHED __builtin_amdgcn_sched_barrier(0)
    Unit cur, nxt; int ui = 0;
    if (!S.next(0, cur)) return;
    f32x4 acc[2][2][4][2];
#pragma unroll
    for (int a = 0; a < 2; ++a)
#pragma unroll
        for (int b = 0; b < 2; ++b)
#pragma unroll
            for (int m = 0; m < 4; ++m)
#pragma unroll
                for (int n = 0; n < 2; ++n) acc[a][b][m][n] = (f32x4){0.f, 0.f, 0.f, 0.f};
    bf16x8 At[4][2], B0[2][2], B1[2][2];
    const char* cA = PG8_SELA(cur.sub) + (size_t)cur.pm * tstep; const char* cB = PG8_SELB(cur.sub) + (size_t)cur.pn * tstep;
    S.a_ready(cur);
    if constexpr (SP2) {
        PG8_STAGE(PG8_SB(0, 0), cB, voffB); PG8_STAGE(PG8_SB(0, 1), cB + hstep, voffB); PG8_STAGE(PG8_SA(0, 0), cA, voffA); PG8_STAGE(PG8_SA(0, 1), cA + hstep, voffA);
        if (wr == 1) PG8_BAR;
        PG8_WAIT_V(2); PG8_BAR;
        PG8_STAGE(PG8_SB(1, 0), cB + kstep, voffB); PG8_STAGE(PG8_SA(1, 0), cA + kstep, voffA); PG8_STAGE(PG8_SB(1, 1), cB + hstep + kstep, voffB);
        PG8_WAIT_V(6); PG8_BAR;
    } else {
        PG8_STAGE(PG8_SB(0, 0), cB, voffB); PG8_STAGE(PG8_SA(0, 0), cA, voffA); PG8_STAGE(PG8_SB(0, 1), cB + hstep, voffB); PG8_STAGE(PG8_SA(0, 1), cA + hstep, voffA);
        if (wr == 1) PG8_BAR;
        PG8_WAIT_V(4); PG8_BAR;
        PG8_STAGE(PG8_SB(1, 0), cB + kstep, voffB); PG8_STAGE(PG8_SA(1, 0), cA + kstep, voffA); PG8_STAGE(PG8_SB(1, 1), cB + hstep + kstep, voffB);
        PG8_WAIT_V(6); PG8_BAR;
    }
    for (;;) {
        const bool has_next = S.next(ui + 1, nxt);
        const char* nA = has_next ? PG8_SELA(nxt.sub) + (size_t)nxt.pm * tstep : cA; const char* nB = has_next ? PG8_SELB(nxt.sub) + (size_t)nxt.pn * tstep : cB;
        for (int t = 0; t < nt; t += 2) {
            const bool last = (t == nt - 2);
            const char* a1 = cA + (size_t)(t + 1) * kstep;
            const char* a2 = last ? nA : cA + (size_t)(t + 2) * kstep; const char* b2 = last ? nB : cB + (size_t)(t + 2) * kstep;
            const char* a3 = a2 + kstep; const char* b3 = b2 + kstep;
            if (last && has_next) S.a_ready(nxt);
            if constexpr (SP2) {
            PG8_LDB(B0, 0, 0); PG8_LDB(B1, 0, 1); PG8_SCHED; PG8_LDA(At, 0, 0); PG8_STAGE(PG8_SA(1, 1), a1 + hstep, voffA);
            PG8_WAIT_V(8); PG8_WAIT_L(0); PG8_BAR; PG8_MMA(0, 0, At, B0); PG8_MMA(0, 1, At, B1); PG8_BAR; PG8_SCHED;
            PG8_LDA(At, 0, 1); PG8_STAGE(PG8_SB(0, 0), b2, voffB); PG8_STAGE(PG8_SB(0, 1), b2 + hstep, voffB); PG8_STAGE(PG8_SA(0, 0), a2, voffA);
            PG8_WAIT_V(8); PG8_WAIT_L(0); PG8_BAR; PG8_MMA(1, 0, At, B0); PG8_MMA(1, 1, At, B1); PG8_BAR; PG8_SCHED;
            PG8_LDB(B0, 1, 0); PG8_LDB(B1, 1, 1); PG8_SCHED; PG8_LDA(At, 1, 0); PG8_STAGE(PG8_SA(0, 1), a2 + hstep, voffA);
            PG8_WAIT_V(8); PG8_WAIT_L(0); PG8_BAR; PG8_MMA(0, 0, At, B0); PG8_MMA(0, 1, At, B1); PG8_BAR; PG8_SCHED;
            PG8_LDA(At, 1, 1); PG8_STAGE(PG8_SB(1, 0), b3, voffB); PG8_STAGE(PG8_SB(1, 1), b3 + hstep, voffB); PG8_STAGE(PG8_SA(1, 0), a3, voffA);
            PG8_WAIT_V(8); PG8_WAIT_L(0); PG8_BAR; PG8_MMA(1, 0, At, B0); PG8_MMA(1, 1, At, B1); PG8_BAR; PG8_SCHED;
            } else {
            PG8_LDB(B0, 0, 0); PG8_SCHED; PG8_LDA(At, 0, 0); PG8_STAGE(PG8_SA(1, 1), a1 + hstep, voffA);
            PG8_WAIT_L(8); PG8_BAR; PG8_WAIT_L(0); PG8_MMA(0, 0, At, B0); PG8_BAR; PG8_SCHED;
            PG8_LDB(B1, 0, 1); PG8_STAGE(PG8_SB(0, 0), b2, voffB);
            PG8_BAR; PG8_WAIT_L(0); PG8_MMA(0, 1, At, B1); PG8_BAR;
            PG8_LDA(At, 0, 1); PG8_STAGE(PG8_SA(0, 0), a2, voffA);
            PG8_BAR; PG8_WAIT_L(0); PG8_MMA(1, 0, At, B0); PG8_BAR; PG8_SCHED;
            PG8_STAGE(PG8_SB(0, 1), b2 + hstep, voffB);
            PG8_WAIT_V(6); PG8_BAR; PG8_MMA(1, 1, At, B1); PG8_BAR;
            PG8_LDB(B0, 1, 0); PG8_SCHED; PG8_LDA(At, 1, 0); PG8_STAGE(PG8_SA(0, 1), a2 + hstep, voffA);
            PG8_WAIT_L(8); PG8_BAR; PG8_WAIT_L(0); PG8_MMA(0, 0, At, B0); PG8_BAR; PG8_SCHED;
            PG8_LDB(B1, 1, 1); PG8_STAGE(PG8_SB(1, 0), b3, voffB);
            PG8_BAR; PG8_WAIT_L(0); PG8_MMA(0, 1, At, B1); PG8_BAR;
            PG8_LDA(At, 1, 1); PG8_STAGE(PG8_SA(1, 0), a3, voffA);
            PG8_BAR; PG8_WAIT_L(0); PG8_MMA(1, 0, At, B0); PG8_BAR; PG8_SCHED;
            PG8_STAGE(PG8_SB(1, 1), b3 + hstep, voffB);
            PG8_WAIT_V(6); PG8_BAR; PG8_MMA(1, 1, At, B1); PG8_BAR;
            }
        }
        if constexpr (ALIGN_EPI) { if (wr == 0) PG8_BAR; }
        if constexpr (!Epi::AFTER_DRAIN) { E(acc, cur, wr, wc, fr, fq); S.done(cur); }
        if (!has_next) break;
#pragma unroll
        for (int a = 0; a < 2; ++a)
#pragma unroll
            for (int b = 0; b < 2; ++b)
#pragma unroll
                for (int m = 0; m < 4; ++m)
#pragma unroll
                    for (int n = 0; n < 2; ++n) acc[a][b][m][n] = (f32x4){0.f, 0.f, 0.f, 0.f};
        cur = nxt; cA = nA; cB = nB; ++ui;
        if constexpr (ALIGN_EPI) { if (wr == 1) PG8_BAR; }
    }
    PG8_WAIT_V(0);
    if constexpr (!ALIGN_EPI) { if (wr == 0) PG8_BAR; }
    PG8_BAR;
    if constexpr (Epi::AFTER_DRAIN) { E.fused(acc, cur, wr, wc, fr, fq, lds, wid, lane); S.done(cur); }
#undef PG8_SA
#undef PG8_SELA
#undef PG8_SELB
#undef PG8_SB
#undef PG8_STAGE
#undef PG8_LDA
#undef PG8_LDB
#undef PG8_MMA
#undef PG8_WAIT_V
#undef PG8_WAIT_L
#undef PG8_BAR
#undef PG8_SCHED
}
}

#include <hip/hip_bf16.h>
#include <cmath>
namespace attn_body {
using bf16=__hip_bfloat16;
using bf16x8=__attribute__((ext_vector_type(8)))short;
using s16x4=__attribute__((ext_vector_type(4)))short;
using f32x16=__attribute__((ext_vector_type(16)))float;
using u32x4=__attribute__((ext_vector_type(4)))unsigned;
constexpr int BATCH=16,NHEAD=8,SEQ=2048,D=64,DM=NHEAD*D;
constexpr int NW=8,QBLK=32,QB=QBLK*NW,KVBLK=64,NQB=SEQ/QB;
constexpr int ATTN_PITCH=DM, ATTN_UNIT_ROWS=QB;
__device__ __forceinline__ int crow(int r,int hi){return (r&3)+8*(r>>2)+4*hi;}
#define SBAR() __builtin_amdgcn_sched_barrier(0)
__device__ __forceinline__ void cmask(f32x16&p0,f32x16&p1,int jb,int qrel,int hi){
  const float NEG=-INFINITY; int kb=64*jb+4*hi;
  #pragma unroll
  for(int r=0;r<16;++r){int kv=kb+(r&3)+8*(r>>2); if(kv>qrel)p0[r]=NEG; if(kv+32>qrel)p1[r]=NEG;}
}

constexpr int NSLOT=3, SLOTB=8192;
constexpr int LDS_K=0, LDS_V=NSLOT*SLOTB, LDS_WS=2*NSLOT*SLOTB, LDS_OST=LDS_WS+NW*64*4, LDS_F=LDS_OST+NW*4096, LDS_FW=LDS_F+SEQ*4, LDS_BYTES=LDS_FW+64;
constexpr float C2=0.125f*1.4426950408889634f;
__device__ __forceinline__ void glds16(const void*gsrc,unsigned lds_dst){unsigned keep;
  asm volatile("s_mov_b32 %0, m0\n\ts_mov_b32 m0, %2\n\ts_nop 0\n\tglobal_load_lds_dwordx4 %1, off\n\ts_mov_b32 m0, %0":"=&s"(keep):"v"(gsrc),"s"(lds_dst):"memory");}
__device__ __forceinline__ float max3f(float a,float b,float c){float r;asm("v_max3_f32 %0, %1, %2, %3":"=v"(r):"v"(a),"v"(b),"v"(c));return r;}
__device__ __forceinline__ float max2f(float a,float b){float r;asm("v_max_f32_e32 %0, %1, %2":"=v"(r):"v"(a),"v"(b));return r;}
__device__ __forceinline__ float fadd_s(float a,float b){float r;asm("v_add_f32_e32 %0, %1, %2":"=v"(r):"v"(a),"v"(b));return r;}
__device__ __forceinline__ float fsub_s(float a,float b){float r;asm("v_sub_f32_e32 %0, %1, %2":"=v"(r):"v"(a),"v"(b));return r;}
typedef float f32x2_t __attribute__((ext_vector_type(2))); typedef __bf16 bf16x2_t __attribute__((ext_vector_type(2)));
__device__ __forceinline__ unsigned cvtpk_s(float lo,float hi){f32x2_t v={lo,hi};bf16x2_t b=__builtin_convertvector(v,bf16x2_t);return __builtin_bit_cast(unsigned,b);}
#define WAIT_BAR(N) asm volatile("s_waitcnt vmcnt(" #N ") lgkmcnt(0)\n\ts_barrier":::"memory")

__device__ __forceinline__ void qkt(f32x16&p0,f32x16&p1,const char*Kslot,const bf16x8*qr,const f32x16&negm,int r32,int hi){
  const char*kb=Kslot+hi*1024+r32*16;
  #pragma unroll
  for(int d0=0;d0<4;++d0){
    const bf16x8 b0=*reinterpret_cast<const bf16x8*>(kb+d0*2048);
    const bf16x8 b1=*reinterpret_cast<const bf16x8*>(kb+d0*2048+512);
    if(d0==0){p0=__builtin_amdgcn_mfma_f32_32x32x16_bf16(b0,qr[0],negm,0,0,0);p1=__builtin_amdgcn_mfma_f32_32x32x16_bf16(b1,qr[0],negm,0,0,0);}
    else{p0=__builtin_amdgcn_mfma_f32_32x32x16_bf16(b0,qr[d0],p0,0,0,0);p1=__builtin_amdgcn_mfma_f32_32x32x16_bf16(b1,qr[d0],p1,0,0,0);}}
}
typedef __attribute__((address_space(3))) const char* lds_cptr;
typedef short v4i16_t __attribute__((ext_vector_type(4)));
__device__ __forceinline__ void kload8(bf16x8*kf,lds_cptr kp){
  kf[0]=*(const __attribute__((address_space(3))) bf16x8*)(kp);      kf[1]=*(const __attribute__((address_space(3))) bf16x8*)(kp+512);
  kf[2]=*(const __attribute__((address_space(3))) bf16x8*)(kp+2048); kf[3]=*(const __attribute__((address_space(3))) bf16x8*)(kp+2560);
  kf[4]=*(const __attribute__((address_space(3))) bf16x8*)(kp+4096); kf[5]=*(const __attribute__((address_space(3))) bf16x8*)(kp+4608);
  kf[6]=*(const __attribute__((address_space(3))) bf16x8*)(kp+6144); kf[7]=*(const __attribute__((address_space(3))) bf16x8*)(kp+6656);
}
__device__ __forceinline__ void kload2(bf16x8*kf,lds_cptr kp,int j){ kf[2*j]=*(const __attribute__((address_space(3))) bf16x8*)(kp+j*2048); kf[2*j+1]=*(const __attribute__((address_space(3))) bf16x8*)(kp+j*2048+512); }
__device__ __forceinline__ s16x4 vtr(lds_cptr p){ return __builtin_bit_cast(s16x4,__builtin_amdgcn_ds_read_tr16_b64_v4i16((__attribute__((address_space(3))) v4i16_t*)p)); }
__device__ __forceinline__ float rowmax(const f32x16&p0,const f32x16&p1){
  float a=max3f(p0[0],p0[1],p1[0]),b=max3f(p0[2],p0[3],p1[1]);a=max3f(a,p1[2],p1[3]);
  #pragma unroll
  for(int r=4;r<16;r+=4){a=max3f(a,p0[r],p0[r+1]);b=max3f(b,p0[r+2],p0[r+3]);a=max3f(a,p1[r],p1[r+1]);b=max3f(b,p1[r+2],p1[r+3]);}
  const float m=max2f(a,b);
  auto rr=__builtin_amdgcn_permlane32_swap(__float_as_uint(m),__float_as_uint(m),false,false);
  return max2f(__uint_as_float(rr[0]),__uint_as_float(rr[1]));
}
__device__ __forceinline__ void pv(f32x16*o,int vb,bf16x8 pa0,bf16x8 pa1,bf16x8 pa2,bf16x8 pa3){
  #pragma unroll
  for(int d0=0;d0<2;++d0){s16x4 lo[4],hi[4];
    #pragma unroll
    for(int ks=0;ks<4;++ks){
      asm volatile("ds_read_b64_tr_b16 %0,%1 offset:%c2":"=&v"(lo[ks]):"v"(vb),"i"(d0*4096+ks*1024):"memory");
      asm volatile("ds_read_b64_tr_b16 %0,%1 offset:%c2":"=&v"(hi[ks]):"v"(vb),"i"(d0*4096+ks*1024+512):"memory");}
    asm volatile("s_waitcnt lgkmcnt(0)":::"memory");SBAR();
    #define PK(k) (bf16x8){lo[k][0],lo[k][1],lo[k][2],lo[k][3],hi[k][0],hi[k][1],hi[k][2],hi[k][3]}
    o[d0]=__builtin_amdgcn_mfma_f32_32x32x16_bf16(pa0,PK(0),o[d0],0,0,0);
    o[d0]=__builtin_amdgcn_mfma_f32_32x32x16_bf16(pa1,PK(1),o[d0],0,0,0);
    o[d0]=__builtin_amdgcn_mfma_f32_32x32x16_bf16(pa2,PK(2),o[d0],0,0,0);
    o[d0]=__builtin_amdgcn_mfma_f32_32x32x16_bf16(pa3,PK(3),o[d0],0,0,0);
    #undef PK
  }
}

#ifndef ATTN_STORE16
#define ATTN_STORE16(p,v) (*(u32x4*)(p)=(v))
#endif
typedef float f32x4v __attribute__((ext_vector_type(4)));
__device__ __forceinline__ float logsig(float x){ return fminf(x,0.f)-log1pf(__expf(-fabsf(x))); }
template<int THRL> __device__ __forceinline__ void attn_unit(int b,int h,int qb,const bf16*Q,const bf16*__restrict__ K,const bf16*__restrict__ V,bf16*O,char*shm,const float*__restrict__ flog,float bfh){
  int tid_=threadIdx.x; asm volatile("":"+v"(tid_)); const int tid=tid_,lane=tid&63,r32=lane&31,hi=lane>>5; const int wid=__builtin_amdgcn_readfirstlane(tid>>6);
  const long rowbase=(long)b*SEQ; const int q0=qb*QB;
  const bf16*Qw=Q+(rowbase+q0+wid*QBLK)*DM+h*D;
  const bf16*Kh=K+rowbase*DM+h*D,*Vh=V+rowbase*DM+h*D;
  const unsigned lds0=(unsigned)(uintptr_t)shm;
  float*wsf=(float*)(shm+LDS_WS)+wid*64;
  const bf16*ksrc=Kh+(long)lane*DM+wid*8;
  const bf16*vsrc=Vh+(long)(16*(wid&3)+(lane>>2))*DM+(wid>>2)*32+(lane&3)*8;
  const unsigned kdst=lds0+LDS_K+wid*1024, vdst=lds0+LDS_V+wid*1024;
  #define DMA_K(t,slot) glds16(ksrc+(long)(t)*KVBLK*DM,(unsigned)__builtin_amdgcn_readfirstlane(kdst+(slot)))
  #define DMA_V(t,slot) glds16(vsrc+(long)(t)*KVBLK*DM,(unsigned)__builtin_amdgcn_readfirstlane(vdst+(slot)))
  const int vb0=(int)(lds0+LDS_V)+((lane>>4)&1)*32+(lane&3)*8+(4*hi+((lane&15)>>2))*64;
  const char*Kbase=shm+LDS_K; bf16x8 kf[8];
  const lds_cptr shm3=(lds_cptr)shm; const lds_cptr kp0=shm3+LDS_K+hi*1024+r32*16; const lds_cptr vp0=shm3+LDS_V+((lane>>4)&1)*32+(lane&3)*8+(4*hi+((lane&15)>>2))*64;
  const int NT=(q0+QB)/KVBLK;
  typedef __attribute__((address_space(3))) float* lds_fptr;
  const lds_fptr fs3=(lds_fptr)(shm3+LDS_F); const lds_fptr fw3=(lds_fptr)(shm3+LDS_FW);
  { float v0=0.f,v1=0.f,v2=0.f,v3=0.f; const int t0=4*tid;
    if(t0<NT*KVBLK){ const float*fp=flog+(rowbase+t0)*NHEAD+h; v0=logsig(fp[0]+bfh); v1=logsig(fp[NHEAD]+bfh); v2=logsig(fp[2*NHEAD]+bfh); v3=logsig(fp[3*NHEAD]+bfh); }
    v1+=v0; v2+=v1; v3+=v2; float inc=v3;
    #pragma unroll
    for(int o=1;o<64;o<<=1){ const float nb=__shfl_up(inc,o); if(lane>=o)inc+=nb; }
    if(lane==63)fw3[wid]=inc;
    asm volatile("s_waitcnt lgkmcnt(0)\n\ts_barrier":::"memory");
    float woff=0.f;
    #pragma unroll
    for(int w_=0;w_<NW;++w_){ const float tw=fw3[w_]; if(w_<wid)woff+=tw; }
    const float ex=woff+(inc-v3); const float L2E=1.4426950408889634f;
    *(__attribute__((address_space(3))) f32x4v*)(fs3+t0)=(f32x4v){(v0+ex)*L2E,(v1+ex)*L2E,(v2+ex)*L2E,(v3+ex)*L2E};
    asm volatile("s_waitcnt lgkmcnt(0)\n\ts_barrier":::"memory"); }
  const float fq2=fs3[q0+wid*QBLK+r32];
  #define FKSUB(P0,P1,t) do{ const lds_fptr fk_=fs3+(t)*KVBLK+4*hi; \
    _Pragma("unroll") for(int r_=0;r_<16;++r_){ P0[r_]+=nq; P1[r_]+=nq; } \
    _Pragma("unroll") for(int j_=0;j_<4;++j_){ { const f32x4v a_=*(const __attribute__((address_space(3))) f32x4v*)(fk_+8*j_); \
      _Pragma("unroll") for(int i_=0;i_<4;++i_) P0[4*j_+i_]-=a_[i_]; } SBAR(); \
      { const f32x4v b_=*(const __attribute__((address_space(3))) f32x4v*)(fk_+32+8*j_); \
      _Pragma("unroll") for(int i_=0;i_<4;++i_) P1[4*j_+i_]-=b_[i_]; } SBAR(); } }while(0)
  DMA_K(0,0);DMA_V(0,0);DMA_K(1,SLOTB);
  bf16x8 qr[4];
  #pragma unroll
  for(int d0=0;d0<4;++d0)qr[d0]=*reinterpret_cast<const bf16x8*>(&Qw[(long)r32*DM+d0*16+hi*8]);
  float mhat=0.f,l_reg=0.f;f32x16 o[2];o[0]=f32x16{};o[1]=f32x16{};const f32x16 negm=f32x16{}; float nq=fq2;
  const int qrel=wid*QBLK+r32;
  #define CMASK(P0,P1,t) do{int jb_=(t)-(NT-4); if(jb_>=0)cmask(P0,P1,jb_,qrel,hi);}while(0)
  bool resc=false;
  #define START(P0,P1) do{ const float rm=rowmax(P0,P1); resc=false; \
    { const float dl=rm; mhat=fadd_s(mhat,dl); \
      _Pragma("unroll") for(int r=0;r<16;++r){P0[r]=fsub_s(P0[r],dl);P1[r]=fsub_s(P1[r],dl);} \
      nq=fq2-mhat; } \
    _Pragma("unroll") for(int r=0;r<16;++r)P0[r]=__builtin_amdgcn_exp2f(P0[r]); }while(0)
  #define RESC() do{ if(resc){ asm volatile("s_waitcnt lgkmcnt(0)":::"memory"); \
      _Pragma("unroll") for(int d_=0;d_<2;++d_) _Pragma("unroll") for(int r=0;r<16;++r)o[d_][r]*=wsf[crow(r,hi)]; } }while(0)
  f32x16 pA0,pA1,pB0,pB1;
  int sl_prev=0,sl_cur=0,sl_next=SLOTB;
  #define ROT() do{sl_prev=sl_cur;sl_cur=sl_next;sl_next=(sl_next==(NSLOT-1)*SLOTB)?0:sl_next+SLOTB;}while(0)
  DMA_K(2,2*SLOTB);
  WAIT_BAR(3);
  qkt(pA0,pA1,Kbase,qr,negm,r32,hi);asm volatile("s_nop 15\n\ts_nop 7":"+v"(pA0),"+v"(pA1));FKSUB(pA0,pA1,0);CMASK(pA0,pA1,0);
  START(pA0,pA1);
  _Pragma("unroll") for(int r=0;r<16;++r)pA1[r]=__builtin_amdgcn_exp2f(pA1[r]);
  WAIT_BAR(0);
  DMA_K(3,0);DMA_V(1,SLOTB);
  ROT();
  kload8(kf,kp0+sl_cur);
  WAIT_BAR(2);
  s16x4 vlo[8],vhi[8]; u32x4 pw0,pw1,pw2,pw3;
  #define PKW(P,B) cvtpk_s(P[B],P[B+1])
  #define PAF(k) __builtin_bit_cast(bf16x8,pw##k)
  #define VFR(i) (bf16x8){vlo[i][0],vlo[i][1],vlo[i][2],vlo[i][3],vhi[i][0],vhi[i][1],vhi[i][2],vhi[i][3]}
  #define PIN(x) asm volatile("":"+v"(x))
  #define MX3(a,b,c) __builtin_fmaxf(__builtin_fmaxf((a),(b)),(c))
  #define GAPA(MF,A0,A1,A2,A3,W0,W1,PW) do{ MF; sacc+=A0; sacc+=A1; sacc+=A2; sacc+=A3; PIN(sacc); W0; W1; PIN(PW); SBAR(); }while(0)
  #define EX(v) __builtin_amdgcn_exp2f(v)
  #define GAPB(MF,X,B) do{ MF; X[B]=EX(X[B]); X[B+1]=EX(X[B+1]); X[B+2]=EX(X[B+2]); X[B+3]=EX(X[B+3]); PIN(X); SBAR(); }while(0)
  #define VRD(i) do{ vlo[i]=vtr(vp_+(((i)>>2)*4096+((i)&3)*1024)); vhi[i]=vtr(vp_+(((i)>>2)*4096+((i)&3)*1024+512)); }while(0)
  #define KRD(G,j) do{ if(G){ kload2(kf,kp0+sl_next,j); SBAR(); } }while(0)
  #define STEP(C0,C1,P0,P1,t,GK,GV,GL) do{ SBAR(); \
    const lds_cptr vp_=vp0+sl_prev; \
    VRD(0); SBAR(); float sacc=(P0[0]+P0[1]); \
    GAPA(C0=__builtin_amdgcn_mfma_f32_32x32x16_bf16(kf[0],qr[0],negm,0,0,0), P0[2],P0[3],P0[4],P0[5],     pw0[0]=PKW(P0,0), pw0[1]=PKW(P0,2), pw0); \
    VRD(4); SBAR(); GAPA(C1=__builtin_amdgcn_mfma_f32_32x32x16_bf16(kf[1],qr[0],negm,0,0,0), P0[6],P0[7],P0[8],P0[9],     pw0[2]=PKW(P0,4), pw0[3]=PKW(P0,6), pw0); \
    VRD(1); SBAR(); GAPA(C0=__builtin_amdgcn_mfma_f32_32x32x16_bf16(kf[2],qr[1],C0,0,0,0),   P0[10],P0[11],P0[12],P0[13], pw1[0]=PKW(P0,8), pw1[1]=PKW(P0,10), pw1); \
    VRD(5); SBAR(); GAPA(C1=__builtin_amdgcn_mfma_f32_32x32x16_bf16(kf[3],qr[1],C1,0,0,0),   P0[14],P0[15],P1[0],P1[1],   pw1[2]=PKW(P0,12),pw1[3]=PKW(P0,14), pw1); \
    VRD(2); SBAR(); GAPA(C0=__builtin_amdgcn_mfma_f32_32x32x16_bf16(kf[4],qr[2],C0,0,0,0),   P1[2],P1[3],P1[4],P1[5],     pw2[0]=PKW(P1,0), pw2[1]=PKW(P1,2), pw2); \
    VRD(6); SBAR(); GAPA(C1=__builtin_amdgcn_mfma_f32_32x32x16_bf16(kf[5],qr[2],C1,0,0,0),   P1[6],P1[7],P1[8],P1[9],     pw2[2]=PKW(P1,4), pw2[3]=PKW(P1,6), pw2); \
    VRD(3); SBAR(); GAPA(C0=__builtin_amdgcn_mfma_f32_32x32x16_bf16(kf[6],qr[3],C0,0,0,0),   P1[10],P1[11],P1[12],P1[13], pw3[0]=PKW(P1,8), pw3[1]=PKW(P1,10), pw3); \
    VRD(7); SBAR(); GAPA(C1=__builtin_amdgcn_mfma_f32_32x32x16_bf16(kf[7],qr[3],C1,0,0,0),   P1[14],P1[15],0.f,0.f,       pw3[2]=PKW(P1,12),pw3[3]=PKW(P1,14), pw3); \
    l_reg+=sacc; \
    if(GK){DMA_K((t)+3,sl_cur);} if(GV){DMA_V((t)+1,sl_next);} \
    FKSUB(C0,C1,t); CMASK(C0,C1,t); \
    { float a=MX3(C0[0],C0[1],C1[0]),b=MX3(C0[2],C0[3],C1[1]); a=MX3(a,C1[2],C1[3]); \
      _Pragma("unroll") for(int r=4;r<16;r+=4){a=MX3(a,C0[r],C0[r+1]);b=MX3(b,C0[r+2],C0[r+3]);a=MX3(a,C1[r],C1[r+1]);b=MX3(b,C1[r+2],C1[r+3]);} \
      float rm=__builtin_fmaxf(a,b); { auto rr=__builtin_amdgcn_permlane32_swap(__float_as_uint(rm),__float_as_uint(rm),false,false); rm=__builtin_fmaxf(__uint_as_float(rr[0]),__uint_as_float(rr[1])); } \
      resc=false; \
      if(__builtin_expect(__any(rm>(float)THRL),0)){ const float dl=__builtin_fmaxf(rm,0.f); mhat+=dl; \
        _Pragma("unroll") for(int r=0;r<16;++r){C0[r]-=dl;C1[r]-=dl;} \
        nq=fq2-mhat; \
        const float f=__builtin_amdgcn_exp2f(-dl); l_reg*=f; if(hi==0)wsf[r32]=f; resc=true; } } \
    SBAR(); \
    GAPB(o[0]=__builtin_amdgcn_mfma_f32_32x32x16_bf16(PAF(0),VFR(0),o[0],0,0,0), C0,0); \
    GAPB(o[1]=__builtin_amdgcn_mfma_f32_32x32x16_bf16(PAF(0),VFR(4),o[1],0,0,0), C0,4); \
    KRD(GL,0); GAPB(o[0]=__builtin_amdgcn_mfma_f32_32x32x16_bf16(PAF(1),VFR(1),o[0],0,0,0), C0,8); \
    KRD(GL,1); GAPB(o[1]=__builtin_amdgcn_mfma_f32_32x32x16_bf16(PAF(1),VFR(5),o[1],0,0,0), C0,12); \
    KRD(GL,2); GAPB(o[0]=__builtin_amdgcn_mfma_f32_32x32x16_bf16(PAF(2),VFR(2),o[0],0,0,0), C1,0); \
    KRD(GL,3); GAPB(o[1]=__builtin_amdgcn_mfma_f32_32x32x16_bf16(PAF(2),VFR(6),o[1],0,0,0), C1,4); \
    GAPB(o[0]=__builtin_amdgcn_mfma_f32_32x32x16_bf16(PAF(3),VFR(3),o[0],0,0,0), C1,8); \
    GAPB(o[1]=__builtin_amdgcn_mfma_f32_32x32x16_bf16(PAF(3),VFR(7),o[1],0,0,0), C1,12); \
    }while(0)
  int t=1;
  #undef CMASK
  #define CMASK(P0,P1,t) do{}while(0)
  for(;t+5<NT;t+=2){
    STEP(pB0,pB1,pA0,pA1,t,true,true,true);     WAIT_BAR(2); RESC(); ROT();
    STEP(pA0,pA1,pB0,pB1,t+1,true,true,true);   WAIT_BAR(2); RESC(); ROT();
  }
  #undef CMASK
  #define CMASK(P0,P1,t) do{int jb_=(t)-(NT-4); if(jb_>=0)cmask(P0,P1,jb_,qrel,hi);}while(0)
  #define ENDW(tt) do{ if((tt)+3<NT){WAIT_BAR(2);} else if((tt)+2<NT){WAIT_BAR(1);} else {WAIT_BAR(0);} }while(0)
  for(;t+1<NT;t+=2){
    STEP(pB0,pB1,pA0,pA1,t,(t+3<NT),(t+1<NT),(t+1<NT));       ENDW(t);   RESC(); ROT();
    STEP(pA0,pA1,pB0,pB1,t+1,(t+4<NT),(t+2<NT),(t+2<NT));     ENDW(t+1); RESC(); ROT();
  }
  STEP(pB0,pB1,pA0,pA1,NT-1,false,false,false); RESC();
  { float sacc=pB0[0]+pB0[1]; _Pragma("unroll") for(int r=2;r<16;++r)sacc+=pB0[r]; _Pragma("unroll") for(int r=0;r<16;++r)sacc+=pB1[r]; l_reg+=sacc;
    pw0=(u32x4){PKW(pB0,0),PKW(pB0,2),PKW(pB0,4),PKW(pB0,6)};pw1=(u32x4){PKW(pB0,8),PKW(pB0,10),PKW(pB0,12),PKW(pB0,14)};pw2=(u32x4){PKW(pB1,0),PKW(pB1,2),PKW(pB1,4),PKW(pB1,6)};pw3=(u32x4){PKW(pB1,8),PKW(pB1,10),PKW(pB1,12),PKW(pB1,14)};
    SBAR(); pv(o,vb0+sl_cur,PAF(0),PAF(1),PAF(2),PAF(3)); }
  #undef PKW
  #undef PAF
  #undef VFR
  #undef PIN
  #undef MX3
  #undef GAPA
  #undef GAPB
  #undef EX
  #undef VRD
  #undef KRD
  #undef STEP
  #undef ENDW
  {auto rr=__builtin_amdgcn_permlane32_swap(__float_as_uint(l_reg),__float_as_uint(l_reg),false,false);l_reg=__uint_as_float(rr[0])+__uint_as_float(rr[1]);}
  if(hi==0)wsf[32+r32]=l_reg;asm volatile("s_waitcnt lgkmcnt(0)":::"memory");
  float rli[16];
  #pragma unroll
  for(int r=0;r<16;++r)rli[r]=__builtin_amdgcn_rcpf(wsf[32+crow(r,hi)]);
  bf16*Ow=O+(rowbase+q0+wid*QBLK)*DM+h*D;
  { bf16*stg=(bf16*)(shm+LDS_OST)+wid*2048;
    #pragma unroll
    for(int r=0;r<16;++r){const int orow=crow(r,hi);
      #pragma unroll
      for(int d0=0;d0<2;++d0)stg[orow*64+d0*32+r32]=__float2bfloat16(o[d0][r]*rli[r]);}
    asm volatile("s_waitcnt lgkmcnt(0)":::"memory");
    #pragma unroll
    for(int i=0;i<4;++i){const int row=i*8+(lane>>3),ch=lane&7; const u32x4 v=*(const u32x4*)(stg+row*64+ch*8); ATTN_STORE16(Ow+(long)row*DM+ch*8,v);} }
  asm volatile("s_waitcnt lgkmcnt(0)\n\ts_barrier":::"memory");
  #undef FKSUB
  #undef DMA_K
  #undef DMA_V
  #undef CMASK
  #undef START
  #undef RESC
  #undef ROT
}
constexpr int ATTN_LDS_BYTES=LDS_BYTES;
struct AttnTensors { const bf16* Q; const bf16* K; const bf16* V; bf16* O; const float* flog; const float* bf; };
struct AttnUnit { int bh; int qb; };
struct StaticOrder {
  int vcu,G;
  __device__ __forceinline__ explicit StaticOrder(int grid,int v):vcu(v),G(grid){}
  __device__ __forceinline__ bool next(int i,AttnUnit&u)const{
    if(G==256){ if(i>=4)return false; const int s=vcu&1; u.bh=vcu>>1; u.qb=(i==0)?7-s:(i==1)?4+s:(i==2)?3-s:s; return true; }
    const int idx=i*G+vcu; if(idx>=BATCH*NHEAD*NQB)return false; u.bh=idx>>3; u.qb=7-(idx&7); return true; }
  __device__ __forceinline__ void a_ready(const AttnUnit&)const{}
  __device__ __forceinline__ void done(const AttnUnit&)const{}
};
template<class Sched,int THRL=8> __device__ __forceinline__ void attn_phase(char*lds,const AttnTensors&T,const Sched&S){
  AttnUnit u;
  for(int i=0;S.next(i,u);++i){ S.a_ready(u); attn_unit<THRL>(u.bh/NHEAD,u.bh%NHEAD,u.qb,T.Q,T.K,T.V,T.O,lds,T.flog,T.bf[u.bh%NHEAD]); S.done(u); }
}
#undef SBAR
#undef WAIT_BAR
}
namespace cg = cooperative_groups;
constexpr int NWAVES = 8;
constexpr int BATCH = 16, SEQ = 2048, DMODEL = 1024, MROWS = BATCH * SEQ, NHEADS = 8, AW = 512, FFH = 2816, NIN = 6912, NINSRC = 6664, DEPTH = 2;
constexpr size_t MiB = 1u << 20, KiB512 = 512u << 10;
constexpr size_t WS_SSQ = 0;
constexpr size_t WS_FLOG = 3 * MiB;
constexpr size_t WS_WIN = 4 * MiB;
constexpr size_t WS_WL = 18 * MiB, WL_STRIDE = 21 * MiB + MiB / 2;
constexpr size_t WL_A = 0, WL_B = 1 * MiB, WL_C = 2 * MiB, WL_OUT = 3 * MiB, WL_GU = 5 * MiB, WL_DN = 16 * MiB;
constexpr size_t WS_XB = 61 * MiB;
constexpr size_t WS_QA = 125 * MiB, WS_K = 157 * MiB, WS_V = 189 * MiB, WS_MIX = 157 * MiB;
constexpr size_t WS_U = 221 * MiB, WS_Z = 253 * MiB, WS_CB = 285 * MiB, WS_G = 317 * MiB;
constexpr size_t WS_ACT = 125 * MiB;
constexpr size_t WS_END = 509 * MiB;
static_assert(WS_WL + 2 * WL_STRIDE <= WS_XB && WS_G + (size_t)MROWS * 3072 * 2 <= WS_END && WS_ACT + (size_t)MROWS * FFH * 2 <= WS_G, "d_ws map");
constexpr int RING_BYTES = 131072, LDS_BYTES = 147456;

#define GAS __attribute__((address_space(1)))
#define LAS __attribute__((address_space(3)))
typedef unsigned short bf16;
typedef unsigned v4u __attribute__((ext_vector_type(4)));
typedef float f32x4 __attribute__((ext_vector_type(4)));
#define LDS_WAIT() asm volatile("s_waitcnt lgkmcnt(0)" ::: "memory")
__device__ __forceinline__ unsigned f2bf(float f) { unsigned u = __builtin_bit_cast(unsigned, f); return (u + 0x7fffu + ((u >> 16) & 1u)) >> 16; }
__device__ __forceinline__ unsigned pk2(float lo, float hi) { return f2bf(lo) | (f2bf(hi) << 16); }
__device__ __forceinline__ float wave_sum(float v) {
#pragma unroll
    for (int o = 1; o < 64; o <<= 1) v += __shfl_xor(v, o);
    return v;
}
struct CmId { __device__ __forceinline__ int operator()(int n) const { return n; } };
struct CmIn { __device__ __forceinline__ int operator()(int n) const {
    if (n < 1536) return n;
    if (n < 2048) return n + 8;
    if (n < 3072) { const int j = (n - 2048) >> 8, w = (n - 2048) & 255; return w < 128 ? 2056 + 128 * j + w : 3080 + 128 * j + (w - 128); }
    if (n < 3584) return 2568 + (n - 3072);
    if (n < 6656) return n + 8;
    if (n < 6664) return 1536 + (n - 6656);
    return -1; } };
struct CmGU { __device__ __forceinline__ int operator()(int n) const { const int j = n >> 8, w = n & 255; return w < 128 ? 128 * j + w : FFH + 128 * j + (w - 128); } };
template <class CM> __device__ __forceinline__ void tr_item(const float* W, int ldw, int K, bf16* WT, LAS float* scr, int item, int nblk, int lane, const float* kscale, CM cm) {
    const int kb = item / nblk, nb = item % nblk, k0 = 64 * kb, n0 = 32 * nb;
    const int sc = cm(n0 + (lane & 31));
#pragma unroll 8
    for (int i = 0; i < 32; ++i) { const int kk = 2 * i + (lane >> 5); float v = 0.f; if (sc >= 0) v = W[(size_t)(k0 + kk) * ldw + sc]; if (kscale) v *= kscale[k0 + kk]; scr[kk * 33 + (lane & 31)] = v; }
    LDS_WAIT(); asm volatile("" ::: "memory");
    const int c = lane & 7;
#pragma unroll
    for (int j = 0; j < 4; ++j) { const int n = (lane >> 3) + 8 * j; const LAS float* s = scr + (8 * c) * 33 + n;
        v4u o; o.x = pk2(s[0 * 33], s[1 * 33]); o.y = pk2(s[2 * 33], s[3 * 33]); o.z = pk2(s[4 * 33], s[5 * 33]); o.w = pk2(s[6 * 33], s[7 * 33]);
        *(GAS v4u*)(WT + (size_t)(n0 + n) * K + k0 + 8 * c) = o; }
    LDS_WAIT(); asm volatile("" ::: "memory");
}
__device__ __forceinline__ void wb_item(const float* pool_w, const float* pscale, const float* wpp, bf16* WBt, int item, int lane) {
    const int nb = (item >> 3) & 15, c8 = (item & 7) + 8 * (item >> 7), n = 64 * nb + lane, c0 = 8 * c8, g = c0 >> 7, cl = c0 & 127;
    float a0 = 0.f, a1 = 0.f, a2 = 0.f, a3 = 0.f, a4 = 0.f, a5 = 0.f, a6 = 0.f, a7 = 0.f;
    const float* pw = pool_w + ((size_t)g * 128 + cl) * 128;
    for (int d = 0; d < 128; ++d) { const float w = wpp[(size_t)(g * 128 + d) * 1024 + n] * pscale[g * 128 + d];
        a0 += pw[0 * 128 + d] * w; a1 += pw[1 * 128 + d] * w; a2 += pw[2 * 128 + d] * w; a3 += pw[3 * 128 + d] * w;
        a4 += pw[4 * 128 + d] * w; a5 += pw[5 * 128 + d] * w; a6 += pw[6 * 128 + d] * w; a7 += pw[7 * 128 + d] * w; }
    v4u o; o.x = pk2(a0, a1); o.y = pk2(a2, a3); o.z = pk2(a4, a5); o.w = pk2(a6, a7);
    *(GAS v4u*)(WBt + (size_t)n * 512 + c0) = o;
}

struct Args { const float* in[16]; float* out; unsigned char* ws; int ph_lo, ph_hi; };
#define XB_TMO      128
#define XB_XCNT(j)  (256  + 64 * (j))
#define XB_XSUB(j)  (1280 + 64 * (j))
#define XB_XGEN(j)  (2304 + 64 * (j))
#define XB_TOP      3328
#define XB_TOPGEN   3392
#define XCD_BAR_WORDS 3456
#define XB_SPIN_CAP (1u << 18)

__device__ __forceinline__ unsigned xb_ld(unsigned* p)              { return __hip_atomic_load(p, __ATOMIC_RELAXED, __HIP_MEMORY_SCOPE_AGENT); }
__device__ __forceinline__ unsigned xb_add(unsigned* p, unsigned v) { return __hip_atomic_fetch_add(p, v, __ATOMIC_RELAXED, __HIP_MEMORY_SCOPE_AGENT); }
__device__ __forceinline__ unsigned xb_xcc_id() { return (unsigned)__builtin_amdgcn_s_getreg((3 << 11) | 20) & 0xFu; }
#define XB_SPIN(cond, bar) do { unsigned _sp = 0; while (cond) { __builtin_amdgcn_s_sleep(1); \
    if ((++_sp & 255u) == 0u) { if (xb_ld(&(bar)[XB_TMO])) break; if (_sp > XB_SPIN_CAP) { atomicAdd(&(bar)[XB_TMO], 1u); break; } } } } while (0)

struct XcdBarrier {
    unsigned* bar; unsigned x;
    volatile LAS unsigned* st;
};

__device__ __forceinline__ XcdBarrier xcd_barrier_post(unsigned* bar, volatile LAS unsigned* st) {
    XcdBarrier b; b.bar = bar; b.x = xb_xcc_id(); b.st = st;
    if (threadIdx.x == 0) (void)xb_add(&bar[XB_XCNT(b.x)], 1u);
    return b;
}
__device__ __forceinline__ void xcd_barrier_complete(unsigned* bar, unsigned x, unsigned& nloc, unsigned& nx) {
    const unsigned G = gridDim.x * gridDim.y * gridDim.z;
    unsigned sum, cnt, mine, sp = 0u;
    for (;;) {
        sum = 0u; cnt = 0u; mine = 0u;
#pragma unroll
        for (unsigned j = 0; j < 16; ++j) { const unsigned c = xb_ld(&bar[XB_XCNT(j)]); sum += c; cnt += (c > 0u) ? 1u : 0u; mine = (j == x) ? c : mine; }
        if (sum == G) break;
        __builtin_amdgcn_s_sleep(1);
        if ((++sp & 255u) == 0u) { if (xb_ld(&bar[XB_TMO])) break; if (sp > XB_SPIN_CAP) { atomicAdd(&bar[XB_TMO], 1u); break; } }
    }
    nloc = mine > 0u ? mine : 1u; nx = cnt > 0u ? cnt : 1u;
}

__device__ __forceinline__ void xcd_barrier(const XcdBarrier& b) {
    asm volatile("s_waitcnt vmcnt(0)" ::: "memory");
    __syncthreads();
    if (threadIdx.x == 0) {
        unsigned* bar = b.bar;
        __builtin_amdgcn_s_waitcnt(0);
        unsigned nloc = b.st[0], nx = b.st[1];
        if (nloc == 0u) { xcd_barrier_complete(bar, b.x, nloc, nx); b.st[0] = nloc; b.st[1] = nx; }
        const unsigned old = xb_add(&bar[XB_XSUB(b.x)], 1u);
        const unsigned gen = old / nloc;
        if (old + 1u == (gen + 1u) * nloc) {
            __builtin_amdgcn_fence(__ATOMIC_RELEASE, "agent");
            asm volatile("s_waitcnt vmcnt(0)" ::: "memory");
            const unsigned og = xb_add(&bar[XB_TOP], 1u);
            const unsigned tg = og / nx;
            if (og + 1u == (tg + 1u) * nx) xb_add(&bar[XB_TOPGEN], 1u);
            else XB_SPIN(xb_ld(&bar[XB_TOPGEN]) == tg, bar);
            __builtin_amdgcn_fence(__ATOMIC_ACQUIRE, "agent");
            xb_add(&bar[XB_XGEN(b.x)], 1u);
            asm volatile("s_waitcnt vmcnt(0)" ::: "memory");
        } else {
            XB_SPIN(xb_ld(&bar[XB_XGEN(b.x)]) == gen, bar);
            __builtin_amdgcn_fence(__ATOMIC_ACQUIRE, "agent");
            asm volatile("s_waitcnt vmcnt(0)" ::: "memory");
        }
    }
    __syncthreads();
}

constexpr size_t WS_BAR = 2 * MiB + 512 * 1024;
constexpr int BARLDS_OFF = RING_BYTES;
#ifndef REP_SEAM
#define REP_SEAM 1
#endif
#define GRID_SEAM() for (int rs_ = 0; rs_ < REP_SEAM; ++rs_) xcd_barrier(bar)

__device__ __forceinline__ void convert_weights(const Args& a, int l, int which, LAS float* scr, int gw, int NGW, int lane) {
    unsigned char* ws = a.ws;
    bf16* WIN = (bf16*)(ws + WS_WIN); unsigned char* wl = ws + WS_WL + (size_t)l * WL_STRIDE;
    constexpr int I_IN = 16 * (NIN / 32), I_A = 8 * 32, I_OUT = 16 * 32, I_GU = 16 * (2 * FFH / 32), I_DN = (FFH / 64) * 32, I_WB = 1024;
    if (which & 1) for (int it = gw; it < I_IN; it += NGW) tr_item(a.in[2] + (size_t)l * 1024 * NINSRC, NINSRC, 1024, WIN, scr, it, NIN / 32, lane, a.in[1] + l * 1024, CmIn());
    if (which & 2) {
        for (int it = gw; it < I_A + I_A + I_OUT + I_GU + I_DN + I_WB; it += NGW) {
            int r = it;
            if (r < I_A) { tr_item(a.in[5] + (size_t)l * 512 * 1024, 1024, 512, (bf16*)(wl + WL_A), scr, r, 32, lane, nullptr, CmId()); continue; } r -= I_A;
            if (r < I_A) { tr_item(a.in[10] + (size_t)l * 512 * 1024, 1024, 512, (bf16*)(wl + WL_C), scr, r, 32, lane, nullptr, CmId()); continue; } r -= I_A;
            if (r < I_OUT) { tr_item(a.in[11] + (size_t)l * 1024 * 1024, 1024, 1024, (bf16*)(wl + WL_OUT), scr, r, 32, lane, nullptr, CmId()); continue; } r -= I_OUT;
            if (r < I_GU) { tr_item(a.in[13] + (size_t)l * 1024 * 2 * FFH, 2 * FFH, 1024, (bf16*)(wl + WL_GU), scr, r, 2 * FFH / 32, lane, a.in[12] + l * 1024, CmGU()); continue; } r -= I_GU;
            if (r < I_DN) { tr_item(a.in[14] + (size_t)l * FFH * 1024, 1024, FFH, (bf16*)(wl + WL_DN), scr, r, 32, lane, nullptr, CmId()); continue; } r -= I_DN;
            wb_item(a.in[6] + (size_t)l * 4 * 128 * 128, a.in[7] + l * 512, a.in[8] + (size_t)l * 512 * 1024, (bf16*)(wl + WL_B), r, lane);
        }
    }
}

__device__ __forceinline__ void x_to_bf16(const Args& a, int gw, int NGW, int lane) {
    const float* x = a.in[0]; bf16* XB = (bf16*)(a.ws + WS_XB);
    const int per = (MROWS + NGW - 1) / NGW;
    for (int m = gw * per; m < MROWS && m < (gw + 1) * per; ++m) {
        const GAS f32x4* xr = (const GAS f32x4*)(x + (size_t)m * 1024) + lane; f32x4 v[4]; float s = 0.f;
#pragma unroll
        for (int j = 0; j < 4; ++j) { v[j] = xr[64 * j]; s += (v[j].x * v[j].x + v[j].y * v[j].y) + (v[j].z * v[j].z + v[j].w * v[j].w); }
        s = wave_sum(s);
        GAS unsigned long long* o8 = (GAS unsigned long long*)(XB + (size_t)m * 1024) + lane;
#pragma unroll
        for (int j = 0; j < 4; ++j) o8[64 * j] = (unsigned long long)pk2(v[j].x, v[j].y) | ((unsigned long long)pk2(v[j].z, v[j].w) << 32);
        if (lane < 20) { const int bufi = lane >> 2, slot = lane & 3; *(GAS float*)(a.ws + WS_SSQ + (size_t)bufi * KiB512 + ((size_t)slot * MROWS + m) * 4) = (lane == 0) ? s : 0.f; }
    }
}

__device__ __forceinline__ void unpk8(const v4u w, float (&f)[8]) {
    f[0] = __uint_as_float(w.x << 16); f[1] = __uint_as_float(w.x & 0xffff0000u); f[2] = __uint_as_float(w.y << 16); f[3] = __uint_as_float(w.y & 0xffff0000u);
    f[4] = __uint_as_float(w.z << 16); f[5] = __uint_as_float(w.z & 0xffff0000u); f[6] = __uint_as_float(w.w << 16); f[7] = __uint_as_float(w.w & 0xffff0000u); }
__device__ __forceinline__ v4u pk8(const float (&f)[8]) { v4u o; o.x = pk2(f[0], f[1]); o.y = pk2(f[2], f[3]); o.z = pk2(f[4], f[5]); o.w = pk2(f[6], f[7]); return o; }

__device__ __forceinline__ void pool_conv_phase(const Args& a, int l, int vcu, int G, int tid) {
    const bf16* U = (const bf16*)(a.ws + WS_U); const bf16* Z = (const bf16*)(a.ws + WS_Z); const bf16* CB = (const bf16*)(a.ws + WS_CB);
    bf16* Dp = (bf16*)a.out; bf16* YC = (bf16*)a.out + (size_t)MROWS * 512;
    const float* cw = a.in[9] + (size_t)l * 3 * 512;
    const int cgp = tid & 63, seg = tid >> 6, ch = 8 * cgp, w = 2 << (cgp >> 4);
    float w0[8], w1[8], w2[8];
#pragma unroll
    for (int j = 0; j < 8; ++j) { w0[j] = cw[ch + j]; w1[j] = cw[512 + ch + j]; w2[j] = cw[1024 + ch + j]; }
    for (int chunk = vcu; chunk < MROWS / 128; chunk += G) {
        const int first = chunk * 128 + seg * 16, tb = first & (SEQ - 1);
        { float sum[8], uc[8], t8[8];
#pragma unroll
          for (int j = 0; j < 8; ++j) sum[j] = 0.f;
          for (int j = 1; j < w; ++j) if (tb - j >= 0) { unpk8(*(const GAS v4u*)(U + (size_t)(first - j) * 512 + ch), t8);
#pragma unroll
              for (int q = 0; q < 8; ++q) sum[q] += t8[q]; }
          for (int i = 0; i < 16; ++i) { const int row = first + i, t = tb + i;
              unpk8(*(const GAS v4u*)(U + (size_t)row * 512 + ch), uc);
              const float inv = 1.0f / (float)((t + 1) < w ? (t + 1) : w);
#pragma unroll
              for (int q = 0; q < 8; ++q) { sum[q] += uc[q]; t8[q] = sum[q] * inv - uc[q]; }
              *(GAS v4u*)(Dp + (size_t)row * 512 + ch) = pk8(t8);
              if (t - w + 1 >= 0) { unpk8(*(const GAS v4u*)(U + (size_t)(row - w + 1) * 512 + ch), t8);
#pragma unroll
                  for (int q = 0; q < 8; ++q) sum[q] -= t8[q]; } } }
        { float z2[8], z1[8], z0[8], cb[8], y[8];
#pragma unroll
          for (int q = 0; q < 8; ++q) { z2[q] = 0.f; z1[q] = 0.f; }
          if (tb >= 2) unpk8(*(const GAS v4u*)(Z + (size_t)(first - 2) * 512 + ch), z2);
          if (tb >= 1) unpk8(*(const GAS v4u*)(Z + (size_t)(first - 1) * 512 + ch), z1);
          for (int i = 0; i < 16; ++i) { const int row = first + i;
              unpk8(*(const GAS v4u*)(Z + (size_t)row * 512 + ch), z0); unpk8(*(const GAS v4u*)(CB + (size_t)row * 512 + ch), cb);
#pragma unroll
              for (int q = 0; q < 8; ++q) { y[q] = cb[q] * (w0[q] * z2[q] + w1[q] * z1[q] + w2[q] * z0[q]); z2[q] = z1[q]; z1[q] = z0[q]; }
              *(GAS v4u*)(YC + (size_t)row * 512 + ch) = pk8(y); } }
    }
}

__device__ __forceinline__ void final_norm_phase(const Args& a, int gw, int NGW, int lane) {
    float* out = a.out; const bf16* XB = (const bf16*)(a.ws + WS_XB); const float* ssq = (const float*)(a.ws + WS_SSQ + 4 * KiB512); const float* gn = a.in[15];
    f32x4 g4[2][2];
#pragma unroll
    for (int j = 0; j < 2; ++j) { g4[j][0] = *(const GAS f32x4*)(gn + 512 * j + 8 * lane); g4[j][1] = *(const GAS f32x4*)(gn + 512 * j + 8 * lane + 4); }
    for (int m = gw; m < MROWS; m += NGW) {
        const float rs = __builtin_amdgcn_rsqf(((ssq[m] + ssq[MROWS + m]) + (ssq[2 * MROWS + m] + ssq[3 * MROWS + m])) * (1.0f / 1024.0f) + 1e-6f);
#pragma unroll
        for (int j = 0; j < 2; ++j) { float v[8]; unpk8(*(const GAS v4u*)(XB + (size_t)m * 1024 + 512 * j + 8 * lane), v);
            GAS f32x4* o = (GAS f32x4*)(out + (size_t)m * 1024 + 512 * j + 8 * lane);
            o[0] = (f32x4){v[0], v[1], v[2], v[3]} * rs * g4[j][0]; o[1] = (f32x4){v[4], v[5], v[6], v[7]} * rs * g4[j][1]; }
    }
}

__global__ void __launch_bounds__(NWAVES * 64, 2) fwd_megakernel(Args a) {
    extern __shared__ __attribute__((aligned(16))) unsigned char lds[];
    cg::grid_group grid = cg::this_grid();
    if (a.ph_lo < 0) grid.sync();
    LAS unsigned char* ldsl = (LAS unsigned char*)lds;
    const int G = gridDim.x, bx = blockIdx.x, vcu = (G % 8 == 0) ? (bx % 8) * (G / 8) + bx / 8 : bx, NGW = G * NWAVES;
#define FRESH_IDS() int tid_ = threadIdx.x; asm volatile("" : "+v"(tid_)); const int tid = tid_, lane = tid & 63, wave = __builtin_amdgcn_readfirstlane(tid >> 6), gw = vcu * NWAVES + wave; LAS float* scr = (LAS float*)(ldsl + wave * 16384); (void)tid; (void)lane; (void)gw; (void)scr
    unsigned char* ws = a.ws;
    bf16* XB = (bf16*)(ws + WS_XB); bf16* WIN = (bf16*)(ws + WS_WIN);
    if (threadIdx.x < 2) ((volatile LAS unsigned*)(ldsl + BARLDS_OFF))[threadIdx.x] = 0u;
    __syncthreads();
    const XcdBarrier bar = xcd_barrier_post((unsigned*)(ws + WS_BAR), (volatile LAS unsigned*)(ldsl + BARLDS_OFF));

#define IN(k) (a.ph_lo <= (k) && (k) < a.ph_hi)
#ifndef REP_PRO
#define REP_PRO 1
#endif
#ifndef REP_IN
#define REP_IN 1
#endif
#ifndef REP_PC
#define REP_PC 1
#endif
#ifndef REP_MIX
#define REP_MIX 1
#endif
#ifndef REP_GU
#define REP_GU 1
#endif
#define BOTH(k) (IN(k) && IN((k) + 1))
#ifndef NO_PRO
    for (int rp_ = 0; rp_ < REP_PRO; ++rp_) if (IN(0)) { FRESH_IDS();
    convert_weights(a, 0, 3, scr, gw, NGW, lane);
    convert_weights(a, 1, 2, scr, gw, NGW, lane);
    x_to_bf16(a, gw, NGW, lane); }
#endif
    if (BOTH(0)) GRID_SEAM();

#pragma unroll 1
    for (int l = 0; l < DEPTH; ++l) {
        unsigned char* wl = ws + WS_WL + (size_t)l * WL_STRIDE; const int p0 = 1 + 6 * l;
        const float* ssq_in = (const float*)(ws + WS_SSQ + (size_t)(2 * l) * KiB512);
        float* ssq_mid = (float*)(ws + WS_SSQ + (size_t)(2 * l + 1) * KiB512);
        float* ssq_end = (float*)(ws + WS_SSQ + (size_t)(2 * l + 2) * KiB512);
#ifndef NO_IN
        for (int rp_ = 0; rp_ < REP_IN; ++rp_) if (IN(p0)) { pg8::Gemm g{XB, XB, XB, WIN, WIN, WIN, MROWS, NIN, 1024}; pg8::StaticOrder S; S.init(MROWS, NIN, G, bx);
          pg8::EpiIn E{ssq_in, a.in[4] + (size_t)l * 3072, (bf16*)(ws + WS_QA), (bf16*)(ws + WS_K), (bf16*)(ws + WS_V), (bf16*)(ws + WS_U), (bf16*)(ws + WS_Z), (bf16*)(ws + WS_CB), (bf16*)(ws + WS_G),
                       (float*)(ws + WS_FLOG), attn_body::C2};
          pg8::gemm_phase<pg8::EpiIn, pg8::StaticOrder, true, true>(ldsl, g, S, E); }
#endif
        if (BOTH(p0 + 0)) GRID_SEAM();
#ifndef NO_PRO
        if (l == 0 && IN(p0 + 1)) { FRESH_IDS(); convert_weights(a, 1, 1, scr, gw, NGW, lane); __syncthreads(); }
#endif
#ifndef NO_ATT
#ifndef REP_ATT
#define REP_ATT 1
#endif
        bf16* const YA = (bf16*)(ws + WS_QA);
        if (IN(p0 + 1)) { const attn_body::AttnTensors AT{(const attn_body::bf16*)(ws + WS_QA), (const attn_body::bf16*)(ws + WS_K), (const attn_body::bf16*)(ws + WS_V), (attn_body::bf16*)YA,
                                          (const float*)(ws + WS_FLOG), a.in[3] + l * NHEADS};
          const attn_body::StaticOrder S(G, vcu);
          attn_body::attn_phase<attn_body::StaticOrder>((char*)lds, AT, S); }
#endif
#ifndef NO_PC
        for (int rp_ = 0; rp_ < REP_PC; ++rp_) if (IN(p0 + 1)) { FRESH_IDS(); pool_conv_phase(a, l, vcu, G, tid); }
#endif
        if (BOTH(p0 + 1)) GRID_SEAM();
#ifndef NO_MIX
        for (int rp_ = 0; rp_ < REP_MIX; ++rp_) if (IN(p0 + 2)) { pg8::Gemm g{(const bf16*)YA, (const bf16*)a.out, (const bf16*)a.out + (size_t)MROWS * 512, (const bf16*)(wl + WL_A), (const bf16*)(wl + WL_B), (const bf16*)(wl + WL_C), MROWS, 1024, 512};
          pg8::StaticOrder3 S; S.init(MROWS, 1024, G, bx);
          pg8::EpiMix E{(const bf16*)(ws + WS_G), (bf16*)(ws + WS_MIX), (bf16*)(ws + WS_U)};
          pg8::gemm_phase<pg8::EpiMix, pg8::StaticOrder3, true, true>(ldsl, g, S, E); }
#endif
        if (BOTH(p0 + 2)) GRID_SEAM();
#ifndef NO_OUT
#ifndef REP_OUT
#define REP_OUT 1
#endif
        if (IN(p0 + 3)) { const bf16* A = (const bf16*)(ws + WS_MIX); const bf16* B = (const bf16*)(wl + WL_OUT);
          pg8::Gemm g{A, A, A, B, B, B, MROWS, 1024, 1024}; pg8::StaticOrder S; S.init(MROWS, 1024, G, bx);
          pg8::EpiResid E{XB, ssq_mid};
          pg8::gemm_phase<pg8::EpiResid, pg8::StaticOrder, true, true>(ldsl, g, S, E); }
#endif
        if (BOTH(p0 + 3)) GRID_SEAM();
#ifndef NO_GU
        for (int rp_ = 0; rp_ < REP_GU; ++rp_) if (IN(p0 + 4)) { const bf16* B = (const bf16*)(wl + WL_GU);
          pg8::Gemm g{XB, XB, XB, B, B, B, MROWS, 2 * FFH, 1024}; pg8::StaticOrder S; S.init(MROWS, 2 * FFH, G, bx);
          pg8::EpiSwiglu E{ssq_mid, (bf16*)(ws + WS_ACT)};
          pg8::gemm_phase<pg8::EpiSwiglu, pg8::StaticOrder, true, true>(ldsl, g, S, E); }
#endif
        if (BOTH(p0 + 4)) GRID_SEAM();
#ifndef NO_DN
        if (IN(p0 + 5)) { const bf16* A = (const bf16*)(ws + WS_ACT); const bf16* B = (const bf16*)(wl + WL_DN);
          pg8::Gemm g{A, A, A, B, B, B, MROWS, 1024, FFH}; pg8::StaticOrder S; S.init(MROWS, 1024, G, bx);
          pg8::EpiResid E{XB, ssq_end};
          pg8::gemm_phase<pg8::EpiResid, pg8::StaticOrder, true, true>(ldsl, g, S, E); }
#endif
        if (BOTH(p0 + 5)) GRID_SEAM();
    }
    if (IN(13)) { FRESH_IDS(); final_norm_phase(a, gw, NGW, lane); }
}

template <bool F32> __global__ void dump_fold(const void* buf, int pitch, int ncols, float scale, float* out, int colofs, int W) {
    const long idx = (long)blockIdx.x * blockDim.x + threadIdx.x; if (idx >= (long)MROWS * W) return;
    const int row = (int)(idx / W), j = (int)(idx % W); float v = 0.f;
    for (int c = j; c < ncols; c += W) v += F32 ? ((const float*)buf)[(size_t)row * pitch + c] : __uint_as_float((unsigned)((const bf16*)buf)[(size_t)row * pitch + c] << 16);
    out[(size_t)row * 1024 + colofs + j] = scale * v;
}
__global__ void ws_too_small_fill(float* out, int n) { for (int i = blockIdx.x * blockDim.x + threadIdx.x; i < n; i += gridDim.x * blockDim.x) out[i] = 7777.f; }

extern "C" void kernel_launch(void* const* d_in, const int* in_sizes, int n_in, void* d_out, int out_size, void* d_ws, size_t ws_size, hipStream_t stream) {
    static int grid = 0;
    if (grid == 0) {
        int dev = 0, cus = 0, per_cu = 0;
        if (hipGetDevice(&dev) != hipSuccess || hipDeviceGetAttribute(&cus, hipDeviceAttributeMultiprocessorCount, dev) != hipSuccess) { fprintf(stderr, "kernel_launch: device query failed\n"); grid = -1; return; }
        if (hipFuncSetAttribute((const void*)fwd_megakernel, hipFuncAttributeMaxDynamicSharedMemorySize, LDS_BYTES) != hipSuccess) { fprintf(stderr, "kernel_launch: hipFuncSetAttribute failed\n"); grid = -1; return; }
        if (hipOccupancyMaxActiveBlocksPerMultiprocessor(&per_cu, (const void*)fwd_megakernel, NWAVES * 64, LDS_BYTES) != hipSuccess || per_cu < 1) per_cu = 1;
        (void)hipGetLastError();
        grid = cus;
    }
    if (grid < 0) return;
    if (n_in != 16 || out_size != MROWS * DMODEL || ws_size < WS_END) { ws_too_small_fill<<<256, 256, 0, stream>>>((float*)d_out, out_size); return; }
    Args a{};
    for (int i = 0; i < 16; ++i) a.in[i] = (const float*)d_in[i];
    a.out = (float*)d_out; a.ws = (unsigned char*)d_ws;
#ifndef MK_LAUNCHES
#define MK_LAUNCHES 1
#endif
#if 0
#elif MK_LAUNCHES == 1
    a.ph_lo = 0; a.ph_hi = 14;
    if (hipMemsetAsync((unsigned char*)d_ws + WS_BAR, 0, XCD_BAR_WORDS * 4, stream) != hipSuccess) { fprintf(stderr, "kernel_launch: memset of the barrier words failed\n"); return; }
    void* args[] = {&a};
    hipError_t e = hipLaunchCooperativeKernel((const void*)fwd_megakernel, dim3(grid), dim3(NWAVES * 64), args, LDS_BYTES, stream);
    if (e != hipSuccess) fprintf(stderr, "kernel_launch: cooperative launch failed: %s (grid %d)\n", hipGetErrorString(e), grid);
#else
    for (int p = 0; p < 14; ++p) { a.ph_lo = p; a.ph_hi = p + 1; hipLaunchKernelGGL(fwd_megakernel, dim3(grid), dim3(NWAVES * 64), LDS_BYTES, stream, a); }
#endif
}
```

```cpp
#define MK_LAUNCHES 1
#include <hip/hip_runtime.h>
#include <hip/hip_cooperative_groups.h>
#include <cstdio>
#include <cstdint>
namespace pg8 {
#define PG8_LAS __attribute__((address_space(3)))
typedef unsigned short bf16_t;
typedef short bf16x8 __attribute__((ext_vector_type(8)));
typedef float f32x4 __attribute__((ext_vector_type(4)));
typedef unsigned u32x4 __attribute__((ext_vector_type(4)));
constexpr int BM = 256, BK = 64, HALF = 128, HTB = HALF * BK * 2  , STAGE_BYTES = 8 * HTB, NXCD = 8, WGM = 8;

__host__ __device__ __forceinline__ int lds_byte(int r, int c) { const int st = (r >> 4) * 2 + (c >> 5), rr = r & 15, cc = c & 31, ob = rr * 64 + cc * 2; return st * 1024 + (ob ^ (((ob >> 9) & 1) << 5)); }
__host__ __device__ __forceinline__ void stage_rc(int b, int& R, int& C) { const int st = b / 1024, sb = b % 1024, swz = sb ^ (((sb >> 9) & 1) << 5); R = (st >> 1) * 16 + swz / 64; C = (st & 1) * 32 + (swz % 64) / 2; }
__host__ __device__ __forceinline__ int perm32(int rho) { const int n = rho >> 4, i = rho & 15; return 8 * (i >> 2) + 4 * n + (i & 3); }

struct Unit { int pm, pn, sub; };
struct Gemm { const bf16_t *A0, *A1, *A2, *B0, *B1, *B2; int M, N, K; };

struct StaticOrder {
    int nM, nN, nwg, G, c;
    __host__ __device__ void init(int M, int N, int G_, int c_) { nM = M / BM; nN = N / BM; nwg = nM * nN; G = G_; c = c_; }
    __host__ __device__ bool next(int i, Unit& u) const {
        const long L = (long)i * G + c; if (L >= nwg) return false;
        int wgid = (int)L; { const int q = nwg / NXCD, r = nwg % NXCD, xcd = wgid % NXCD, off = wgid / NXCD; wgid = (xcd < r ? xcd * (q + 1) : r * (q + 1) + (xcd - r) * q) + off; }
        const int nig = WGM * nN, gid = wgid / nig, fm = gid * WGM, gsz = (nM - fm) < WGM ? (nM - fm) : WGM;
        u.pm = fm + ((wgid % nig) % gsz); u.pn = (wgid % nig) / gsz; u.sub = 0; return true;
    }
    __device__ __forceinline__ void a_ready(const Unit&) const {}
    __device__ __forceinline__ void done(const Unit&) const {}
};

struct StaticOrder3 {
    StaticOrder b;
    __host__ __device__ void init(int M, int N, int G_, int c_) { b.init(M, N, G_, c_); }
    __host__ __device__ bool next(int i, Unit& u) const { if (!b.next(i / 3, u)) return false; u.sub = i % 3; return true; }
    __device__ __forceinline__ void a_ready(const Unit&) const {}
    __device__ __forceinline__ void done(const Unit&) const {}
};
typedef float f32x2c_t __attribute__((ext_vector_type(2))); typedef __bf16 bf16x2c_t __attribute__((ext_vector_type(2)));
__device__ __forceinline__ unsigned cvt_pk_bf16(float lo, float hi) { const f32x2c_t v = {lo, hi}; const bf16x2c_t b = __builtin_convertvector(v, bf16x2c_t); return __builtin_bit_cast(unsigned, b); }
typedef float f32x2 __attribute__((ext_vector_type(2)));
__device__ __forceinline__ float rstd_of(const float* ssq, int row) { const float s0 = ssq[row], s1 = ssq[32768 + row], s2 = ssq[2 * 32768 + row], s3 = ssq[3 * 32768 + row]; return __builtin_amdgcn_rsqf(((s0 + s1) + (s2 + s3)) * (1.0f / 1024.0f) + 1e-6f); }
__device__ __forceinline__ float sigm(float v) { return __builtin_amdgcn_rcpf(1.0f + __builtin_amdgcn_exp2f(-1.4426950408889634f * v)); }
__device__ __forceinline__ u32x4 pack8(const f32x4 a, const f32x4 b) { u32x4 w; w.x = cvt_pk_bf16(a[0], a[1]); w.y = cvt_pk_bf16(a[2], a[3]); w.z = cvt_pk_bf16(b[0], b[1]); w.w = cvt_pk_bf16(b[2], b[3]); return w; }
__device__ __forceinline__ void st16_nt(void* p, const u32x4 v) { __builtin_nontemporal_store(v, (u32x4*)p); }
__device__ __forceinline__ void unpack8(const u32x4 w, f32x4& a, f32x4& b) {
    a[0] = __uint_as_float(w.x << 16); a[1] = __uint_as_float(w.x & 0xffff0000u); a[2] = __uint_as_float(w.y << 16); a[3] = __uint_as_float(w.y & 0xffff0000u);
    b[0] = __uint_as_float(w.z << 16); b[1] = __uint_as_float(w.z & 0xffff0000u); b[2] = __uint_as_float(w.w << 16); b[3] = __uint_as_float(w.w & 0xffff0000u); }

constexpr int AUX_OFF = 131072 + 1024, AUX_BYTES = 4096 + 1024;
__device__ __forceinline__ void pre_rows(PG8_LAS unsigned char* lds, const float* ssq, int pm, int par, int wid, int lane) {
#pragma unroll
    for (int i = 0; i < 2; ++i) { const int q = wid * 2 + i, slot = q >> 2, r0 = (q & 3) * 64;
        __builtin_amdgcn_global_load_lds((const unsigned*)(ssq + (size_t)slot * 32768 + pm * BM + r0 + lane), (PG8_LAS unsigned*)(lds + AUX_OFF + par * AUX_BYTES + (slot * 256 + r0) * 4), 4, 0, 0); }
}
__device__ __forceinline__ float rstd_lds(const PG8_LAS float* aux, int rl) { return __builtin_amdgcn_rsqf(((aux[rl] + aux[256 + rl]) + (aux[512 + rl] + aux[768 + rl])) * (1.0f / 1024.0f) + 1e-6f); }

struct EpiIn {
    static constexpr bool PERM = true, AFTER_DRAIN = false, PRE = true, SPLIT = false;
    const float* ssq; const float* bgate; bf16_t *Q, *G; float* FLOG; float qscale;
    __device__ __forceinline__ void pre(PG8_LAS unsigned char* lds, const Unit& u, int par, int wid, int lane) const {
        pre_rows(lds, ssq, u.pm, par, wid, lane);
        if (u.pn >= 14 && u.pn < 26 && wid < 4)
            __builtin_amdgcn_global_load_lds((const unsigned*)(bgate + (u.pn - 14) * 256 + wid * 64 + lane), (PG8_LAS unsigned*)(lds + AUX_OFF + par * AUX_BYTES + 4096 + wid * 256), 4, 0, 0);
    }
    template <int AI> __device__ __forceinline__ void part(const f32x4 (&acc)[2][2][4][2], const Unit& u, int wr, int wc, int fr, int fq, PG8_LAS unsigned char* lds, int par) const {
        const PG8_LAS float* aux = (const PG8_LAS float*)(lds + AUX_OFF + par * AUX_BYTES);
        const int rl0 = wr * 64 + fr + AI * HALF, row0 = u.pm * BM + rl0, pn = u.pn, cw = wc * 32 + 8 * fq;
        if (pn < 8 || pn == 12 || pn == 13) {
            const int blk = pn < 8 ? (pn >> 1) : 5, colt = (pn & 1) * 256; const float sc = pn < 2 ? qscale : 1.f;
            bf16_t* base = Q + (size_t)blk * ((size_t)32768 * 512);
#pragma unroll
            for (int m = 0; m < 4; ++m) { const int row = row0 + m * 16; const float rs = rstd_lds(aux, rl0 + m * 16) * sc; bf16_t* rowp = base + (size_t)row * 512 + colt + cw;
#pragma unroll
                for (int bj = 0; bj < 2; ++bj) st16_nt(rowp + bj * HALF, pack8(acc[AI][bj][m][0] * rs, acc[AI][bj][m][1] * rs)); }
        } else if (pn < 12) {
            const int colz = (pn - 8) * 128 + cw;
#pragma unroll
            for (int m = 0; m < 4; ++m) { const int row = row0 + m * 16; const float rs = rstd_lds(aux, rl0 + m * 16), rs2 = rs * rs;
                st16_nt(Q + (size_t)4 * ((size_t)32768 * 512) + (size_t)row * 512 + colz, pack8(acc[AI][0][m][0] * acc[AI][1][m][0] * rs2, acc[AI][0][m][1] * acc[AI][1][m][1] * rs2)); }
        } else if (pn < 26) {
            const int colg = (pn - 14) * 256 + cw;
            f32x4 bv[2][2];
#pragma unroll
            for (int bj = 0; bj < 2; ++bj)
#pragma unroll
                for (int n = 0; n < 2; ++n) bv[bj][n] = *(const PG8_LAS f32x4*)(aux + 1024 + cw + bj * HALF + 4 * n);
#pragma unroll
            for (int m = 0; m < 4; ++m) { const int row = row0 + m * 16; const float rs = rstd_lds(aux, rl0 + m * 16); bf16_t* rowp = G + (size_t)row * 3072 + colg;
#pragma unroll
                for (int bj = 0; bj < 2; ++bj) { f32x4 v0 = acc[AI][bj][m][0] * rs + bv[bj][0], v1 = acc[AI][bj][m][1] * rs + bv[bj][1];
#pragma unroll
                    for (int i = 0; i < 4; ++i) { v0[i] = sigm(v0[i]); v1[i] = sigm(v1[i]); }
                    st16_nt(rowp + bj * HALF, pack8(v0, v1)); } }
        } else {
            if (wc == 0 && fq == 0) {
#pragma unroll
                for (int m = 0; m < 4; ++m) { const int row = row0 + m * 16; const float rs = rstd_lds(aux, rl0 + m * 16);
                    *(f32x4*)(FLOG + (size_t)row * 8) = acc[AI][0][m][0] * rs; *(f32x4*)(FLOG + (size_t)row * 8 + 4) = acc[AI][0][m][1] * rs; }
            }
        }
    }
};

struct EpiResid {
    static constexpr bool PERM = true, AFTER_DRAIN = false, PRE = false, SPLIT = false;
    bf16_t* xb; float* ssq;
    __device__ __forceinline__ void operator()(const f32x4 (&acc)[2][2][4][2], const Unit& u, int wr, int wc, int fr, int fq) const {
        const int row0 = u.pm * BM + wr * 64 + fr, col0 = u.pn * BM + wc * 32 + 8 * fq;
#pragma unroll
        for (int ai = 0; ai < 2; ++ai)
#pragma unroll
            for (int m = 0; m < 4; ++m) { const int row = row0 + ai * HALF + m * 16; bf16_t* p = xb + (size_t)row * 1024 + col0; float ss = 0.f;
#pragma unroll
                for (int bj = 0; bj < 2; ++bj) { f32x4 a, b; unpack8(*(const u32x4*)(p + bj * HALF), a, b);
                    a = a + acc[ai][bj][m][0]; b = b + acc[ai][bj][m][1];
                    ss += ((a[0] * a[0] + a[1] * a[1]) + (a[2] * a[2] + a[3] * a[3])) + ((b[0] * b[0] + b[1] * b[1]) + (b[2] * b[2] + b[3] * b[3]));
                    *(u32x4*)(p + bj * HALF) = pack8(a, b); }
                ss += __shfl_xor(ss, 16); ss += __shfl_xor(ss, 32);
                if (fq == 0) atomicAdd(ssq + (size_t)u.pn * 32768 + row, ss); }
    }
};

__device__ __forceinline__ u32x4 ld16_sc1(const bf16_t* p) {
    const unsigned long long* q = (const unsigned long long*)p;
    const unsigned long long lo = __hip_atomic_load(q, __ATOMIC_RELAXED, __HIP_MEMORY_SCOPE_AGENT), hi = __hip_atomic_load(q + 1, __ATOMIC_RELAXED, __HIP_MEMORY_SCOPE_AGENT);
    u32x4 w; w.x = (unsigned)lo; w.y = (unsigned)(lo >> 32); w.z = (unsigned)hi; w.w = (unsigned)(hi >> 32); return w; }
struct EpiMix {
    static constexpr bool PERM = true, AFTER_DRAIN = false, PRE = false, SPLIT = false;
    const bf16_t* G; bf16_t* MIX; bf16_t* P1;
    __device__ __forceinline__ void operator()(const f32x4 (&acc)[2][2][4][2], const Unit& u, int wr, int wc, int fr, int fq) const {
        const int row0 = u.pm * BM + wr * 64 + fr, col0 = u.pn * BM + wc * 32 + 8 * fq, sub = u.sub;
#pragma unroll
        for (int ai = 0; ai < 2; ++ai)
#pragma unroll
            for (int m = 0; m < 4; ++m) { const int row = row0 + ai * HALF + m * 16;
#pragma unroll
                for (int bj = 0; bj < 2; ++bj) { const int c = col0 + bj * HALF; f32x4 g0, g1; unpack8(*(const u32x4*)(G + (size_t)row * 3072 + sub * 1024 + c), g0, g1);
                    f32x4 v0 = acc[ai][bj][m][0] * g0, v1 = acc[ai][bj][m][1] * g1; const size_t off = (size_t)row * 1024 + c;
                    if (sub == 2) { f32x4 p0, p1; unpack8(*(const u32x4*)(MIX + off), p0, p1); v0 = v0 + p0; v1 = v1 + p1; unpack8(*(const u32x4*)(P1 + off), p0, p1); v0 = v0 + p0; v1 = v1 + p1; }
                    *(u32x4*)((sub == 1 ? P1 : MIX) + off) = pack8(v0, v1); } }
    }
};

struct EpiSwiglu {
    static constexpr bool PERM = true, AFTER_DRAIN = false, PRE = true, SPLIT = true;
    const float* ssq; bf16_t* ACT;
    __device__ __forceinline__ void pre(PG8_LAS unsigned char* lds, const Unit& u, int par, int wid, int lane) const { pre_rows(lds, ssq, u.pm, par, wid, lane); }
    template <int AI> __device__ __forceinline__ void part(const f32x4 (&acc)[2][2][4][2], const Unit& u, int wr, int wc, int fr, int fq, PG8_LAS unsigned char* lds, int par) const {
        const PG8_LAS float* aux = (const PG8_LAS float*)(lds + AUX_OFF + par * AUX_BYTES);
        const int rl0 = wr * 64 + fr + AI * HALF, row0 = u.pm * BM + rl0, colh = u.pn * 128 + wc * 32 + 8 * fq;
#pragma unroll
        for (int m = 0; m < 4; ++m) { const int row = row0 + m * 16; const float rs = rstd_lds(aux, rl0 + m * 16);
            f32x4 h[2];
#pragma unroll
            for (int n = 0; n < 2; ++n) { const f32x4 a = acc[AI][0][m][n] * rs, b = acc[AI][1][m][n] * rs;
#pragma unroll
                for (int i = 0; i < 4; ++i) h[n][i] = a[i] * sigm(a[i]) * b[i]; }
            st16_nt(ACT + (size_t)row * 2816 + colh, pack8(h[0], h[1])); }
    }
};

template <class Epi, class Sched, bool ALIGN_EPI = false, bool SP2 = false>
__device__ __forceinline__ void gemm_phase(PG8_LAS unsigned char* lds, const Gemm g, const Sched& S, const Epi& E) {
    int tid_ = threadIdx.x; asm volatile("" : "+v"(tid_));
    const int tid = tid_, wid = __builtin_amdgcn_readfirstlane(tid >> 6), lane = tid & 63, wr = wid >> 2, wc = wid & 3, fr = lane & 15, fq = lane >> 4;
    const int K = g.K, nt = K / BK;
    unsigned voffA[2], voffB[2];
#pragma unroll
    for (int i = 0; i < 2; ++i) { int R, C; stage_rc(tid * 16 + i * 8192, R, C); const int Rb = Epi::PERM ? ((R & ~31) + perm32(R & 31)) : R;
        voffA[i] = (unsigned)(R * K + C) * 2u; voffB[i] = (unsigned)(Rb * K + C) * 2u; }
    const size_t kstep = (size_t)(BK * 2);
    const size_t hstep = (size_t)HALF * K * 2;
    const size_t tstep = 2 * hstep;
    const unsigned ldsw = (unsigned)wid * 1024u;
    const int aoff = lds_byte(wr * 64 + fr, fq * 8), boff = lds_byte(wc * 32 + fr, fq * 8);
#define PG8_SELA(s) ((const char*)((s) == 0 ? g.A0 : ((s) == 1 ? g.A1 : g.A2)))
#define PG8_SELB(s) ((const char*)((s) == 0 ? g.B0 : ((s) == 1 ? g.B1 : g.B2)))
#define PG8_SA(b, h) (((b) * 2 + (h)) * HTB)
#define PG8_SB(b, h) ((4 + (b) * 2 + (h)) * HTB)
#define PG8_STAGE(bufoff, gbase, voff) do { _Pragma("unroll") for (int _i = 0; _i < 2; ++_i) \
        __builtin_amdgcn_global_load_lds((const unsigned*)((const char*)(gbase) + (voff)[_i]), (PG8_LAS unsigned*)(lds + (bufoff) + ldsw + _i * 8192), 16, 0, 0); } while (0)
#define PG8_LDA(dst, b, h) do { _Pragma("unroll") for (int m = 0; m < 4; ++m) _Pragma("unroll") for (int k = 0; k < 2; ++k) dst[m][k] = *(const PG8_LAS bf16x8*)(lds + PG8_SA(b, h) + aoff + m * 2048 + k * 1024); } while (0)
#define PG8_LDB(dst, b, h) do { _Pragma("unroll") for (int n = 0; n < 2; ++n) _Pragma("unroll") for (int k = 0; k < 2; ++k) dst[n][k] = *(const PG8_LAS bf16x8*)(lds + PG8_SB(b, h) + boff + n * 2048 + k * 1024); } while (0)
#define PG8_MMA(ai, bj, At, Bt) do { __builtin_amdgcn_s_setprio(1); _Pragma("unroll") for (int m = 0; m < 4; ++m) _Pragma("unroll") for (int n = 0; n < 2; ++n) _Pragma("unroll") for (int k = 0; k < 2; ++k) \
        acc[ai][bj][m][n] = __builtin_amdgcn_mfma_f32_16x16x32_bf16(Bt[n][k], At[m][k], acc[ai][bj][m][n], 0, 0, 0); __builtin_amdgcn_s_setprio(0); } while (0)
#define PG8_WAIT_V(n) asm volatile("s_waitcnt vmcnt(" #n ")" ::: "memory")
#define PG8_WAIT_L(n) asm volatile("s_waitcnt lgkmcnt(" #n ")" ::: "memory")
#define PG8_BAR __builtin_amdgcn_s_barrier()
#define PG8_SCHED __builtin_amdgcn_sched_barrier(0)
    Unit cur, nxt; int ui = 0;
    if (!S.next(0, cur)) return;
    f32x4 acc[2][2][4][2];
#pragma unroll
    for (int a = 0; a < 2; ++a)
#pragma unroll
        for (int b = 0; b < 2; ++b)
#pragma unroll
            for (int m = 0; m < 4; ++m)
#pragma unroll
                for (int n = 0; n < 2; ++n) acc[a][b][m][n] = (f32x4){0.f, 0.f, 0.f, 0.f};
    bf16x8 At[4][2], B0[2][2], B1[2][2];
    const char* cA = PG8_SELA(cur.sub) + (size_t)cur.pm * tstep; const char* cB = PG8_SELB(cur.sub) + (size_t)cur.pn * tstep;
    S.a_ready(cur);
    if constexpr (Epi::PRE) E.pre(lds, cur, 0, wid, lane);
    if constexpr (SP2) {
        PG8_STAGE(PG8_SB(0, 0), cB, voffB); PG8_STAGE(PG8_SB(0, 1), cB + hstep, voffB); PG8_STAGE(PG8_SA(0, 0), cA, voffA); PG8_STAGE(PG8_SA(0, 1), cA + hstep, voffA);
        if (wr == 1) PG8_BAR;
        PG8_WAIT_V(2); PG8_BAR;
        PG8_STAGE(PG8_SB(1, 0), cB + kstep, voffB); PG8_STAGE(PG8_SA(1, 0), cA + kstep, voffA); PG8_STAGE(PG8_SB(1, 1), cB + hstep + kstep, voffB);
        PG8_WAIT_V(6); PG8_BAR;
    } else {
        PG8_STAGE(PG8_SB(0, 0), cB, voffB); PG8_STAGE(PG8_SA(0, 0), cA, voffA); PG8_STAGE(PG8_SB(0, 1), cB + hstep, voffB); PG8_STAGE(PG8_SA(0, 1), cA + hstep, voffA);
        if (wr == 1) PG8_BAR;
        PG8_WAIT_V(4); PG8_BAR;
        PG8_STAGE(PG8_SB(1, 0), cB + kstep, voffB); PG8_STAGE(PG8_SA(1, 0), cA + kstep, voffA); PG8_STAGE(PG8_SB(1, 1), cB + hstep + kstep, voffB);
        PG8_WAIT_V(6); PG8_BAR;
    }
    for (;;) {
        const bool has_next = S.next(ui + 1, nxt);
        const char* nA = has_next ? PG8_SELA(nxt.sub) + (size_t)nxt.pm * tstep : cA; const char* nB = has_next ? PG8_SELB(nxt.sub) + (size_t)nxt.pn * tstep : cB;
        for (int t = 0; t < nt; t += 2) {
            const bool last = (t == nt - 2);
            const char* a1 = cA + (size_t)(t + 1) * kstep;
            const char* a2 = last ? nA : cA + (size_t)(t + 2) * kstep; const char* b2 = last ? nB : cB + (size_t)(t + 2) * kstep;
            const char* a3 = a2 + kstep; const char* b3 = b2 + kstep;
            if (last && has_next) { S.a_ready(nxt); if constexpr (Epi::PRE) E.pre(lds, nxt, (ui + 1) & 1, wid, lane); }
            if constexpr (SP2) {
            PG8_LDB(B0, 0, 0); PG8_LDB(B1, 0, 1); PG8_SCHED; PG8_LDA(At, 0, 0); PG8_STAGE(PG8_SA(1, 1), a1 + hstep, voffA);
            PG8_WAIT_V(8); PG8_WAIT_L(0); PG8_BAR; PG8_MMA(0, 0, At, B0); PG8_MMA(0, 1, At, B1); PG8_BAR; PG8_SCHED;
            PG8_LDA(At, 0, 1); PG8_STAGE(PG8_SB(0, 0), b2, voffB); PG8_STAGE(PG8_SB(0, 1), b2 + hstep, voffB); PG8_STAGE(PG8_SA(0, 0), a2, voffA);
            PG8_WAIT_V(8); PG8_WAIT_L(0); PG8_BAR; PG8_MMA(1, 0, At, B0); PG8_MMA(1, 1, At, B1); PG8_BAR; PG8_SCHED;
            PG8_LDB(B0, 1, 0); PG8_LDB(B1, 1, 1); PG8_SCHED; PG8_LDA(At, 1, 0); PG8_STAGE(PG8_SA(0, 1), a2 + hstep, voffA);
            PG8_WAIT_V(8); PG8_WAIT_L(0); PG8_BAR; PG8_MMA(0, 0, At, B0); PG8_MMA(0, 1, At, B1); PG8_BAR; PG8_SCHED;
            PG8_LDA(At, 1, 1); PG8_STAGE(PG8_SB(1, 0), b3, voffB); PG8_STAGE(PG8_SB(1, 1), b3 + hstep, voffB); PG8_STAGE(PG8_SA(1, 0), a3, voffA);
            PG8_WAIT_V(8); PG8_WAIT_L(0); PG8_BAR; PG8_MMA(1, 0, At, B0); PG8_MMA(1, 1, At, B1);
            if constexpr (Epi::SPLIT) { if (last) { PG8_SCHED; E.template part<0>(acc, cur, wr, wc, fr, fq, lds, ui & 1); } }
            PG8_BAR; PG8_SCHED;
            } else {
            PG8_LDB(B0, 0, 0); PG8_SCHED; PG8_LDA(At, 0, 0); PG8_STAGE(PG8_SA(1, 1), a1 + hstep, voffA);
            PG8_WAIT_L(8); PG8_BAR; PG8_WAIT_L(0); PG8_MMA(0, 0, At, B0); PG8_BAR; PG8_SCHED;
            PG8_LDB(B1, 0, 1); PG8_STAGE(PG8_SB(0, 0), b2, voffB);
            PG8_BAR; PG8_WAIT_L(0); PG8_MMA(0, 1, At, B1); PG8_BAR;
            PG8_LDA(At, 0, 1); PG8_STAGE(PG8_SA(0, 0), a2, voffA);
            PG8_BAR; PG8_WAIT_L(0); PG8_MMA(1, 0, At, B0); PG8_BAR; PG8_SCHED;
            PG8_STAGE(PG8_SB(0, 1), b2 + hstep, voffB);
            PG8_WAIT_V(6); PG8_BAR; PG8_MMA(1, 1, At, B1); PG8_BAR;
            PG8_LDB(B0, 1, 0); PG8_SCHED; PG8_LDA(At, 1, 0); PG8_STAGE(PG8_SA(0, 1), a2 + hstep, voffA);
            PG8_WAIT_L(8); PG8_BAR; PG8_WAIT_L(0); PG8_MMA(0, 0, At, B0); PG8_BAR; PG8_SCHED;
            PG8_LDB(B1, 1, 1); PG8_STAGE(PG8_SB(1, 0), b3, voffB);
            PG8_BAR; PG8_WAIT_L(0); PG8_MMA(0, 1, At, B1); PG8_BAR;
            PG8_LDA(At, 1, 1); PG8_STAGE(PG8_SA(1, 0), a3, voffA);
            PG8_BAR; PG8_WAIT_L(0); PG8_MMA(1, 0, At, B0); PG8_BAR; PG8_SCHED;
            PG8_STAGE(PG8_SB(1, 1), b3 + hstep, voffB);
            PG8_WAIT_V(6); PG8_BAR; PG8_MMA(1, 1, At, B1); PG8_BAR;
            }
        }
        if constexpr (ALIGN_EPI) { if (wr == 0) PG8_BAR; }
        if constexpr (Epi::SPLIT) { E.template part<1>(acc, cur, wr, wc, fr, fq, lds, ui & 1); S.done(cur); }
        else if constexpr (Epi::PRE) { E.template part<0>(acc, cur, wr, wc, fr, fq, lds, ui & 1); E.template part<1>(acc, cur, wr, wc, fr, fq, lds, ui & 1); S.done(cur); }
        else if constexpr (!Epi::AFTER_DRAIN) { E(acc, cur, wr, wc, fr, fq); S.done(cur); }
        if (!has_next) break;
#pragma unroll
        for (int a = 0; a < 2; ++a)
#pragma unroll
            for (int b = 0; b < 2; ++b)
#pragma unroll
                for (int m = 0; m < 4; ++m)
#pragma unroll
                    for (int n = 0; n < 2; ++n) acc[a][b][m][n] = (f32x4){0.f, 0.f, 0.f, 0.f};
        cur = nxt; cA = nA; cB = nB; ++ui;
        if constexpr (ALIGN_EPI) { if (wr == 1) PG8_BAR; }
    }
    PG8_WAIT_V(0);
    if constexpr (!ALIGN_EPI) { if (wr == 0) PG8_BAR; }
    PG8_BAR;
    if constexpr (Epi::AFTER_DRAIN) { E.fused(acc, cur, wr, wc, fr, fq, lds, wid, lane); S.done(cur); }
#undef PG8_SA
#undef PG8_SELA
#undef PG8_SELB
#undef PG8_SB
#undef PG8_STAGE
#undef PG8_LDA
#undef PG8_LDB
#undef PG8_MMA
#undef PG8_WAIT_V
#undef PG8_WAIT_L
#undef PG8_BAR
#undef PG8_SCHED
}
}

#include <hip/hip_bf16.h>
#include <cmath>
namespace attn_body {
using bf16=__hip_bfloat16;
using bf16x8=__attribute__((ext_vector_type(8)))short;
using s16x4=__attribute__((ext_vector_type(4)))short;
using f32x16=__attribute__((ext_vector_type(16)))float;
using u32x4=__attribute__((ext_vector_type(4)))unsigned;
constexpr int BATCH=16,NHEAD=8,SEQ=2048,D=64,DM=NHEAD*D;
constexpr int NW=8,QBLK=32,QB=QBLK*NW,KVBLK=64,NQB=SEQ/QB;
constexpr int ATTN_PITCH=DM, ATTN_UNIT_ROWS=QB;
__device__ __forceinline__ int crow(int r,int hi){return (r&3)+8*(r>>2)+4*hi;}
#define SBAR() __builtin_amdgcn_sched_barrier(0)
__device__ __forceinline__ void cmask(f32x16&p0,f32x16&p1,int jb,int qrel,int hi){
  const float NEG=-INFINITY; int kb=64*jb+4*hi;
  #pragma unroll
  for(int r=0;r<16;++r){int kv=kb+(r&3)+8*(r>>2); if(kv>qrel)p0[r]=NEG; if(kv+32>qrel)p1[r]=NEG;}
}

constexpr int NSLOT=3, SLOTB=8192;
constexpr int LDS_K=0, LDS_V=NSLOT*SLOTB, LDS_WS=2*NSLOT*SLOTB, LDS_OST=LDS_WS+NW*64*4, LDS_F=LDS_OST+NW*4096, LDS_FW=LDS_F+SEQ*4, LDS_BYTES=LDS_FW+64;
constexpr float C2=0.125f*1.4426950408889634f;
__device__ __forceinline__ void glds16(const void*gsrc,unsigned lds_dst){unsigned keep;
  asm volatile("s_mov_b32 %0, m0\n\ts_mov_b32 m0, %2\n\ts_nop 0\n\tglobal_load_lds_dwordx4 %1, off\n\ts_mov_b32 m0, %0":"=&s"(keep):"v"(gsrc),"s"(lds_dst):"memory");}
__device__ __forceinline__ float max3f(float a,float b,float c){float r;asm("v_max3_f32 %0, %1, %2, %3":"=v"(r):"v"(a),"v"(b),"v"(c));return r;}
__device__ __forceinline__ float max2f(float a,float b){float r;asm("v_max_f32_e32 %0, %1, %2":"=v"(r):"v"(a),"v"(b));return r;}
__device__ __forceinline__ float fadd_s(float a,float b){float r;asm("v_add_f32_e32 %0, %1, %2":"=v"(r):"v"(a),"v"(b));return r;}
__device__ __forceinline__ float fsub_s(float a,float b){float r;asm("v_sub_f32_e32 %0, %1, %2":"=v"(r):"v"(a),"v"(b));return r;}
typedef float f32x2_t __attribute__((ext_vector_type(2))); typedef __bf16 bf16x2_t __attribute__((ext_vector_type(2)));
__device__ __forceinline__ unsigned cvtpk_s(float lo,float hi){f32x2_t v={lo,hi};bf16x2_t b=__builtin_convertvector(v,bf16x2_t);return __builtin_bit_cast(unsigned,b);}
#define WAIT_BAR(N) asm volatile("s_waitcnt vmcnt(" #N ") lgkmcnt(0)\n\ts_barrier":::"memory")

__device__ __forceinline__ void qkt(f32x16&p0,f32x16&p1,const char*Kslot,const bf16x8*qr,const f32x16&negm,int r32,int hi){
  const char*kb=Kslot+hi*1024+r32*16;
  #pragma unroll
  for(int d0=0;d0<4;++d0){
    const bf16x8 b0=*reinterpret_cast<const bf16x8*>(kb+d0*2048);
    const bf16x8 b1=*reinterpret_cast<const bf16x8*>(kb+d0*2048+512);
    if(d0==0){p0=__builtin_amdgcn_mfma_f32_32x32x16_bf16(b0,qr[0],negm,0,0,0);p1=__builtin_amdgcn_mfma_f32_32x32x16_bf16(b1,qr[0],negm,0,0,0);}
    else{p0=__builtin_amdgcn_mfma_f32_32x32x16_bf16(b0,qr[d0],p0,0,0,0);p1=__builtin_amdgcn_mfma_f32_32x32x16_bf16(b1,qr[d0],p1,0,0,0);}}
}
typedef __attribute__((address_space(3))) const char* lds_cptr;
typedef short v4i16_t __attribute__((ext_vector_type(4)));
__device__ __forceinline__ void kload8(bf16x8*kf,lds_cptr kp){
  kf[0]=*(const __attribute__((address_space(3))) bf16x8*)(kp);      kf[1]=*(const __attribute__((address_space(3))) bf16x8*)(kp+512);
  kf[2]=*(const __attribute__((address_space(3))) bf16x8*)(kp+2048); kf[3]=*(const __attribute__((address_space(3))) bf16x8*)(kp+2560);
  kf[4]=*(const __attribute__((address_space(3))) bf16x8*)(kp+4096); kf[5]=*(const __attribute__((address_space(3))) bf16x8*)(kp+4608);
  kf[6]=*(const __attribute__((address_space(3))) bf16x8*)(kp+6144); kf[7]=*(const __attribute__((address_space(3))) bf16x8*)(kp+6656);
}
__device__ __forceinline__ void kload2(bf16x8*kf,lds_cptr kp,int j){ kf[2*j]=*(const __attribute__((address_space(3))) bf16x8*)(kp+j*2048); kf[2*j+1]=*(const __attribute__((address_space(3))) bf16x8*)(kp+j*2048+512); }
__device__ __forceinline__ s16x4 vtr(lds_cptr p){ return __builtin_bit_cast(s16x4,__builtin_amdgcn_ds_read_tr16_b64_v4i16((__attribute__((address_space(3))) v4i16_t*)p)); }
__device__ __forceinline__ float rowmax(const f32x16&p0,const f32x16&p1){
  float a=max3f(p0[0],p0[1],p1[0]),b=max3f(p0[2],p0[3],p1[1]);a=max3f(a,p1[2],p1[3]);
  #pragma unroll
  for(int r=4;r<16;r+=4){a=max3f(a,p0[r],p0[r+1]);b=max3f(b,p0[r+2],p0[r+3]);a=max3f(a,p1[r],p1[r+1]);b=max3f(b,p1[r+2],p1[r+3]);}
  const float m=max2f(a,b);
  auto rr=__builtin_amdgcn_permlane32_swap(__float_as_uint(m),__float_as_uint(m),false,false);
  return max2f(__uint_as_float(rr[0]),__uint_as_float(rr[1]));
}
__device__ __forceinline__ void pv(f32x16*o,int vb,bf16x8 pa0,bf16x8 pa1,bf16x8 pa2,bf16x8 pa3){
  #pragma unroll
  for(int d0=0;d0<2;++d0){s16x4 lo[4],hi[4];
    #pragma unroll
    for(int ks=0;ks<4;++ks){
      asm volatile("ds_read_b64_tr_b16 %0,%1 offset:%c2":"=&v"(lo[ks]):"v"(vb),"i"(d0*4096+ks*1024):"memory");
      asm volatile("ds_read_b64_tr_b16 %0,%1 offset:%c2":"=&v"(hi[ks]):"v"(vb),"i"(d0*4096+ks*1024+512):"memory");}
    asm volatile("s_waitcnt lgkmcnt(0)":::"memory");SBAR();
    #define PK(k) (bf16x8){lo[k][0],lo[k][1],lo[k][2],lo[k][3],hi[k][0],hi[k][1],hi[k][2],hi[k][3]}
    o[d0]=__builtin_amdgcn_mfma_f32_32x32x16_bf16(pa0,PK(0),o[d0],0,0,0);
    o[d0]=__builtin_amdgcn_mfma_f32_32x32x16_bf16(pa1,PK(1),o[d0],0,0,0);
    o[d0]=__builtin_amdgcn_mfma_f32_32x32x16_bf16(pa2,PK(2),o[d0],0,0,0);
    o[d0]=__builtin_amdgcn_mfma_f32_32x32x16_bf16(pa3,PK(3),o[d0],0,0,0);
    #undef PK
  }
}

#ifndef ATTN_STORE16
#define ATTN_STORE16(p,v) (*(u32x4*)(p)=(v))
#endif
typedef float f32x4v __attribute__((ext_vector_type(4)));
__device__ __forceinline__ float logsig(float x){ return fminf(x,0.f)-__logf(1.f+__expf(-fabsf(x))); }
template<int THRL> __device__ __forceinline__ void attn_unit(int b,int h,int qb,const bf16*Q,const bf16*__restrict__ K,const bf16*__restrict__ V,bf16*O,char*shm,const float*__restrict__ flog,float bfh,bool newbh){
  int tid_=threadIdx.x; asm volatile("":"+v"(tid_)); const int tid=tid_,lane=tid&63,r32=lane&31,hi=lane>>5; const int wid=__builtin_amdgcn_readfirstlane(tid>>6);
  const long rowbase=(long)b*SEQ; const int q0=qb*QB;
  const bf16*Qw=Q+(rowbase+q0+wid*QBLK)*DM+h*D;
  const bf16*Kh=K+rowbase*DM+h*D,*Vh=V+rowbase*DM+h*D;
  const unsigned lds0=(unsigned)(uintptr_t)shm;
  float*wsf=(float*)(shm+LDS_WS)+wid*64;
  const bf16*ksrc=Kh+(long)lane*DM+wid*8;
  const bf16*vsrc=Vh+(long)(16*(wid&3)+(lane>>2))*DM+(wid>>2)*32+(lane&3)*8;
  const unsigned kdst=lds0+LDS_K+wid*1024, vdst=lds0+LDS_V+wid*1024;
  #define DMA_K(t,slot) glds16(ksrc+(long)(t)*KVBLK*DM,(unsigned)__builtin_amdgcn_readfirstlane(kdst+(slot)))
  #define DMA_V(t,slot) glds16(vsrc+(long)(t)*KVBLK*DM,(unsigned)__builtin_amdgcn_readfirstlane(vdst+(slot)))
  const int vb0=(int)(lds0+LDS_V)+((lane>>4)&1)*32+(lane&3)*8+(4*hi+((lane&15)>>2))*64;
  const char*Kbase=shm+LDS_K; bf16x8 kf[8];
  const lds_cptr shm3=(lds_cptr)shm; const lds_cptr kp0=shm3+LDS_K+hi*1024+r32*16; const lds_cptr vp0=shm3+LDS_V+((lane>>4)&1)*32+(lane&3)*8+(4*hi+((lane&15)>>2))*64;
  const int NT=(q0+QB)/KVBLK;
  typedef __attribute__((address_space(3))) float* lds_fptr;
  const lds_fptr fs3=(lds_fptr)(shm3+LDS_F); const lds_fptr fw3=(lds_fptr)(shm3+LDS_FW);
  if(newbh){ float v0=0.f,v1=0.f,v2=0.f,v3=0.f; const int t0=4*tid;
    { const float*fp=flog+(rowbase+t0)*NHEAD+h; v0=logsig(fp[0]+bfh); v1=logsig(fp[NHEAD]+bfh); v2=logsig(fp[2*NHEAD]+bfh); v3=logsig(fp[3*NHEAD]+bfh); }
    v1+=v0; v2+=v1; v3+=v2; float inc=v3;
    #pragma unroll
    for(int o=1;o<64;o<<=1){ const float nb=__shfl_up(inc,o); if(lane>=o)inc+=nb; }
    if(lane==63)fw3[wid]=inc;
    asm volatile("s_waitcnt lgkmcnt(0)\n\ts_barrier":::"memory");
    float woff=0.f;
    #pragma unroll
    for(int w_=0;w_<NW;++w_){ const float tw=fw3[w_]; if(w_<wid)woff+=tw; }
    const float ex=woff+(inc-v3); const float L2E=1.4426950408889634f;
    *(__attribute__((address_space(3))) f32x4v*)(fs3+t0)=(f32x4v){(v0+ex)*L2E,(v1+ex)*L2E,(v2+ex)*L2E,(v3+ex)*L2E};
    asm volatile("s_waitcnt lgkmcnt(0)\n\ts_barrier":::"memory"); }
  const float fq2=fs3[q0+wid*QBLK+r32];
  #define FKSUB(P0,P1,t) do{ const lds_fptr fk_=fs3+(t)*KVBLK+4*hi; \
    _Pragma("unroll") for(int r_=0;r_<16;++r_){ P0[r_]+=nq; P1[r_]+=nq; } \
    _Pragma("unroll") for(int j_=0;j_<4;++j_){ { const f32x4v a_=*(const __attribute__((address_space(3))) f32x4v*)(fk_+8*j_); \
      _Pragma("unroll") for(int i_=0;i_<4;++i_) P0[4*j_+i_]-=a_[i_]; } SBAR(); \
      { const f32x4v b_=*(const __attribute__((address_space(3))) f32x4v*)(fk_+32+8*j_); \
      _Pragma("unroll") for(int i_=0;i_<4;++i_) P1[4*j_+i_]-=b_[i_]; } SBAR(); } }while(0)
  #define INITRD(P0,P1,tt) do{ const lds_fptr fk_=fs3+(tt)*KVBLK+4*hi; \
    _Pragma("unroll") for(int j_=0;j_<4;++j_){ const f32x4v a_=*(const __attribute__((address_space(3))) f32x4v*)(fk_+8*j_); const f32x4v b_=*(const __attribute__((address_space(3))) f32x4v*)(fk_+32+8*j_); \
      _Pragma("unroll") for(int i_=0;i_<4;++i_){ P0[4*j_+i_]=a_[i_]; P1[4*j_+i_]=b_[i_]; } } }while(0)
  #define INITSUB(P0,P1) do{ _Pragma("unroll") for(int r_=0;r_<16;++r_){ P0[r_]=nq-P0[r_]; P1[r_]=nq-P1[r_]; } }while(0)
  DMA_K(0,0);DMA_V(0,0);DMA_K(1,SLOTB);
  bf16x8 qr[4];
  #pragma unroll
  for(int d0=0;d0<4;++d0)qr[d0]=*reinterpret_cast<const bf16x8*>(&Qw[(long)r32*DM+d0*16+hi*8]);
  float mhat=0.f,l_reg=0.f;f32x16 o[2];o[0]=f32x16{};o[1]=f32x16{};const f32x16 negm=f32x16{}; float nq=fq2;
  const int qrel=wid*QBLK+r32;
  #define CMASK(P0,P1,t) do{int jb_=(t)-(NT-4); if(jb_>=0)cmask(P0,P1,jb_,qrel,hi);}while(0)
  bool resc=false;
  #define START(P0,P1) do{ const float rm=rowmax(P0,P1); resc=false; \
    { const float dl=max2f(rm,0.f); mhat=fadd_s(mhat,dl);     \
      _Pragma("unroll") for(int r=0;r<16;++r){P0[r]=fsub_s(P0[r],dl);P1[r]=fsub_s(P1[r],dl);} \
      nq=fq2-mhat; } \
    _Pragma("unroll") for(int r=0;r<16;++r)P0[r]=__builtin_amdgcn_exp2f(P0[r]); }while(0)
  #define RESC() do{ if(resc){ asm volatile("s_waitcnt lgkmcnt(0)":::"memory"); \
      _Pragma("unroll") for(int d_=0;d_<2;++d_) _Pragma("unroll") for(int r=0;r<16;++r)o[d_][r]*=wsf[crow(r,hi)]; } }while(0)
  f32x16 pA0,pA1,pB0,pB1;
  int sl_prev=0,sl_cur=0,sl_next=SLOTB;
  #define ROT() do{sl_prev=sl_cur;sl_cur=sl_next;sl_next=(sl_next==(NSLOT-1)*SLOTB)?0:sl_next+SLOTB;}while(0)
  DMA_K(2,2*SLOTB);
  WAIT_BAR(3);
  qkt(pA0,pA1,Kbase,qr,negm,r32,hi);asm volatile("s_nop 15\n\ts_nop 7":"+v"(pA0),"+v"(pA1));FKSUB(pA0,pA1,0);CMASK(pA0,pA1,0);
  START(pA0,pA1);
  _Pragma("unroll") for(int r=0;r<16;++r)pA1[r]=__builtin_amdgcn_exp2f(pA1[r]);
  INITRD(pB0,pB1,1); INITSUB(pB0,pB1);
  WAIT_BAR(0);
  DMA_K(3,0);DMA_V(1,SLOTB);
  ROT();
  kload8(kf,kp0+sl_cur);
  WAIT_BAR(2);
  s16x4 vlo[8],vhi[8]; u32x4 pw0,pw1,pw2,pw3;
  #define PKW(P,B) cvtpk_s(P[B],P[B+1])
  #define PAF(k) __builtin_bit_cast(bf16x8,pw##k)
  #define VFR(i) (bf16x8){vlo[i][0],vlo[i][1],vlo[i][2],vlo[i][3],vhi[i][0],vhi[i][1],vhi[i][2],vhi[i][3]}
  #define PIN(x) asm volatile("":"+v"(x))
  #define MX3(a,b,c) __builtin_fmaxf(__builtin_fmaxf((a),(b)),(c))
  #define GAPA(MF,A0,A1,A2,A3,W0,W1,PW) do{ MF; sacc+=A0; sacc+=A1; sacc+=A2; sacc+=A3; PIN(sacc); W0; W1; PIN(PW); SBAR(); }while(0)
  #define EX(v) __builtin_amdgcn_exp2f(v)
  #define GAPB(MF,X,B) do{ MF; X[B]=EX(X[B]); X[B+1]=EX(X[B+1]); X[B+2]=EX(X[B+2]); X[B+3]=EX(X[B+3]); PIN(X); SBAR(); }while(0)
  #define VRD(i) do{ vlo[i]=vtr(vp_+(((i)>>2)*4096+((i)&3)*1024)); vhi[i]=vtr(vp_+(((i)>>2)*4096+((i)&3)*1024+512)); }while(0)
  #define KRD(G,j) do{ if(G){ kload2(kf,kp0+sl_next,j); SBAR(); } }while(0)
  #define STEP(C0,C1,P0,P1,t,GK,GV,GL) do{ SBAR(); \
    const lds_cptr vp_=vp0+sl_prev; \
    VRD(0); SBAR(); float sacc=(P0[0]+P0[1]); \
    GAPA(C0=__builtin_amdgcn_mfma_f32_32x32x16_bf16(kf[0],qr[0],C0,0,0,0), P0[2],P0[3],P0[4],P0[5],     pw0[0]=PKW(P0,0), pw0[1]=PKW(P0,2), pw0); \
    VRD(4); SBAR(); GAPA(C1=__builtin_amdgcn_mfma_f32_32x32x16_bf16(kf[1],qr[0],C1,0,0,0), P0[6],P0[7],P0[8],P0[9],     pw0[2]=PKW(P0,4), pw0[3]=PKW(P0,6), pw0); \
    VRD(1); SBAR(); GAPA(C0=__builtin_amdgcn_mfma_f32_32x32x16_bf16(kf[2],qr[1],C0,0,0,0),   P0[10],P0[11],P0[12],P0[13], pw1[0]=PKW(P0,8), pw1[1]=PKW(P0,10), pw1); \
    VRD(5); SBAR(); GAPA(C1=__builtin_amdgcn_mfma_f32_32x32x16_bf16(kf[3],qr[1],C1,0,0,0),   P0[14],P0[15],P1[0],P1[1],   pw1[2]=PKW(P0,12),pw1[3]=PKW(P0,14), pw1); \
    VRD(2); SBAR(); GAPA(C0=__builtin_amdgcn_mfma_f32_32x32x16_bf16(kf[4],qr[2],C0,0,0,0),   P1[2],P1[3],P1[4],P1[5],     pw2[0]=PKW(P1,0), pw2[1]=PKW(P1,2), pw2); \
    VRD(6); SBAR(); GAPA(C1=__builtin_amdgcn_mfma_f32_32x32x16_bf16(kf[5],qr[2],C1,0,0,0),   P1[6],P1[7],P1[8],P1[9],     pw2[2]=PKW(P1,4), pw2[3]=PKW(P1,6), pw2); \
    VRD(3); SBAR(); GAPA(C0=__builtin_amdgcn_mfma_f32_32x32x16_bf16(kf[6],qr[3],C0,0,0,0),   P1[10],P1[11],P1[12],P1[13], pw3[0]=PKW(P1,8), pw3[1]=PKW(P1,10), pw3); \
    VRD(7); SBAR(); GAPA(C1=__builtin_amdgcn_mfma_f32_32x32x16_bf16(kf[7],qr[3],C1,0,0,0),   P1[14],P1[15],0.f,0.f,       pw3[2]=PKW(P1,12),pw3[3]=PKW(P1,14), pw3); \
    l_reg+=sacc; \
    if(GK){DMA_K((t)+3,sl_cur);} if(GV){DMA_V((t)+1,sl_next);} \
    CMASK(C0,C1,t); \
    { float a=MX3(C0[0],C0[1],C1[0]),b=MX3(C0[2],C0[3],C1[1]); a=MX3(a,C1[2],C1[3]); \
      _Pragma("unroll") for(int r=4;r<16;r+=4){a=MX3(a,C0[r],C0[r+1]);b=MX3(b,C0[r+2],C0[r+3]);a=MX3(a,C1[r],C1[r+1]);b=MX3(b,C1[r+2],C1[r+3]);} \
      float rm=__builtin_fmaxf(a,b); { auto rr=__builtin_amdgcn_permlane32_swap(__float_as_uint(rm),__float_as_uint(rm),false,false); rm=__builtin_fmaxf(__uint_as_float(rr[0]),__uint_as_float(rr[1])); } \
      resc=false; \
      if(__builtin_expect(__any(rm>(float)THRL),0)){ const float dl=__builtin_fmaxf(rm,0.f); mhat+=dl; \
        _Pragma("unroll") for(int r=0;r<16;++r){C0[r]-=dl;C1[r]-=dl;} \
        nq=fq2-mhat; \
        const float f=__builtin_amdgcn_exp2f(-dl); l_reg*=f; if(hi==0)wsf[r32]=f; resc=true; } } \
    SBAR(); if(GL){INITRD(P0,P1,(t)+1);} SBAR(); \
    GAPB(o[0]=__builtin_amdgcn_mfma_f32_32x32x16_bf16(PAF(0),VFR(0),o[0],0,0,0), C0,0); \
    GAPB(o[1]=__builtin_amdgcn_mfma_f32_32x32x16_bf16(PAF(0),VFR(4),o[1],0,0,0), C0,4); \
    KRD(GL,0); GAPB(o[0]=__builtin_amdgcn_mfma_f32_32x32x16_bf16(PAF(1),VFR(1),o[0],0,0,0), C0,8); \
    KRD(GL,1); GAPB(o[1]=__builtin_amdgcn_mfma_f32_32x32x16_bf16(PAF(1),VFR(5),o[1],0,0,0), C0,12); \
    KRD(GL,2); GAPB(o[0]=__builtin_amdgcn_mfma_f32_32x32x16_bf16(PAF(2),VFR(2),o[0],0,0,0), C1,0); \
    KRD(GL,3); GAPB(o[1]=__builtin_amdgcn_mfma_f32_32x32x16_bf16(PAF(2),VFR(6),o[1],0,0,0), C1,4); \
    GAPB(o[0]=__builtin_amdgcn_mfma_f32_32x32x16_bf16(PAF(3),VFR(3),o[0],0,0,0), C1,8); \
    GAPB(o[1]=__builtin_amdgcn_mfma_f32_32x32x16_bf16(PAF(3),VFR(7),o[1],0,0,0), C1,12); \
    if(GL){INITSUB(P0,P1);} \
    }while(0)
  int t=1;
  #undef CMASK
  #define CMASK(P0,P1,t) do{}while(0)
  for(;t+5<NT;t+=2){
    STEP(pB0,pB1,pA0,pA1,t,true,true,true);     WAIT_BAR(2); RESC(); ROT();
    STEP(pA0,pA1,pB0,pB1,t+1,true,true,true);   WAIT_BAR(2); RESC(); ROT();
  }
  #undef CMASK
  #define CMASK(P0,P1,t) do{int jb_=(t)-(NT-4); if(jb_>=0)cmask(P0,P1,jb_,qrel,hi);}while(0)
  #define ENDW(tt) do{ if((tt)+3<NT){WAIT_BAR(2);} else if((tt)+2<NT){WAIT_BAR(1);} else {WAIT_BAR(0);} }while(0)
  for(;t+1<NT;t+=2){
    STEP(pB0,pB1,pA0,pA1,t,(t+3<NT),(t+1<NT),(t+1<NT));       ENDW(t);   RESC(); ROT();
    STEP(pA0,pA1,pB0,pB1,t+1,(t+4<NT),(t+2<NT),(t+2<NT));     ENDW(t+1); RESC(); ROT();
  }
  STEP(pB0,pB1,pA0,pA1,NT-1,false,false,false); RESC();
  { float sacc=pB0[0]+pB0[1]; _Pragma("unroll") for(int r=2;r<16;++r)sacc+=pB0[r]; _Pragma("unroll") for(int r=0;r<16;++r)sacc+=pB1[r]; l_reg+=sacc;
    pw0=(u32x4){PKW(pB0,0),PKW(pB0,2),PKW(pB0,4),PKW(pB0,6)};pw1=(u32x4){PKW(pB0,8),PKW(pB0,10),PKW(pB0,12),PKW(pB0,14)};pw2=(u32x4){PKW(pB1,0),PKW(pB1,2),PKW(pB1,4),PKW(pB1,6)};pw3=(u32x4){PKW(pB1,8),PKW(pB1,10),PKW(pB1,12),PKW(pB1,14)};
    SBAR(); pv(o,vb0+sl_cur,PAF(0),PAF(1),PAF(2),PAF(3)); }
  #undef PKW
  #undef PAF
  #undef VFR
  #undef PIN
  #undef MX3
  #undef GAPA
  #undef GAPB
  #undef EX
  #undef VRD
  #undef KRD
  #undef STEP
  #undef ENDW
  {auto rr=__builtin_amdgcn_permlane32_swap(__float_as_uint(l_reg),__float_as_uint(l_reg),false,false);l_reg=__uint_as_float(rr[0])+__uint_as_float(rr[1]);}
  if(hi==0)wsf[32+r32]=l_reg;asm volatile("s_waitcnt lgkmcnt(0)":::"memory");
  float rli[16];
  #pragma unroll
  for(int r=0;r<16;++r)rli[r]=__builtin_amdgcn_rcpf(wsf[32+crow(r,hi)]);
  bf16*Ow=O+(rowbase+q0+wid*QBLK)*DM+h*D;
  { bf16*stg=(bf16*)(shm+LDS_OST)+wid*2048;
    #pragma unroll
    for(int r=0;r<16;++r){const int orow=crow(r,hi);
      #pragma unroll
      for(int d0=0;d0<2;++d0)stg[orow*64+d0*32+r32]=__float2bfloat16(o[d0][r]*rli[r]);}
    asm volatile("s_waitcnt lgkmcnt(0)":::"memory");
    #pragma unroll
    for(int i=0;i<4;++i){const int row=i*8+(lane>>3),ch=lane&7; const u32x4 v=*(const u32x4*)(stg+row*64+ch*8); ATTN_STORE16(Ow+(long)row*DM+ch*8,v);} }
  asm volatile("s_waitcnt lgkmcnt(0)\n\ts_barrier":::"memory");
  #undef FKSUB
  #undef INITRD
  #undef INITSUB
  #undef DMA_K
  #undef DMA_V
  #undef CMASK
  #undef START
  #undef RESC
  #undef ROT
}
constexpr int ATTN_LDS_BYTES=LDS_BYTES;
struct AttnTensors { const bf16* Q; const bf16* K; const bf16* V; bf16* O; const float* flog; const float* bf; };
struct AttnUnit { int bh; int qb; };
struct StaticOrder {
  int vcu,G;
  __device__ __forceinline__ explicit StaticOrder(int grid,int v):vcu(v),G(grid){}
  __device__ __forceinline__ bool next(int i,AttnUnit&u)const{
    if(G==256){ if(i>=4)return false; const int s=vcu&1; u.bh=vcu>>1; u.qb=(i==0)?7-s:(i==1)?4+s:(i==2)?3-s:s; return true; }
    const int idx=i*G+vcu; if(idx>=BATCH*NHEAD*NQB)return false; u.bh=idx>>3; u.qb=7-(idx&7); return true; }
  __device__ __forceinline__ void a_ready(const AttnUnit&)const{}
  __device__ __forceinline__ void done(const AttnUnit&)const{}
};
template<class Sched,int THRL=8> __device__ __forceinline__ void attn_phase(char*lds,const AttnTensors&T,const Sched&S){
  AttnUnit u; int prevbh=-1;
  for(int i=0;S.next(i,u);++i){ S.a_ready(u); attn_unit<THRL>(u.bh/NHEAD,u.bh%NHEAD,u.qb,T.Q,T.K,T.V,T.O,lds,T.flog,T.bf[u.bh%NHEAD],u.bh!=prevbh); prevbh=u.bh; S.done(u); }
}
#undef SBAR
#undef WAIT_BAR
}
namespace cg = cooperative_groups;
constexpr int NWAVES = 8;
constexpr int BATCH = 16, SEQ = 2048, DMODEL = 1024, MROWS = BATCH * SEQ, NHEADS = 8, AW = 512, FFH = 2816, NIN = 6912, NINSRC = 6664, DEPTH = 2;
constexpr size_t MiB = 1u << 20, KiB512 = 512u << 10;
constexpr size_t WS_SSQ = 0;
constexpr size_t WS_FLOG = 3 * MiB;
constexpr size_t WS_WIN = 4 * MiB;
constexpr size_t WS_WL = 18 * MiB, WL_STRIDE = 21 * MiB + MiB / 2;
constexpr size_t WL_A = 0, WL_B = 1 * MiB, WL_C = 2 * MiB, WL_OUT = 3 * MiB, WL_GU = 5 * MiB, WL_DN = 16 * MiB;
constexpr size_t WS_XB = 61 * MiB;
constexpr size_t WS_QA = 125 * MiB, WS_K = 157 * MiB, WS_V = 189 * MiB, WS_MIX = 157 * MiB;
constexpr size_t WS_U = 221 * MiB, WS_Z = 253 * MiB, WS_CB = 285 * MiB, WS_G = 317 * MiB;
constexpr size_t WS_ACT = 125 * MiB;
constexpr size_t WS_END = 509 * MiB;
static_assert(WS_K == WS_QA + 32 * MiB && WS_V == WS_QA + 64 * MiB && WS_U == WS_QA + 96 * MiB && WS_Z == WS_QA + 128 * MiB && WS_CB == WS_QA + 160 * MiB, "EpiIn addresses Q|K|V|U|Z|CB as six consecutive blocks");
static_assert(WS_WL + 2 * WL_STRIDE <= WS_XB && WS_G + (size_t)MROWS * 3072 * 2 <= WS_END && WS_ACT + (size_t)MROWS * FFH * 2 <= WS_G, "d_ws map");
constexpr int RING_BYTES = 131072, LDS_BYTES = 147456;

#define GAS __attribute__((address_space(1)))
#define LAS __attribute__((address_space(3)))
typedef unsigned short bf16;
typedef unsigned v4u __attribute__((ext_vector_type(4)));
typedef float f32x4 __attribute__((ext_vector_type(4)));
#define LDS_WAIT() asm volatile("s_waitcnt lgkmcnt(0)" ::: "memory")
__device__ __forceinline__ unsigned f2bf(float f) { unsigned u = __builtin_bit_cast(unsigned, f); return (u + 0x7fffu + ((u >> 16) & 1u)) >> 16; }
__device__ __forceinline__ unsigned pk2(float lo, float hi) { return f2bf(lo) | (f2bf(hi) << 16); }
__device__ __forceinline__ float wave_sum(float v) {
#pragma unroll
    for (int o = 1; o < 64; o <<= 1) v += __shfl_xor(v, o);
    return v;
}
struct CmId { __device__ __forceinline__ int operator()(int n) const { return n; } };
struct CmIn { __device__ __forceinline__ int operator()(int n) const {
    if (n < 1536) return n;
    if (n < 2048) return n + 8;
    if (n < 3072) { const int j = (n - 2048) >> 8, w = (n - 2048) & 255; return w < 128 ? 2056 + 128 * j + w : 3080 + 128 * j + (w - 128); }
    if (n < 3584) return 2568 + (n - 3072);
    if (n < 6656) return n + 8;
    if (n < 6664) return 1536 + (n - 6656);
    return -1; } };
struct CmGU { __device__ __forceinline__ int operator()(int n) const { const int j = n >> 8, w = n & 255; return w < 128 ? 128 * j + w : FFH + 128 * j + (w - 128); } };
__device__ __forceinline__ void wb_item(const float* pool_w, const float* pscale, const float* wpp, bf16* WBt, int item, int lane) {
    const int nb = (item >> 3) & 15, c8 = (item & 7) + 8 * (item >> 7), n = 64 * nb + lane, c0 = 8 * c8, g = c0 >> 7, cl = c0 & 127;
    float a0 = 0.f, a1 = 0.f, a2 = 0.f, a3 = 0.f, a4 = 0.f, a5 = 0.f, a6 = 0.f, a7 = 0.f;
    const float* pw = pool_w + ((size_t)g * 128 + cl) * 128;
#pragma unroll 2
    for (int d = 0; d < 128; d += 4) {
        const f32x4 ps = *(const GAS f32x4*)(pscale + g * 128 + d);
        const float w0 = wpp[(size_t)(g * 128 + d) * 1024 + n] * ps[0], w1 = wpp[(size_t)(g * 128 + d + 1) * 1024 + n] * ps[1], w2 = wpp[(size_t)(g * 128 + d + 2) * 1024 + n] * ps[2], w3 = wpp[(size_t)(g * 128 + d + 3) * 1024 + n] * ps[3];
#define WB_ROW(acc_, j_) { const f32x4 p_ = *(const GAS f32x4*)(pw + (j_) * 128 + d); acc_ += (p_[0] * w0 + p_[1] * w1) + (p_[2] * w2 + p_[3] * w3); }
        WB_ROW(a0, 0) WB_ROW(a1, 1) WB_ROW(a2, 2) WB_ROW(a3, 3) WB_ROW(a4, 4) WB_ROW(a5, 5) WB_ROW(a6, 6) WB_ROW(a7, 7)
#undef WB_ROW
    }
    v4u o; o.x = pk2(a0, a1); o.y = pk2(a2, a3); o.z = pk2(a4, a5); o.w = pk2(a6, a7);
    *(GAS v4u*)(WBt + (size_t)n * 512 + c0) = o;
}

struct Args { const float* in[16]; float* out; unsigned char* ws; int ph_lo, ph_hi; };
#define XB_TMO      128
#define XB_XCNT(j)  (256  + 64 * (j))
#define XB_XSUB(j)  (1280 + 64 * (j))
#define XB_XGEN(j)  (2304 + 64 * (j))
#define XB_TOP      3328
#define XB_TOPGEN   3392
#define XCD_BAR_WORDS 3456
#define XB_SPIN_CAP (1u << 18)

__device__ __forceinline__ unsigned xb_ld(unsigned* p)              { return __hip_atomic_load(p, __ATOMIC_RELAXED, __HIP_MEMORY_SCOPE_AGENT); }
__device__ __forceinline__ unsigned xb_add(unsigned* p, unsigned v) { return __hip_atomic_fetch_add(p, v, __ATOMIC_RELAXED, __HIP_MEMORY_SCOPE_AGENT); }
__device__ __forceinline__ unsigned xb_xcc_id() { return (unsigned)__builtin_amdgcn_s_getreg((3 << 11) | 20) & 0xFu; }
#define XB_SPIN(cond, bar) do { unsigned _sp = 0; while (cond) { __builtin_amdgcn_s_sleep(1); \
    if ((++_sp & 255u) == 0u) { if (xb_ld(&(bar)[XB_TMO])) break; if (_sp > XB_SPIN_CAP) { atomicAdd(&(bar)[XB_TMO], 1u); break; } } } } while (0)

struct XcdBarrier {
    unsigned* bar; unsigned x;
    volatile LAS unsigned* st;
};

__device__ __forceinline__ XcdBarrier xcd_barrier_post(unsigned* bar, volatile LAS unsigned* st) {
    XcdBarrier b; b.bar = bar; b.x = xb_xcc_id(); b.st = st;
    if (threadIdx.x == 0) (void)xb_add(&bar[XB_XCNT(b.x)], 1u);
    return b;
}
__device__ __forceinline__ void xcd_barrier_complete(unsigned* bar, unsigned x, unsigned& nloc, unsigned& nx) {
    const unsigned G = gridDim.x * gridDim.y * gridDim.z;
    unsigned sum, cnt, mine, sp = 0u;
    for (;;) {
        sum = 0u; cnt = 0u; mine = 0u;
#pragma unroll
        for (unsigned j = 0; j < 16; ++j) { const unsigned c = xb_ld(&bar[XB_XCNT(j)]); sum += c; cnt += (c > 0u) ? 1u : 0u; mine = (j == x) ? c : mine; }
        if (sum == G) break;
        __builtin_amdgcn_s_sleep(1);
        if ((++sp & 255u) == 0u) { if (xb_ld(&bar[XB_TMO])) break; if (sp > XB_SPIN_CAP) { atomicAdd(&bar[XB_TMO], 1u); break; } }
    }
    nloc = mine > 0u ? mine : 1u; nx = cnt > 0u ? cnt : 1u;
}

__device__ __forceinline__ void xcd_barrier(const XcdBarrier& b) {
    asm volatile("s_waitcnt vmcnt(0)" ::: "memory");
    __syncthreads();
    if (threadIdx.x == 0) {
        unsigned* bar = b.bar;
        __builtin_amdgcn_s_waitcnt(0);
        unsigned nloc = b.st[0], nx = b.st[1];
        if (nloc == 0u) { xcd_barrier_complete(bar, b.x, nloc, nx); b.st[0] = nloc; b.st[1] = nx; }
        const unsigned old = xb_add(&bar[XB_XSUB(b.x)], 1u);
        const unsigned gen = old / nloc;
        if (old + 1u == (gen + 1u) * nloc) {
            __builtin_amdgcn_fence(__ATOMIC_RELEASE, "agent");
            asm volatile("s_waitcnt vmcnt(0)" ::: "memory");
            const unsigned og = xb_add(&bar[XB_TOP], 1u);
            const unsigned tg = og / nx;
            if (og + 1u == (tg + 1u) * nx) xb_add(&bar[XB_TOPGEN], 1u);
            else XB_SPIN(xb_ld(&bar[XB_TOPGEN]) == tg, bar);
            __builtin_amdgcn_fence(__ATOMIC_ACQUIRE, "agent");
            xb_add(&bar[XB_XGEN(b.x)], 1u);
            asm volatile("s_waitcnt vmcnt(0)" ::: "memory");
        } else {
            XB_SPIN(xb_ld(&bar[XB_XGEN(b.x)]) == gen, bar);
            __builtin_amdgcn_fence(__ATOMIC_ACQUIRE, "agent");
            asm volatile("s_waitcnt vmcnt(0)" ::: "memory");
        }
    }
    __syncthreads();
}

constexpr size_t WS_BAR = 2 * MiB + 512 * 1024;
constexpr int BARLDS_OFF = RING_BYTES;
#ifndef REP_SEAM
#define REP_SEAM 1
#endif
#define GRID_SEAM() for (int rs_ = 0; rs_ < REP_SEAM; ++rs_) xcd_barrier(bar)

struct TrD { const float* W; const float* kscale; bf16* WT; int ldw, K, nblk, cmk, item; };
__device__ __forceinline__ void tr_desc(const Args& a, int it, TrD& d) {
    constexpr int I_IN = 16 * (NIN / 32), I_A = 8 * 32, I_OUT = 16 * 32, I_GU = 16 * (2 * FFH / 32), I_DN = (FFH / 64) * 32, PER_TR = I_IN + 2 * I_A + I_OUT + I_GU + I_DN;
    const int l = it / PER_TR; int r = it - l * PER_TR; unsigned char* wl = a.ws + WS_WL + (size_t)l * WL_STRIDE;
    d.kscale = nullptr; d.cmk = 0; d.ldw = 1024; d.nblk = 32;
    if (r < I_IN) { d.W = a.in[2] + (size_t)l * 1024 * NINSRC; d.ldw = NINSRC; d.K = 1024; d.WT = (l == 0) ? (bf16*)(a.ws + WS_WIN) : (bf16*)((unsigned char*)a.out + 64 * MiB); d.nblk = NIN / 32; d.kscale = a.in[1] + l * 1024; d.cmk = 1; d.item = r; return; } r -= I_IN;
    if (r < I_A) { d.W = a.in[5] + (size_t)l * 512 * 1024; d.K = 512; d.WT = (bf16*)(wl + WL_A); d.item = r; return; } r -= I_A;
    if (r < I_A) { d.W = a.in[10] + (size_t)l * 512 * 1024; d.K = 512; d.WT = (bf16*)(wl + WL_C); d.item = r; return; } r -= I_A;
    if (r < I_OUT) { d.W = a.in[11] + (size_t)l * 1024 * 1024; d.K = 1024; d.WT = (bf16*)(wl + WL_OUT); d.item = r; return; } r -= I_OUT;
    if (r < I_GU) { d.W = a.in[13] + (size_t)l * 1024 * 2 * FFH; d.ldw = 2 * FFH; d.K = 1024; d.WT = (bf16*)(wl + WL_GU); d.nblk = 2 * FFH / 32; d.kscale = a.in[12] + l * 1024; d.cmk = 2; d.item = r; return; } r -= I_GU;
    d.W = a.in[14] + (size_t)l * FFH * 1024; d.K = FFH; d.WT = (bf16*)(wl + WL_DN); d.item = r;
}
__device__ __forceinline__ void tr_load(const TrD& d, int lane, f32x4 (&v)[8]) {
    const int kb = d.item / d.nblk, nb = d.item % d.nblk, k0 = 64 * kb, n0 = 32 * nb, c4 = lane & 7, rr = lane >> 3, nd = n0 + 4 * c4;
    const int sc = d.cmk == 1 ? CmIn()(nd) : (d.cmk == 2 ? CmGU()(nd) : nd);
#pragma unroll
    for (int i = 0; i < 8; ++i) { const int k = k0 + 8 * i + rr; v[i] = (f32x4){0.f, 0.f, 0.f, 0.f}; if (sc >= 0) v[i] = *(const GAS f32x4*)(d.W + (size_t)k * d.ldw + sc); if (d.kscale) v[i] = v[i] * d.kscale[k]; }
}
__device__ __forceinline__ void tr_store(const TrD& d, int lane, const f32x4 (&v)[8], LAS float* scr) {
    const int kb = d.item / d.nblk, nb = d.item % d.nblk, k0 = 64 * kb, n0 = 32 * nb, c4 = lane & 7, rr = lane >> 3;
#pragma unroll
    for (int i = 0; i < 8; ++i) { LAS float* p = scr + (8 * i + rr) * 33 + 4 * c4; p[0] = v[i][0]; p[1] = v[i][1]; p[2] = v[i][2]; p[3] = v[i][3]; }
    LDS_WAIT(); asm volatile("" ::: "memory");
    const int c = lane & 7;
#pragma unroll
    for (int j = 0; j < 4; ++j) { const int n = (lane >> 3) + 8 * j; const LAS float* s = scr + (8 * c) * 33 + n;
        v4u o; o.x = pk2(s[0 * 33], s[1 * 33]); o.y = pk2(s[2 * 33], s[3 * 33]); o.z = pk2(s[4 * 33], s[5 * 33]); o.w = pk2(s[6 * 33], s[7 * 33]);
        *(GAS v4u*)(d.WT + (size_t)(n0 + n) * d.K + k0 + 8 * c) = o; }
    LDS_WAIT(); asm volatile("" ::: "memory");
}
__device__ __forceinline__ void convert_weights(const Args& a, LAS float* scr, int gw, int NGW, int lane, int mode, int lsel) {
    constexpr int I_IN = 16 * (NIN / 32), I_A = 8 * 32, I_OUT = 16 * 32, I_GU = 16 * (2 * FFH / 32), I_DN = (FFH / 64) * 32, PER_TR = I_IN + 2 * I_A + I_OUT + I_GU + I_DN, I_WB = 1024;
    static_assert(I_WB % 8 == 0, "wb_item: items 8k..8k+7 must be the eight waves of one workgroup");
    const int nwb = mode == 2 ? 0 : 2 * I_WB;
    for (int it = gw; it < nwb; it += NGW) { const int l = it / I_WB, r = it - l * I_WB; unsigned char* wl = a.ws + WS_WL + (size_t)l * WL_STRIDE;
        wb_item(a.in[6] + (size_t)l * 4 * 128 * 128, a.in[7] + l * 512, a.in[8] + (size_t)l * 512 * 1024, (bf16*)(wl + WL_B), r, lane); }
    constexpr int I_ACO = 2 * I_A + I_OUT, I_P = I_IN + I_GU, I_S = I_ACO + I_DN;
    const int ntr = mode == 0 ? 2 * PER_TR : (mode == 1 ? 2 * I_P : I_S);
#define TR_MAP(i_) (mode == 0 ? (i_) : (mode == 1 ? ((i_) / I_P) * PER_TR + (((i_) % I_P) < I_IN ? ((i_) % I_P) : ((i_) % I_P) + I_ACO) : lsel * PER_TR + I_IN + ((i_) < I_ACO ? (i_) : (i_) + I_GU)))
    int it = gw; bool h0 = it < ntr, h1 = it + NGW < ntr; TrD d0, d1, d2; f32x4 va[8], vb[8], vc[8];
    if (h0) { tr_desc(a, TR_MAP(it), d0); tr_load(d0, lane, va); }
    if (h1) { tr_desc(a, TR_MAP(it + NGW), d1); tr_load(d1, lane, vb); }
    while (h0) {
        const int it2 = it + 2 * NGW; const bool h2 = it2 < ntr;
        if (h2) { tr_desc(a, TR_MAP(it2), d2); tr_load(d2, lane, vc); }
        tr_store(d0, lane, va, scr);
        d0 = d1; d1 = d2; it += NGW; h0 = h1; h1 = h2;
#pragma unroll
        for (int i = 0; i < 8; ++i) { va[i] = vb[i]; vb[i] = vc[i]; }
    }
#undef TR_MAP
}

__device__ __forceinline__ void x_to_bf16(const Args& a, int gw, int NGW, int lane) {
    const float* x = a.in[0]; bf16* XB = (bf16*)(a.ws + WS_XB);
    for (int blk = gw >> 3; blk < MROWS / 32; blk += NGW >> 3) { const int m0 = blk * 32 + (gw & 7) * 4;
        f32x4 v[4][4];
#pragma unroll
        for (int r = 0; r < 4; ++r)
#pragma unroll
            for (int j = 0; j < 4; ++j) v[r][j] = *((const GAS f32x4*)(x + (size_t)(m0 + r) * 1024) + lane + 64 * j);
#pragma unroll
        for (int r = 0; r < 4; ++r) { const int m = m0 + r; float s = 0.f;
#pragma unroll
            for (int j = 0; j < 4; ++j) s += (v[r][j].x * v[r][j].x + v[r][j].y * v[r][j].y) + (v[r][j].z * v[r][j].z + v[r][j].w * v[r][j].w);
            s = wave_sum(s);
            GAS unsigned long long* o8 = (GAS unsigned long long*)(XB + (size_t)m * 1024) + lane;
#pragma unroll
            for (int j = 0; j < 4; ++j) o8[64 * j] = (unsigned long long)pk2(v[r][j].x, v[r][j].y) | ((unsigned long long)pk2(v[r][j].z, v[r][j].w) << 32);
            if (lane < 20) { const int bufi = lane >> 2, slot = lane & 3; *(GAS float*)(a.ws + WS_SSQ + (size_t)bufi * KiB512 + ((size_t)slot * MROWS + m) * 4) = (lane == 0) ? s : 0.f; } }
    }
}

__device__ __forceinline__ void unpk8(const v4u w, float (&f)[8]) {
    f[0] = __uint_as_float(w.x << 16); f[1] = __uint_as_float(w.x & 0xffff0000u); f[2] = __uint_as_float(w.y << 16); f[3] = __uint_as_float(w.y & 0xffff0000u);
    f[4] = __uint_as_float(w.z << 16); f[5] = __uint_as_float(w.z & 0xffff0000u); f[6] = __uint_as_float(w.w << 16); f[7] = __uint_as_float(w.w & 0xffff0000u); }
__device__ __forceinline__ v4u pk8(const float (&f)[8]) { v4u o; o.x = pk2(f[0], f[1]); o.y = pk2(f[2], f[3]); o.z = pk2(f[4], f[5]); o.w = pk2(f[6], f[7]); return o; }

__device__ __forceinline__ void pool_conv_phase(const Args& a, int l, int vcu, int G, int tid) {
    const bf16* __restrict__ U = (const bf16*)(a.ws + WS_U); const bf16* __restrict__ Z = (const bf16*)(a.ws + WS_Z); const bf16* __restrict__ CB = (const bf16*)(a.ws + WS_CB);
    bf16* __restrict__ Dp = (bf16*)a.out; bf16* __restrict__ YC = (bf16*)a.out + (size_t)MROWS * 512;
    const float* cw = a.in[9] + (size_t)l * 3 * 512;
    const int cgp = tid & 63, seg = tid >> 6, ch = 8 * cgp, w = 2 << (cgp >> 4);
    float w0[8], w1[8], w2[8];
#pragma unroll
    for (int j = 0; j < 8; ++j) { w0[j] = cw[ch + j]; w1[j] = cw[512 + ch + j]; w2[j] = cw[1024 + ch + j]; }
    for (int chunk = vcu; chunk < MROWS / 128; chunk += G) {
        const int first = chunk * 128 + seg * 16, tb = first & (SEQ - 1);
        { float sum[8], uc[8], t8[8];
#pragma unroll
          for (int j = 0; j < 8; ++j) sum[j] = 0.f;
          for (int j = 1; j < w; ++j) if (tb - j >= 0) { unpk8(*(const GAS v4u*)(U + (size_t)(first - j) * 512 + ch), t8);
#pragma unroll
              for (int q = 0; q < 8; ++q) sum[q] += t8[q]; }
#pragma unroll
          for (int i = 0; i < 16; ++i) { const int row = first + i, t = tb + i;
              unpk8(*(const GAS v4u*)(U + (size_t)row * 512 + ch), uc);
              const float inv = 1.0f / (float)((t + 1) < w ? (t + 1) : w);
#pragma unroll
              for (int q = 0; q < 8; ++q) { sum[q] += uc[q]; t8[q] = sum[q] * inv - uc[q]; }
              *(GAS v4u*)(Dp + (size_t)row * 512 + ch) = pk8(t8);
              if (t - w + 1 >= 0) { unpk8(*(const GAS v4u*)(U + (size_t)(row - w + 1) * 512 + ch), t8);
#pragma unroll
                  for (int q = 0; q < 8; ++q) sum[q] -= t8[q]; } } }
        { float z2[8], z1[8], z0[8], cb[8], y[8];
#pragma unroll
          for (int q = 0; q < 8; ++q) { z2[q] = 0.f; z1[q] = 0.f; }
          if (tb >= 2) unpk8(*(const GAS v4u*)(Z + (size_t)(first - 2) * 512 + ch), z2);
          if (tb >= 1) unpk8(*(const GAS v4u*)(Z + (size_t)(first - 1) * 512 + ch), z1);
#pragma unroll
          for (int i = 0; i < 16; ++i) { const int row = first + i;
              unpk8(*(const GAS v4u*)(Z + (size_t)row * 512 + ch), z0); unpk8(*(const GAS v4u*)(CB + (size_t)row * 512 + ch), cb);
#pragma unroll
              for (int q = 0; q < 8; ++q) { y[q] = cb[q] * (w0[q] * z2[q] + w1[q] * z1[q] + w2[q] * z0[q]); z2[q] = z1[q]; z1[q] = z0[q]; }
              *(GAS v4u*)(YC + (size_t)row * 512 + ch) = pk8(y); } }
    }
}

__device__ __forceinline__ void final_norm_phase(const Args& a, int gw, int NGW, int lane) {
    float* out = a.out; const bf16* XB = (const bf16*)(a.ws + WS_XB); const float* ssq = (const float*)(a.ws + WS_SSQ + 4 * KiB512); const float* gn = a.in[15];
    f32x4 g4[2][2];
#pragma unroll
    for (int j = 0; j < 2; ++j) { g4[j][0] = *(const GAS f32x4*)(gn + 512 * j + 8 * lane); g4[j][1] = *(const GAS f32x4*)(gn + 512 * j + 8 * lane + 4); }
    for (int m = gw; m < MROWS; m += NGW) {
        const float rs = __builtin_amdgcn_rsqf(((ssq[m] + ssq[MROWS + m]) + (ssq[2 * MROWS + m] + ssq[3 * MROWS + m])) * (1.0f / 1024.0f) + 1e-6f);
#pragma unroll
        for (int j = 0; j < 2; ++j) { float v[8]; unpk8(*(const GAS v4u*)(XB + (size_t)m * 1024 + 512 * j + 8 * lane), v);
            GAS f32x4* o = (GAS f32x4*)(out + (size_t)m * 1024 + 512 * j + 8 * lane);
            o[0] = (f32x4){v[0], v[1], v[2], v[3]} * rs * g4[j][0]; o[1] = (f32x4){v[4], v[5], v[6], v[7]} * rs * g4[j][1]; }
    }
}

__global__ void __launch_bounds__(NWAVES * 64, 2) fwd_megakernel(Args a) {
    extern __shared__ __attribute__((aligned(16))) unsigned char lds[];
    cg::grid_group grid = cg::this_grid();
    if (a.ph_lo < 0) grid.sync();
    LAS unsigned char* ldsl = (LAS unsigned char*)lds;
    const int G = gridDim.x, bx = blockIdx.x, vcu = (G % 8 == 0) ? (bx % 8) * (G / 8) + bx / 8 : bx, NGW = G * NWAVES;
#define FRESH_IDS() int tid_ = threadIdx.x; asm volatile("" : "+v"(tid_)); const int tid = tid_, lane = tid & 63, wave = __builtin_amdgcn_readfirstlane(tid >> 6), gw = vcu * NWAVES + wave; LAS float* scr = (LAS float*)(ldsl + wave * 16384); (void)tid; (void)lane; (void)gw; (void)scr
    unsigned char* ws = a.ws;
    bf16* XB = (bf16*)(ws + WS_XB);
    if (threadIdx.x < 2) ((volatile LAS unsigned*)(ldsl + BARLDS_OFF))[threadIdx.x] = 0u;
    __syncthreads();
    const XcdBarrier bar = xcd_barrier_post((unsigned*)(ws + WS_BAR), (volatile LAS unsigned*)(ldsl + BARLDS_OFF));

#define IN(k) (a.ph_lo <= (k) && (k) < a.ph_hi)
#ifndef REP_PRO
#define REP_PRO 1
#endif
#ifndef REP_IN
#define REP_IN 1
#endif
#ifndef REP_PC
#define REP_PC 1
#endif
#ifndef REP_MIX
#define REP_MIX 1
#endif
#ifndef REP_GU
#define REP_GU 1
#endif
#define BOTH(k) (IN(k) && IN((k) + 1))
#ifndef NO_PRO
    for (int rp_ = 0; rp_ < REP_PRO; ++rp_) if (IN(0)) { FRESH_IDS();
    convert_weights(a, scr, gw, NGW, lane, (G == 256) ? 1 : 0, 0);
    x_to_bf16(a, gw, NGW, lane); }
#endif
    if (BOTH(0)) GRID_SEAM();

#pragma unroll 1
    for (int l = 0; l < DEPTH; ++l) {
        unsigned char* wl = ws + WS_WL + (size_t)l * WL_STRIDE; const int p0 = 1 + 6 * l;
        const bf16* WIN = (l == 0) ? (const bf16*)(ws + WS_WIN) : (const bf16*)((unsigned char*)a.out + 64 * MiB);
        const float* ssq_in = (const float*)(ws + WS_SSQ + (size_t)(2 * l) * KiB512);
        float* ssq_mid = (float*)(ws + WS_SSQ + (size_t)(2 * l + 1) * KiB512);
        float* ssq_end = (float*)(ws + WS_SSQ + (size_t)(2 * l + 2) * KiB512);
#ifndef NO_IN
#ifndef STAG_IN
#define STAG_IN 0
#endif
        if (IN(p0) && STAG_IN > 0 && G == 256 && bx >= 128) { const unsigned long long t0_ = __builtin_amdgcn_s_memrealtime(), d_ = (unsigned long long)(1 + ((bx >> 3) % 3)) * STAG_IN; while (__builtin_amdgcn_s_memrealtime() - t0_ < d_) __builtin_amdgcn_s_sleep(32); }
        for (int rp_ = 0; rp_ < REP_IN; ++rp_) if (IN(p0)) { pg8::Gemm g{XB, XB, XB, WIN, WIN, WIN, MROWS, NIN, 1024}; pg8::StaticOrder S; S.init(MROWS, NIN, G, bx);
          pg8::EpiIn E{ssq_in, a.in[4] + (size_t)l * 3072, (bf16*)(ws + WS_QA), (bf16*)(ws + WS_G),
                       (float*)(ws + WS_FLOG), attn_body::C2};
          pg8::gemm_phase<pg8::EpiIn, pg8::StaticOrder, true, true>(ldsl, g, S, E);
          if (rp_ == REP_IN - 1 && G == 256 && bx >= 128) { FRESH_IDS(); convert_weights(a, scr, (bx - 128) * NWAVES + wave, 128 * NWAVES, lane, 2, l); } }
#endif
        if (BOTH(p0 + 0)) GRID_SEAM();
#ifndef NO_PRO
#endif
#ifndef NO_ATT
#ifndef REP_ATT
#define REP_ATT 1
#endif
        bf16* const YA = (bf16*)(ws + WS_QA);
#pragma unroll 1
        for (int st_ = 0; st_ < 2; ++st_) {
        const bool att_now = (st_ == ((vcu >> 1) & 1));
        if (att_now && IN(p0 + 1)) { const attn_body::AttnTensors AT{(const attn_body::bf16*)(ws + WS_QA), (const attn_body::bf16*)(ws + WS_K), (const attn_body::bf16*)(ws + WS_V), (attn_body::bf16*)YA,
                                          (const float*)(ws + WS_FLOG), a.in[3] + l * NHEADS};
          const attn_body::StaticOrder S(G, vcu);
          attn_body::attn_phase<attn_body::StaticOrder>((char*)lds, AT, S); }
#endif
#ifndef NO_PC
        for (int rp_ = 0; rp_ < REP_PC; ++rp_) if (!att_now && IN(p0 + 1)) { FRESH_IDS(); pool_conv_phase(a, l, vcu, G, tid); }
#endif
        }
        if (BOTH(p0 + 1)) GRID_SEAM();
#ifndef NO_MIX
        for (int rp_ = 0; rp_ < REP_MIX; ++rp_) if (IN(p0 + 2)) { pg8::Gemm g{(const bf16*)YA, (const bf16*)a.out, (const bf16*)a.out + (size_t)MROWS * 512, (const bf16*)(wl + WL_A), (const bf16*)(wl + WL_B), (const bf16*)(wl + WL_C), MROWS, 1024, 512};
          pg8::StaticOrder3 S; S.init(MROWS, 1024, G, bx);
          pg8::EpiMix E{(const bf16*)(ws + WS_G), (bf16*)(ws + WS_MIX), (bf16*)(ws + WS_U)};
          pg8::gemm_phase<pg8::EpiMix, pg8::StaticOrder3, true, true>(ldsl, g, S, E); }
#endif
        if (BOTH(p0 + 2)) GRID_SEAM();
#ifndef NO_OUT
#ifndef REP_OUT
#define REP_OUT 1
#endif
        if (IN(p0 + 3)) { const bf16* A = (const bf16*)(ws + WS_MIX); const bf16* B = (const bf16*)(wl + WL_OUT);
          pg8::Gemm g{A, A, A, B, B, B, MROWS, 1024, 1024}; pg8::StaticOrder S; S.init(MROWS, 1024, G, bx);
          pg8::EpiResid E{XB, ssq_mid};
          pg8::gemm_phase<pg8::EpiResid, pg8::StaticOrder, true, true>(ldsl, g, S, E); }
#endif
        if (BOTH(p0 + 3)) GRID_SEAM();
#ifndef NO_GU
        for (int rp_ = 0; rp_ < REP_GU; ++rp_) if (IN(p0 + 4)) { const bf16* B = (const bf16*)(wl + WL_GU);
          pg8::Gemm g{XB, XB, XB, B, B, B, MROWS, 2 * FFH, 1024}; pg8::StaticOrder S; S.init(MROWS, 2 * FFH, G, bx);
          pg8::EpiSwiglu E{ssq_mid, (bf16*)(ws + WS_ACT)};
          pg8::gemm_phase<pg8::EpiSwiglu, pg8::StaticOrder, true, true>(ldsl, g, S, E); }
#endif
        if (BOTH(p0 + 4)) GRID_SEAM();
#ifndef NO_DN
        if (IN(p0 + 5)) { const bf16* A = (const bf16*)(ws + WS_ACT); const bf16* B = (const bf16*)(wl + WL_DN);
          pg8::Gemm g{A, A, A, B, B, B, MROWS, 1024, FFH}; pg8::StaticOrder S; S.init(MROWS, 1024, G, bx);
          pg8::EpiResid E{XB, ssq_end};
          pg8::gemm_phase<pg8::EpiResid, pg8::StaticOrder, true, true>(ldsl, g, S, E); }
#endif
        if (BOTH(p0 + 5)) GRID_SEAM();
    }
    if (IN(13)) { FRESH_IDS(); final_norm_phase(a, gw, NGW, lane); }
}

__global__ void ws_too_small_fill(float* out, int n) { for (int i = blockIdx.x * blockDim.x + threadIdx.x; i < n; i += gridDim.x * blockDim.x) out[i] = 7777.f; }

extern "C" void kernel_launch(void* const* d_in, const int* in_sizes, int n_in, void* d_out, int out_size, void* d_ws, size_t ws_size, hipStream_t stream) {
    static int grid = 0;
    if (grid == 0) {
        int dev = 0, cus = 0, per_cu = 0;
        if (hipGetDevice(&dev) != hipSuccess || hipDeviceGetAttribute(&cus, hipDeviceAttributeMultiprocessorCount, dev) != hipSuccess) { fprintf(stderr, "kernel_launch: device query failed\n"); grid = -1; return; }
        if (hipFuncSetAttribute((const void*)fwd_megakernel, hipFuncAttributeMaxDynamicSharedMemorySize, LDS_BYTES) != hipSuccess) { fprintf(stderr, "kernel_launch: hipFuncSetAttribute failed\n"); grid = -1; return; }
        if (hipOccupancyMaxActiveBlocksPerMultiprocessor(&per_cu, (const void*)fwd_megakernel, NWAVES * 64, LDS_BYTES) != hipSuccess || per_cu < 1) per_cu = 1;
        (void)hipGetLastError();
        grid = cus;
    }
    if (grid < 0) return;
    if (n_in != 16 || out_size != MROWS * DMODEL || ws_size < WS_END) { ws_too_small_fill<<<256, 256, 0, stream>>>((float*)d_out, out_size); return; }
    Args a{};
    for (int i = 0; i < 16; ++i) a.in[i] = (const float*)d_in[i];
    a.out = (float*)d_out; a.ws = (unsigned char*)d_ws;
#ifndef MK_LAUNCHES
#define MK_LAUNCHES 1
#endif
#if MK_LAUNCHES == 1
    a.ph_lo = 0; a.ph_hi = 14;
    if (hipMemsetAsync((unsigned char*)d_ws + WS_BAR, 0, XCD_BAR_WORDS * 4, stream) != hipSuccess) { fprintf(stderr, "kernel_launch: memset of the barrier words failed\n"); return; }
    void* args[] = {&a};
    hipError_t e = hipLaunchCooperativeKernel((const void*)fwd_megakernel, dim3(grid), dim3(NWAVES * 64), args, LDS_BYTES, stream);
    if (e != hipSuccess) fprintf(stderr, "kernel_launch: cooperative launch failed: %s (grid %d)\n", hipGetErrorString(e), grid);
#else
    for (int p = 0; p < 14; ++p) { a.ph_lo = p; a.ph_hi = p + 1; hipLaunchKernelGGL(fwd_megakernel, dim3(grid), dim3(NWAVES * 64), LDS_BYTES, stream, a); }
#endif
}
```

```cpp
#define MK_LAUNCHES 1
#include <hip/hip_runtime.h>
#include <hip/hip_cooperative_groups.h>
#include <cstdio>
#include <cstdint>
namespace pg8 {
#define PG8_LAS __attribute__((address_space(3)))
typedef unsigned short bf16_t;
typedef short bf16x8 __attribute__((ext_vector_type(8)));
typedef float f32x4 __attribute__((ext_vector_type(4)));
typedef unsigned u32x4 __attribute__((ext_vector_type(4)));
constexpr int BM = 256, BK = 64, HALF = 128, HTB = HALF * BK * 2  , STAGE_BYTES = 8 * HTB, NXCD = 8, WGM = 8;

__host__ __device__ __forceinline__ int lds_byte(int r, int c) { const int st = (r >> 4) * 2 + (c >> 5), rr = r & 15, cc = c & 31, ob = rr * 64 + cc * 2; return st * 1024 + (ob ^ (((ob >> 9) & 1) << 5)); }
__host__ __device__ __forceinline__ void stage_rc(int b, int& R, int& C) { const int st = b / 1024, sb = b % 1024, swz = sb ^ (((sb >> 9) & 1) << 5); R = (st >> 1) * 16 + swz / 64; C = (st & 1) * 32 + (swz % 64) / 2; }
__host__ __device__ __forceinline__ int perm32(int rho) { const int n = rho >> 4, i = rho & 15; return 8 * (i >> 2) + 4 * n + (i & 3); }

struct Unit { int pm, pn, sub; };
struct Gemm { const bf16_t *A0, *A1, *A2, *B0, *B1, *B2; int M, N, K; };

struct StaticOrder {
    int nM, nN, nwg, G, c;
    __host__ __device__ void init(int M, int N, int G_, int c_) { nM = M / BM; nN = N / BM; nwg = nM * nN; G = G_; c = c_; }
    __host__ __device__ bool next(int i, Unit& u) const {
        const long L = (long)i * G + c; if (L >= nwg) return false;
        int wgid = (int)L; { const int q = nwg / NXCD, r = nwg % NXCD, xcd = wgid % NXCD, off = wgid / NXCD; wgid = (xcd < r ? xcd * (q + 1) : r * (q + 1) + (xcd - r) * q) + off; }
        const int nig = WGM * nN, gid = wgid / nig, fm = gid * WGM, gsz = (nM - fm) < WGM ? (nM - fm) : WGM;
        u.pm = fm + ((wgid % nig) % gsz); u.pn = (wgid % nig) / gsz; u.sub = 0; return true;
    }
    __device__ __forceinline__ void a_ready(const Unit&) const {}
    __device__ __forceinline__ void done(const Unit&) const {}
};

struct StaticOrder3 {
    StaticOrder b;
    __host__ __device__ void init(int M, int N, int G_, int c_) { b.init(M, N, G_, c_); }
    __host__ __device__ bool next(int i, Unit& u) const { if (!b.next(i / 3, u)) return false; u.sub = i % 3; return true; }
    __device__ __forceinline__ void a_ready(const Unit&) const {}
    __device__ __forceinline__ void done(const Unit&) const {}
};
typedef float f32x2c_t __attribute__((ext_vector_type(2))); typedef __bf16 bf16x2c_t __attribute__((ext_vector_type(2)));
__device__ __forceinline__ unsigned cvt_pk_bf16(float lo, float hi) { const f32x2c_t v = {lo, hi}; const bf16x2c_t b = __builtin_convertvector(v, bf16x2c_t); return __builtin_bit_cast(unsigned, b); }
typedef float f32x2 __attribute__((ext_vector_type(2)));
__device__ __forceinline__ float rstd_of(const float* ssq, int row) { const float s0 = ssq[row], s1 = ssq[32768 + row], s2 = ssq[2 * 32768 + row], s3 = ssq[3 * 32768 + row]; return __builtin_amdgcn_rsqf(((s0 + s1) + (s2 + s3)) * (1.0f / 1024.0f) + 1e-6f); }
__device__ __forceinline__ float sigm(float v) { return __builtin_amdgcn_rcpf(1.0f + __builtin_amdgcn_exp2f(-1.4426950408889634f * v)); }
__device__ __forceinline__ u32x4 pack8(const f32x4 a, const f32x4 b) { u32x4 w; w.x = cvt_pk_bf16(a[0], a[1]); w.y = cvt_pk_bf16(a[2], a[3]); w.z = cvt_pk_bf16(b[0], b[1]); w.w = cvt_pk_bf16(b[2], b[3]); return w; }
__device__ __forceinline__ void st16_nt(void* p, const u32x4 v) { __builtin_nontemporal_store(v, (u32x4*)p); }
__device__ __forceinline__ void unpack8(const u32x4 w, f32x4& a, f32x4& b) {
    a[0] = __uint_as_float(w.x << 16); a[1] = __uint_as_float(w.x & 0xffff0000u); a[2] = __uint_as_float(w.y << 16); a[3] = __uint_as_float(w.y & 0xffff0000u);
    b[0] = __uint_as_float(w.z << 16); b[1] = __uint_as_float(w.z & 0xffff0000u); b[2] = __uint_as_float(w.w << 16); b[3] = __uint_as_float(w.w & 0xffff0000u); }

constexpr int AUX_OFF = 131072 + 1024, AUX_BYTES = 4096 + 1024;
__device__ __forceinline__ void pre_rows(PG8_LAS unsigned char* lds, const float* ssq, int pm, int par, int wid, int lane) {
#pragma unroll
    for (int i = 0; i < 2; ++i) { const int q = wid * 2 + i, slot = q >> 2, r0 = (q & 3) * 64;
        __builtin_amdgcn_global_load_lds((const unsigned*)(ssq + (size_t)slot * 32768 + pm * BM + r0 + lane), (PG8_LAS unsigned*)(lds + AUX_OFF + par * AUX_BYTES + (slot * 256 + r0) * 4), 4, 0, 0); }
}
__device__ __forceinline__ float rstd_lds(const PG8_LAS float* aux, int rl) { return __builtin_amdgcn_rsqf(((aux[rl] + aux[256 + rl]) + (aux[512 + rl] + aux[768 + rl])) * (1.0f / 1024.0f) + 1e-6f); }

struct EpiIn {
    static constexpr bool PERM = true, AFTER_DRAIN = false, PRE = true, SPLIT = false;
    const float* ssq; const float* bgate; bf16_t *Q, *G; float* FLOG; float qscale;
    __device__ __forceinline__ void pre(PG8_LAS unsigned char* lds, const Unit& u, int par, int wid, int lane) const {
        pre_rows(lds, ssq, u.pm, par, wid, lane);
        if (u.pn >= 14 && u.pn < 26 && wid < 4)
            __builtin_amdgcn_global_load_lds((const unsigned*)(bgate + (u.pn - 14) * 256 + wid * 64 + lane), (PG8_LAS unsigned*)(lds + AUX_OFF + par * AUX_BYTES + 4096 + wid * 256), 4, 0, 0);
    }
    template <int AI> __device__ __forceinline__ void part(const f32x4 (&acc)[2][2][4][2], const Unit& u, int wr, int wc, int fr, int fq, PG8_LAS unsigned char* lds, int par) const {
        const PG8_LAS float* aux = (const PG8_LAS float*)(lds + AUX_OFF + par * AUX_BYTES);
        const int rl0 = wr * 64 + fr + AI * HALF, row0 = u.pm * BM + rl0, pn = u.pn, cw = wc * 32 + 8 * fq;
        if (pn < 8 || pn == 12 || pn == 13) {
            const int blk = pn < 8 ? (pn >> 1) : 5, colt = (pn & 1) * 256; const float sc = pn < 2 ? qscale : 1.f;
            bf16_t* base = Q + (size_t)blk * ((size_t)32768 * 512);
#pragma unroll
            for (int m = 0; m < 4; ++m) { const int row = row0 + m * 16; const float rs = rstd_lds(aux, rl0 + m * 16) * sc; bf16_t* rowp = base + (size_t)row * 512 + colt + cw;
#pragma unroll
                for (int bj = 0; bj < 2; ++bj) st16_nt(rowp + bj * HALF, pack8(acc[AI][bj][m][0] * rs, acc[AI][bj][m][1] * rs)); }
        } else if (pn < 12) {
            const int colz = (pn - 8) * 128 + cw;
#pragma unroll
            for (int m = 0; m < 4; ++m) { const int row = row0 + m * 16; const float rs = rstd_lds(aux, rl0 + m * 16), rs2 = rs * rs;
                st16_nt(Q + (size_t)4 * ((size_t)32768 * 512) + (size_t)row * 512 + colz, pack8(acc[AI][0][m][0] * acc[AI][1][m][0] * rs2, acc[AI][0][m][1] * acc[AI][1][m][1] * rs2)); }
        } else if (pn < 26) {
            const int colg = (pn - 14) * 256 + cw;
            f32x4 bv[2][2];
#pragma unroll
            for (int bj = 0; bj < 2; ++bj)
#pragma unroll
                for (int n = 0; n < 2; ++n) bv[bj][n] = *(const PG8_LAS f32x4*)(aux + 1024 + cw + bj * HALF + 4 * n);
#pragma unroll
            for (int m = 0; m < 4; ++m) { const int row = row0 + m * 16; const float rs = rstd_lds(aux, rl0 + m * 16); bf16_t* rowp = G + (size_t)row * 3072 + colg;
#pragma unroll
                for (int bj = 0; bj < 2; ++bj) { f32x4 v0 = acc[AI][bj][m][0] * rs + bv[bj][0], v1 = acc[AI][bj][m][1] * rs + bv[bj][1];
#pragma unroll
                    for (int i = 0; i < 4; ++i) { v0[i] = sigm(v0[i]); v1[i] = sigm(v1[i]); }
                    st16_nt(rowp + bj * HALF, pack8(v0, v1)); } }
        } else {
            if (wc == 0 && fq == 0) {
#pragma unroll
                for (int m = 0; m < 4; ++m) { const int row = row0 + m * 16; const float rs = rstd_lds(aux, rl0 + m * 16);
                    *(f32x4*)(FLOG + (size_t)row * 8) = acc[AI][0][m][0] * rs; *(f32x4*)(FLOG + (size_t)row * 8 + 4) = acc[AI][0][m][1] * rs; }
            }
        }
    }
};

struct EpiResid {
    static constexpr bool PERM = true, AFTER_DRAIN = false, PRE = false, SPLIT = false;
    bf16_t* xb; float* ssq;
    __device__ __forceinline__ void operator()(const f32x4 (&acc)[2][2][4][2], const Unit& u, int wr, int wc, int fr, int fq) const {
        const int row0 = u.pm * BM + wr * 64 + fr, col0 = u.pn * BM + wc * 32 + 8 * fq;
#pragma unroll
        for (int ai = 0; ai < 2; ++ai)
#pragma unroll
            for (int m = 0; m < 4; ++m) { const int row = row0 + ai * HALF + m * 16; bf16_t* p = xb + (size_t)row * 1024 + col0; float ss = 0.f;
#pragma unroll
                for (int bj = 0; bj < 2; ++bj) { f32x4 a, b; unpack8(*(const u32x4*)(p + bj * HALF), a, b);
                    a = a + acc[ai][bj][m][0]; b = b + acc[ai][bj][m][1];
                    ss += ((a[0] * a[0] + a[1] * a[1]) + (a[2] * a[2] + a[3] * a[3])) + ((b[0] * b[0] + b[1] * b[1]) + (b[2] * b[2] + b[3] * b[3]));
                    *(u32x4*)(p + bj * HALF) = pack8(a, b); }
                ss += __shfl_xor(ss, 16); ss += __shfl_xor(ss, 32);
                if (fq == 0) atomicAdd(ssq + (size_t)u.pn * 32768 + row, ss); }
    }
};

__device__ __forceinline__ u32x4 ld16_sc1(const bf16_t* p) {
    const unsigned long long* q = (const unsigned long long*)p;
    const unsigned long long lo = __hip_atomic_load(q, __ATOMIC_RELAXED, __HIP_MEMORY_SCOPE_AGENT), hi = __hip_atomic_load(q + 1, __ATOMIC_RELAXED, __HIP_MEMORY_SCOPE_AGENT);
    u32x4 w; w.x = (unsigned)lo; w.y = (unsigned)(lo >> 32); w.z = (unsigned)hi; w.w = (unsigned)(hi >> 32); return w; }
struct EpiMix {
    static constexpr bool PERM = true, AFTER_DRAIN = false, PRE = false, SPLIT = false;
    const bf16_t* G; bf16_t* MIX; bf16_t* P1;
    __device__ __forceinline__ void operator()(const f32x4 (&acc)[2][2][4][2], const Unit& u, int wr, int wc, int fr, int fq) const {
        const int row0 = u.pm * BM + wr * 64 + fr, col0 = u.pn * BM + wc * 32 + 8 * fq, sub = u.sub;
#pragma unroll
        for (int ai = 0; ai < 2; ++ai)
#pragma unroll
            for (int m = 0; m < 4; ++m) { const int row = row0 + ai * HALF + m * 16;
#pragma unroll
                for (int bj = 0; bj < 2; ++bj) { const int c = col0 + bj * HALF; f32x4 g0, g1; unpack8(*(const u32x4*)(G + (size_t)row * 3072 + sub * 1024 + c), g0, g1);
                    f32x4 v0 = acc[ai][bj][m][0] * g0, v1 = acc[ai][bj][m][1] * g1; const size_t off = (size_t)row * 1024 + c;
                    if (sub == 2) { f32x4 p0, p1; unpack8(*(const u32x4*)(MIX + off), p0, p1); v0 = v0 + p0; v1 = v1 + p1; unpack8(*(const u32x4*)(P1 + off), p0, p1); v0 = v0 + p0; v1 = v1 + p1; }
                    *(u32x4*)((sub == 1 ? P1 : MIX) + off) = pack8(v0, v1); } }
    }
};

struct EpiSwiglu {
    static constexpr bool PERM = true, AFTER_DRAIN = false, PRE = true, SPLIT = true;
    const float* ssq; bf16_t* ACT;
    __device__ __forceinline__ void pre(PG8_LAS unsigned char* lds, const Unit& u, int par, int wid, int lane) const { pre_rows(lds, ssq, u.pm, par, wid, lane); }
    template <int AI> __device__ __forceinline__ void part(const f32x4 (&acc)[2][2][4][2], const Unit& u, int wr, int wc, int fr, int fq, PG8_LAS unsigned char* lds, int par) const {
        const PG8_LAS float* aux = (const PG8_LAS float*)(lds + AUX_OFF + par * AUX_BYTES);
        const int rl0 = wr * 64 + fr + AI * HALF, row0 = u.pm * BM + rl0, colh = u.pn * 128 + wc * 32 + 8 * fq;
#pragma unroll
        for (int m = 0; m < 4; ++m) { const int row = row0 + m * 16; const float rs = rstd_lds(aux, rl0 + m * 16);
            f32x4 h[2];
#pragma unroll
            for (int n = 0; n < 2; ++n) { const f32x4 a = acc[AI][0][m][n] * rs, b = acc[AI][1][m][n] * rs;
#pragma unroll
                for (int i = 0; i < 4; ++i) h[n][i] = a[i] * sigm(a[i]) * b[i]; }
            st16_nt(ACT + (size_t)row * 2816 + colh, pack8(h[0], h[1])); }
    }
};

template <class Epi, class Sched, bool ALIGN_EPI = false, bool SP2 = false>
__device__ __forceinline__ void gemm_phase(PG8_LAS unsigned char* lds, const Gemm g, const Sched& S, const Epi& E) {
    int tid_ = threadIdx.x; asm volatile("" : "+v"(tid_));
    const int tid = tid_, wid = __builtin_amdgcn_readfirstlane(tid >> 6), lane = tid & 63, wr = wid >> 2, wc = wid & 3, fr = lane & 15, fq = lane >> 4;
    const int K = g.K, nt = K / BK;
    unsigned voffA[2], voffB[2];
#pragma unroll
    for (int i = 0; i < 2; ++i) { int R, C; stage_rc(tid * 16 + i * 8192, R, C); const int Rb = Epi::PERM ? ((R & ~31) + perm32(R & 31)) : R;
        voffA[i] = (unsigned)(R * K + C) * 2u; voffB[i] = (unsigned)(Rb * K + C) * 2u; }
    const size_t kstep = (size_t)(BK * 2);
    const size_t hstep = (size_t)HALF * K * 2;
    const size_t tstep = 2 * hstep;
    const unsigned ldsw = (unsigned)wid * 1024u;
    const int aoff = lds_byte(wr * 64 + fr, fq * 8), boff = lds_byte(wc * 32 + fr, fq * 8);
#define PG8_SELA(s) ((const char*)((s) == 0 ? g.A0 : ((s) == 1 ? g.A1 : g.A2)))
#define PG8_SELB(s) ((const char*)((s) == 0 ? g.B0 : ((s) == 1 ? g.B1 : g.B2)))
#define PG8_SA(b, h) (((b) * 2 + (h)) * HTB)
#define PG8_SB(b, h) ((4 + (b) * 2 + (h)) * HTB)
#define PG8_STAGE(bufoff, gbase, voff) do { _Pragma("unroll") for (int _i = 0; _i < 2; ++_i) \
        __builtin_amdgcn_global_load_lds((const unsigned*)((const char*)(gbase) + (voff)[_i]), (PG8_LAS unsigned*)(lds + (bufoff) + ldsw + _i * 8192), 16, 0, 0); } while (0)
#define PG8_LDA(dst, b, h) do { _Pragma("unroll") for (int m = 0; m < 4; ++m) _Pragma("unroll") for (int k = 0; k < 2; ++k) dst[m][k] = *(const PG8_LAS bf16x8*)(lds + PG8_SA(b, h) + aoff + m * 2048 + k * 1024); } while (0)
#define PG8_LDB(dst, b, h) do { _Pragma("unroll") for (int n = 0; n < 2; ++n) _Pragma("unroll") for (int k = 0; k < 2; ++k) dst[n][k] = *(const PG8_LAS bf16x8*)(lds + PG8_SB(b, h) + boff + n * 2048 + k * 1024); } while (0)
#define PG8_MMA(ai, bj, At, Bt) do { __builtin_amdgcn_s_setprio(1); _Pragma("unroll") for (int m = 0; m < 4; ++m) _Pragma("unroll") for (int n = 0; n < 2; ++n) _Pragma("unroll") for (int k = 0; k < 2; ++k) \
        acc[ai][bj][m][n] = __builtin_amdgcn_mfma_f32_16x16x32_bf16(Bt[n][k], At[m][k], acc[ai][bj][m][n], 0, 0, 0); __builtin_amdgcn_s_setprio(0); } while (0)
#define PG8_WAIT_V(n) asm volatile("s_waitcnt vmcnt(" #n ")" ::: "memory")
#define PG8_WAIT_L(n) asm volatile("s_waitcnt lgkmcnt(" #n ")" ::: "memory")
#define PG8_BAR __builtin_amdgcn_s_barrier()
#define PG8_SCHED __builtin_amdgcn_sched_barrier(0)
    Unit cur, nxt; int ui = 0;
    if (!S.next(0, cur)) return;
    f32x4 acc[2][2][4][2];
#pragma unroll
    for (int a = 0; a < 2; ++a)
#pragma unroll
        for (int b = 0; b < 2; ++b)
#pragma unroll
            for (int m = 0; m < 4; ++m)
#pragma unroll
                for (int n = 0; n < 2; ++n) acc[a][b][m][n] = (f32x4){0.f, 0.f, 0.f, 0.f};
    bf16x8 At[4][2], B0[2][2], B1[2][2];
    const char* cA = PG8_SELA(cur.sub) + (size_t)cur.pm * tstep; const char* cB = PG8_SELB(cur.sub) + (size_t)cur.pn * tstep;
    S.a_ready(cur);
    if constexpr (Epi::PRE) E.pre(lds, cur, 0, wid, lane);
    if constexpr (SP2) {
        PG8_STAGE(PG8_SB(0, 0), cB, voffB); PG8_STAGE(PG8_SB(0, 1), cB + hstep, voffB); PG8_STAGE(PG8_SA(0, 0), cA, voffA); PG8_STAGE(PG8_SA(0, 1), cA + hstep, voffA);
        if (wr == 1) PG8_BAR;
        PG8_WAIT_V(2); PG8_BAR;
        PG8_STAGE(PG8_SB(1, 0), cB + kstep, voffB); PG8_STAGE(PG8_SA(1, 0), cA + kstep, voffA); PG8_STAGE(PG8_SB(1, 1), cB + hstep + kstep, voffB);
        PG8_WAIT_V(6); PG8_BAR;
    } else {
        PG8_STAGE(PG8_SB(0, 0), cB, voffB); PG8_STAGE(PG8_SA(0, 0), cA, voffA); PG8_STAGE(PG8_SB(0, 1), cB + hstep, voffB); PG8_STAGE(PG8_SA(0, 1), cA + hstep, voffA);
        if (wr == 1) PG8_BAR;
        PG8_WAIT_V(4); PG8_BAR;
        PG8_STAGE(PG8_SB(1, 0), cB + kstep, voffB); PG8_STAGE(PG8_SA(1, 0), cA + kstep, voffA); PG8_STAGE(PG8_SB(1, 1), cB + hstep + kstep, voffB);
        PG8_WAIT_V(6); PG8_BAR;
    }
    for (;;) {
        const bool has_next = S.next(ui + 1, nxt);
        const char* nA = has_next ? PG8_SELA(nxt.sub) + (size_t)nxt.pm * tstep : cA; const char* nB = has_next ? PG8_SELB(nxt.sub) + (size_t)nxt.pn * tstep : cB;
        for (int t = 0; t < nt; t += 2) {
            const bool last = (t == nt - 2);
            const char* a1 = cA + (size_t)(t + 1) * kstep;
            const char* a2 = last ? nA : cA + (size_t)(t + 2) * kstep; const char* b2 = last ? nB : cB + (size_t)(t + 2) * kstep;
            const char* a3 = a2 + kstep; const char* b3 = b2 + kstep;
            if (last && has_next) { S.a_ready(nxt); if constexpr (Epi::PRE) E.pre(lds, nxt, (ui + 1) & 1, wid, lane); }
            if constexpr (SP2) {
            PG8_LDB(B0, 0, 0); PG8_LDB(B1, 0, 1); PG8_SCHED; PG8_LDA(At, 0, 0); PG8_STAGE(PG8_SA(1, 1), a1 + hstep, voffA);
            PG8_WAIT_V(8); PG8_WAIT_L(0); PG8_BAR; PG8_MMA(0, 0, At, B0); PG8_MMA(0, 1, At, B1); PG8_BAR; PG8_SCHED;
            PG8_LDA(At, 0, 1); PG8_STAGE(PG8_SB(0, 0), b2, voffB); PG8_STAGE(PG8_SB(0, 1), b2 + hstep, voffB); PG8_STAGE(PG8_SA(0, 0), a2, voffA);
            PG8_WAIT_V(8); PG8_WAIT_L(0); PG8_BAR; PG8_MMA(1, 0, At, B0); PG8_MMA(1, 1, At, B1); PG8_BAR; PG8_SCHED;
            PG8_LDB(B0, 1, 0); PG8_LDB(B1, 1, 1); PG8_SCHED; PG8_LDA(At, 1, 0); PG8_STAGE(PG8_SA(0, 1), a2 + hstep, voffA);
            PG8_WAIT_V(8); PG8_WAIT_L(0); PG8_BAR; PG8_MMA(0, 0, At, B0); PG8_MMA(0, 1, At, B1); PG8_BAR; PG8_SCHED;
            PG8_LDA(At, 1, 1); PG8_STAGE(PG8_SB(1, 0), b3, voffB); PG8_STAGE(PG8_SB(1, 1), b3 + hstep, voffB); PG8_STAGE(PG8_SA(1, 0), a3, voffA);
            PG8_WAIT_V(8); PG8_WAIT_L(0); PG8_BAR; PG8_MMA(1, 0, At, B0); PG8_MMA(1, 1, At, B1);
            if constexpr (Epi::SPLIT) { if (last) { PG8_SCHED; E.template part<0>(acc, cur, wr, wc, fr, fq, lds, ui & 1); } }
            PG8_BAR; PG8_SCHED;
            } else {
            PG8_LDB(B0, 0, 0); PG8_SCHED; PG8_LDA(At, 0, 0); PG8_STAGE(PG8_SA(1, 1), a1 + hstep, voffA);
            PG8_WAIT_L(8); PG8_BAR; PG8_WAIT_L(0); PG8_MMA(0, 0, At, B0); PG8_BAR; PG8_SCHED;
            PG8_LDB(B1, 0, 1); PG8_STAGE(PG8_SB(0, 0), b2, voffB);
            PG8_BAR; PG8_WAIT_L(0); PG8_MMA(0, 1, At, B1); PG8_BAR;
            PG8_LDA(At, 0, 1); PG8_STAGE(PG8_SA(0, 0), a2, voffA);
            PG8_BAR; PG8_WAIT_L(0); PG8_MMA(1, 0, At, B0); PG8_BAR; PG8_SCHED;
            PG8_STAGE(PG8_SB(0, 1), b2 + hstep, voffB);
            PG8_WAIT_V(6); PG8_BAR; PG8_MMA(1, 1, At, B1); PG8_BAR;
            PG8_LDB(B0, 1, 0); PG8_SCHED; PG8_LDA(At, 1, 0); PG8_STAGE(PG8_SA(0, 1), a2 + hstep, voffA);
            PG8_WAIT_L(8); PG8_BAR; PG8_WAIT_L(0); PG8_MMA(0, 0, At, B0); PG8_BAR; PG8_SCHED;
            PG8_LDB(B1, 1, 1); PG8_STAGE(PG8_SB(1, 0), b3, voffB);
            PG8_BAR; PG8_WAIT_L(0); PG8_MMA(0, 1, At, B1); PG8_BAR;
            PG8_LDA(At, 1, 1); PG8_STAGE(PG8_SA(1, 0), a3, voffA);
            PG8_BAR; PG8_WAIT_L(0); PG8_MMA(1, 0, At, B0); PG8_BAR; PG8_SCHED;
            PG8_STAGE(PG8_SB(1, 1), b3 + hstep, voffB);
            PG8_WAIT_V(6); PG8_BAR; PG8_MMA(1, 1, At, B1); PG8_BAR;
            }
        }
        if constexpr (ALIGN_EPI) { if (wr == 0) PG8_BAR; }
        if constexpr (Epi::SPLIT) { E.template part<1>(acc, cur, wr, wc, fr, fq, lds, ui & 1); S.done(cur); }
        else if constexpr (Epi::PRE) { E.template part<0>(acc, cur, wr, wc, fr, fq, lds, ui & 1); E.template part<1>(acc, cur, wr, wc, fr, fq, lds, ui & 1); S.done(cur); }
        else if constexpr (!Epi::AFTER_DRAIN) { E(acc, cur, wr, wc, fr, fq); S.done(cur); }
        if (!has_next) break;
#pragma unroll
        for (int a = 0; a < 2; ++a)
#pragma unroll
            for (int b = 0; b < 2; ++b)
#pragma unroll
                for (int m = 0; m < 4; ++m)
#pragma unroll
                    for (int n = 0; n < 2; ++n) acc[a][b][m][n] = (f32x4){0.f, 0.f, 0.f, 0.f};
        cur = nxt; cA = nA; cB = nB; ++ui;
        if constexpr (ALIGN_EPI) { if (wr == 1) PG8_BAR; }
    }
    PG8_WAIT_V(0);
    if constexpr (!ALIGN_EPI) { if (wr == 0) PG8_BAR; }
    PG8_BAR;
    if constexpr (Epi::AFTER_DRAIN) { E.fused(acc, cur, wr, wc, fr, fq, lds, wid, lane); S.done(cur); }
#undef PG8_SA
#undef PG8_SELA
#undef PG8_SELB
#undef PG8_SB
#undef PG8_STAGE
#undef PG8_LDA
#undef PG8_LDB
#undef PG8_MMA
#undef PG8_WAIT_V
#undef PG8_WAIT_L
#undef PG8_BAR
#undef PG8_SCHED
}
}

#include <hip/hip_bf16.h>
#include <cmath>
namespace attn_body {
using bf16=__hip_bfloat16;
using bf16x8=__attribute__((ext_vector_type(8)))short;
using s16x4=__attribute__((ext_vector_type(4)))short;
using f32x16=__attribute__((ext_vector_type(16)))float;
using u32x4=__attribute__((ext_vector_type(4)))unsigned;
constexpr int BATCH=16,NHEAD=8,SEQ=2048,D=64,DM=NHEAD*D;
constexpr int NW=8,QBLK=32,QB=QBLK*NW,KVBLK=64,NQB=SEQ/QB;
constexpr int ATTN_PITCH=DM, ATTN_UNIT_ROWS=QB;
__device__ __forceinline__ int crow(int r,int hi){return (r&3)+8*(r>>2)+4*hi;}
#define SBAR() __builtin_amdgcn_sched_barrier(0)
__device__ __forceinline__ void cmask(f32x16&p0,f32x16&p1,int jb,int qrel,int hi){
  const float NEG=-INFINITY; int kb=64*jb+4*hi;
  #pragma unroll
  for(int r=0;r<16;++r){int kv=kb+(r&3)+8*(r>>2); if(kv>qrel)p0[r]=NEG; if(kv+32>qrel)p1[r]=NEG;}
}

constexpr int NSLOT=3, SLOTB=8192;
constexpr int LDS_K=0, LDS_V=NSLOT*SLOTB, LDS_WS=2*NSLOT*SLOTB, LDS_OST=LDS_WS+NW*64*4, LDS_F=LDS_OST+NW*4096, LDS_FW=LDS_F+SEQ*4, LDS_BYTES=LDS_FW+64;
constexpr float C2=0.125f*1.4426950408889634f;
__device__ __forceinline__ void glds16(const void*gsrc,unsigned lds_dst){unsigned keep;
  asm volatile("s_mov_b32 %0, m0\n\ts_mov_b32 m0, %2\n\ts_nop 0\n\tglobal_load_lds_dwordx4 %1, off\n\ts_mov_b32 m0, %0":"=&s"(keep):"v"(gsrc),"s"(lds_dst):"memory");}
__device__ __forceinline__ float max3f(float a,float b,float c){float r;asm("v_max3_f32 %0, %1, %2, %3":"=v"(r):"v"(a),"v"(b),"v"(c));return r;}
__device__ __forceinline__ float max2f(float a,float b){float r;asm("v_max_f32_e32 %0, %1, %2":"=v"(r):"v"(a),"v"(b));return r;}
__device__ __forceinline__ float fadd_s(float a,float b){float r;asm("v_add_f32_e32 %0, %1, %2":"=v"(r):"v"(a),"v"(b));return r;}
__device__ __forceinline__ float fsub_s(float a,float b){float r;asm("v_sub_f32_e32 %0, %1, %2":"=v"(r):"v"(a),"v"(b));return r;}
typedef float f32x2_t __attribute__((ext_vector_type(2))); typedef __bf16 bf16x2_t __attribute__((ext_vector_type(2)));
__device__ __forceinline__ unsigned cvtpk_s(float lo,float hi){f32x2_t v={lo,hi};bf16x2_t b=__builtin_convertvector(v,bf16x2_t);return __builtin_bit_cast(unsigned,b);}
#define WAIT_BAR(N) asm volatile("s_waitcnt vmcnt(" #N ") lgkmcnt(0)\n\ts_barrier":::"memory")

__device__ __forceinline__ void qkt(f32x16&p0,f32x16&p1,const char*Kslot,const bf16x8*qr,const f32x16&negm,int r32,int hi){
  const char*kb=Kslot+hi*1024+r32*16;
  #pragma unroll
  for(int d0=0;d0<4;++d0){
    const bf16x8 b0=*reinterpret_cast<const bf16x8*>(kb+d0*2048);
    const bf16x8 b1=*reinterpret_cast<const bf16x8*>(kb+d0*2048+512);
    if(d0==0){p0=__builtin_amdgcn_mfma_f32_32x32x16_bf16(b0,qr[0],negm,0,0,0);p1=__builtin_amdgcn_mfma_f32_32x32x16_bf16(b1,qr[0],negm,0,0,0);}
    else{p0=__builtin_amdgcn_mfma_f32_32x32x16_bf16(b0,qr[d0],p0,0,0,0);p1=__builtin_amdgcn_mfma_f32_32x32x16_bf16(b1,qr[d0],p1,0,0,0);}}
}
typedef __attribute__((address_space(3))) const char* lds_cptr;
typedef short v4i16_t __attribute__((ext_vector_type(4)));
__device__ __forceinline__ void kload8(bf16x8*kf,lds_cptr kp){
  kf[0]=*(const __attribute__((address_space(3))) bf16x8*)(kp);      kf[1]=*(const __attribute__((address_space(3))) bf16x8*)(kp+512);
  kf[2]=*(const __attribute__((address_space(3))) bf16x8*)(kp+2048); kf[3]=*(const __attribute__((address_space(3))) bf16x8*)(kp+2560);
  kf[4]=*(const __attribute__((address_space(3))) bf16x8*)(kp+4096); kf[5]=*(const __attribute__((address_space(3))) bf16x8*)(kp+4608);
  kf[6]=*(const __attribute__((address_space(3))) bf16x8*)(kp+6144); kf[7]=*(const __attribute__((address_space(3))) bf16x8*)(kp+6656);
}
__device__ __forceinline__ void kload2(bf16x8*kf,lds_cptr kp,int j){ kf[2*j]=*(const __attribute__((address_space(3))) bf16x8*)(kp+j*2048); kf[2*j+1]=*(const __attribute__((address_space(3))) bf16x8*)(kp+j*2048+512); }
__device__ __forceinline__ s16x4 vtr(lds_cptr p){ return __builtin_bit_cast(s16x4,__builtin_amdgcn_ds_read_tr16_b64_v4i16((__attribute__((address_space(3))) v4i16_t*)p)); }
__device__ __forceinline__ float rowmax(const f32x16&p0,const f32x16&p1){
  float a=max3f(p0[0],p0[1],p1[0]),b=max3f(p0[2],p0[3],p1[1]);a=max3f(a,p1[2],p1[3]);
  #pragma unroll
  for(int r=4;r<16;r+=4){a=max3f(a,p0[r],p0[r+1]);b=max3f(b,p0[r+2],p0[r+3]);a=max3f(a,p1[r],p1[r+1]);b=max3f(b,p1[r+2],p1[r+3]);}
  const float m=max2f(a,b);
  auto rr=__builtin_amdgcn_permlane32_swap(__float_as_uint(m),__float_as_uint(m),false,false);
  return max2f(__uint_as_float(rr[0]),__uint_as_float(rr[1]));
}
__device__ __forceinline__ void pv(f32x16*o,int vb,bf16x8 pa0,bf16x8 pa1,bf16x8 pa2,bf16x8 pa3){
  #pragma unroll
  for(int d0=0;d0<2;++d0){s16x4 lo[4],hi[4];
    #pragma unroll
    for(int ks=0;ks<4;++ks){
      asm volatile("ds_read_b64_tr_b16 %0,%1 offset:%c2":"=&v"(lo[ks]):"v"(vb),"i"(d0*4096+ks*1024):"memory");
      asm volatile("ds_read_b64_tr_b16 %0,%1 offset:%c2":"=&v"(hi[ks]):"v"(vb),"i"(d0*4096+ks*1024+512):"memory");}
    asm volatile("s_waitcnt lgkmcnt(0)":::"memory");SBAR();
    #define PK(k) (bf16x8){lo[k][0],lo[k][1],lo[k][2],lo[k][3],hi[k][0],hi[k][1],hi[k][2],hi[k][3]}
    o[d0]=__builtin_amdgcn_mfma_f32_32x32x16_bf16(pa0,PK(0),o[d0],0,0,0);
    o[d0]=__builtin_amdgcn_mfma_f32_32x32x16_bf16(pa1,PK(1),o[d0],0,0,0);
    o[d0]=__builtin_amdgcn_mfma_f32_32x32x16_bf16(pa2,PK(2),o[d0],0,0,0);
    o[d0]=__builtin_amdgcn_mfma_f32_32x32x16_bf16(pa3,PK(3),o[d0],0,0,0);
    #undef PK
  }
}

#ifndef ATTN_STORE16
#define ATTN_STORE16(p,v) (*(u32x4*)(p)=(v))
#endif
typedef float f32x4v __attribute__((ext_vector_type(4)));
__device__ __forceinline__ float logsig(float x){ return fminf(x,0.f)-__logf(1.f+__expf(-fabsf(x))); }
template<int THRL> __device__ __forceinline__ void attn_unit(int b,int h,int qb,const bf16*Q,const bf16*__restrict__ K,const bf16*__restrict__ V,bf16*O,char*shm,const float*__restrict__ flog,float bfh,bool newbh){
  int tid_=threadIdx.x; asm volatile("":"+v"(tid_)); const int tid=tid_,lane=tid&63,r32=lane&31,hi=lane>>5; const int wid=__builtin_amdgcn_readfirstlane(tid>>6);
  const long rowbase=(long)b*SEQ; const int q0=qb*QB;
  const bf16*Qw=Q+(rowbase+q0+wid*QBLK)*DM+h*D;
  const bf16*Kh=K+rowbase*DM+h*D,*Vh=V+rowbase*DM+h*D;
  const unsigned lds0=(unsigned)(uintptr_t)shm;
  float*wsf=(float*)(shm+LDS_WS)+wid*64;
  const bf16*ksrc=Kh+(long)lane*DM+wid*8;
  const bf16*vsrc=Vh+(long)(16*(wid&3)+(lane>>2))*DM+(wid>>2)*32+(lane&3)*8;
  const unsigned kdst=lds0+LDS_K+wid*1024, vdst=lds0+LDS_V+wid*1024;
  #define DMA_K(t,slot) glds16(ksrc+(long)(t)*KVBLK*DM,(unsigned)__builtin_amdgcn_readfirstlane(kdst+(slot)))
  #define DMA_V(t,slot) glds16(vsrc+(long)(t)*KVBLK*DM,(unsigned)__builtin_amdgcn_readfirstlane(vdst+(slot)))
  const int vb0=(int)(lds0+LDS_V)+((lane>>4)&1)*32+(lane&3)*8+(4*hi+((lane&15)>>2))*64;
  const char*Kbase=shm+LDS_K; bf16x8 kf[8];
  const lds_cptr shm3=(lds_cptr)shm; const lds_cptr kp0=shm3+LDS_K+hi*1024+r32*16; const lds_cptr vp0=shm3+LDS_V+((lane>>4)&1)*32+(lane&3)*8+(4*hi+((lane&15)>>2))*64;
  const int NT=(q0+QB)/KVBLK;
  typedef __attribute__((address_space(3))) float* lds_fptr;
  const lds_fptr fs3=(lds_fptr)(shm3+LDS_F); const lds_fptr fw3=(lds_fptr)(shm3+LDS_FW);
  if(newbh){ float v0=0.f,v1=0.f,v2=0.f,v3=0.f; const int t0=4*tid;
    { const float*fp=flog+(rowbase+t0)*NHEAD+h; v0=logsig(fp[0]+bfh); v1=logsig(fp[NHEAD]+bfh); v2=logsig(fp[2*NHEAD]+bfh); v3=logsig(fp[3*NHEAD]+bfh); }
    v1+=v0; v2+=v1; v3+=v2; float inc=v3;
    #pragma unroll
    for(int o=1;o<64;o<<=1){ const float nb=__shfl_up(inc,o); if(lane>=o)inc+=nb; }
    if(lane==63)fw3[wid]=inc;
    asm volatile("s_waitcnt lgkmcnt(0)\n\ts_barrier":::"memory");
    float woff=0.f;
    #pragma unroll
    for(int w_=0;w_<NW;++w_){ const float tw=fw3[w_]; if(w_<wid)woff+=tw; }
    const float ex=woff+(inc-v3); const float L2E=1.4426950408889634f;
    *(__attribute__((address_space(3))) f32x4v*)(fs3+t0)=(f32x4v){(v0+ex)*L2E,(v1+ex)*L2E,(v2+ex)*L2E,(v3+ex)*L2E};
    asm volatile("s_waitcnt lgkmcnt(0)\n\ts_barrier":::"memory"); }
  const float fq2=fs3[q0+wid*QBLK+r32];
  #define FKSUB(P0,P1,t) do{ const lds_fptr fk_=fs3+(t)*KVBLK+4*hi; \
    _Pragma("unroll") for(int r_=0;r_<16;++r_){ P0[r_]+=nq; P1[r_]+=nq; } \
    _Pragma("unroll") for(int j_=0;j_<4;++j_){ { const f32x4v a_=*(const __attribute__((address_space(3))) f32x4v*)(fk_+8*j_); \
      _Pragma("unroll") for(int i_=0;i_<4;++i_) P0[4*j_+i_]-=a_[i_]; } SBAR(); \
      { const f32x4v b_=*(const __attribute__((address_space(3))) f32x4v*)(fk_+32+8*j_); \
      _Pragma("unroll") for(int i_=0;i_<4;++i_) P1[4*j_+i_]-=b_[i_]; } SBAR(); } }while(0)
  #define INITRD(P0,P1,tt) do{ const lds_fptr fk_=fs3+(tt)*KVBLK+4*hi; \
    _Pragma("unroll") for(int j_=0;j_<4;++j_){ const f32x4v a_=*(const __attribute__((address_space(3))) f32x4v*)(fk_+8*j_); const f32x4v b_=*(const __attribute__((address_space(3))) f32x4v*)(fk_+32+8*j_); \
      _Pragma("unroll") for(int i_=0;i_<4;++i_){ P0[4*j_+i_]=a_[i_]; P1[4*j_+i_]=b_[i_]; } } }while(0)
  #define INITSUB(P0,P1) do{ _Pragma("unroll") for(int r_=0;r_<16;++r_){ P0[r_]=nq-P0[r_]; P1[r_]=nq-P1[r_]; } }while(0)
  DMA_K(0,0);DMA_V(0,0);DMA_K(1,SLOTB);
  bf16x8 qr[4];
  #pragma unroll
  for(int d0=0;d0<4;++d0)qr[d0]=*reinterpret_cast<const bf16x8*>(&Qw[(long)r32*DM+d0*16+hi*8]);
  float mhat=0.f,l_reg=0.f;f32x16 o[2];o[0]=f32x16{};o[1]=f32x16{};const f32x16 negm=f32x16{}; float nq=fq2;
  const int qrel=wid*QBLK+r32;
  #define CMASK(P0,P1,t) do{int jb_=(t)-(NT-4); if(jb_>=0)cmask(P0,P1,jb_,qrel,hi);}while(0)
  bool resc=false;
  #define START(P0,P1) do{ const float rm=rowmax(P0,P1); resc=false; \
    { const float dl=max2f(rm,0.f); mhat=fadd_s(mhat,dl);     \
      _Pragma("unroll") for(int r=0;r<16;++r){P0[r]=fsub_s(P0[r],dl);P1[r]=fsub_s(P1[r],dl);} \
      nq=fq2-mhat; } \
    _Pragma("unroll") for(int r=0;r<16;++r)P0[r]=__builtin_amdgcn_exp2f(P0[r]); }while(0)
  #define RESC() do{ if(resc){ asm volatile("s_waitcnt lgkmcnt(0)":::"memory"); \
      _Pragma("unroll") for(int d_=0;d_<2;++d_) _Pragma("unroll") for(int r=0;r<16;++r)o[d_][r]*=wsf[crow(r,hi)]; } }while(0)
  f32x16 pA0,pA1,pB0,pB1;
  int sl_prev=0,sl_cur=0,sl_next=SLOTB;
  #define ROT() do{sl_prev=sl_cur;sl_cur=sl_next;sl_next=(sl_next==(NSLOT-1)*SLOTB)?0:sl_next+SLOTB;}while(0)
  DMA_K(2,2*SLOTB);
  WAIT_BAR(3);
  qkt(pA0,pA1,Kbase,qr,negm,r32,hi);asm volatile("s_nop 15\n\ts_nop 7":"+v"(pA0),"+v"(pA1));FKSUB(pA0,pA1,0);CMASK(pA0,pA1,0);
  START(pA0,pA1);
  _Pragma("unroll") for(int r=0;r<16;++r)pA1[r]=__builtin_amdgcn_exp2f(pA1[r]);
  INITRD(pB0,pB1,1); INITSUB(pB0,pB1);
  WAIT_BAR(0);
  DMA_K(3,0);DMA_V(1,SLOTB);
  ROT();
  kload8(kf,kp0+sl_cur);
  WAIT_BAR(2);
  s16x4 vlo[8],vhi[8]; u32x4 pw0,pw1,pw2,pw3;
  #define PKW(P,B) cvtpk_s(P[B],P[B+1])
  #define PAF(k) __builtin_bit_cast(bf16x8,pw##k)
  #define VFR(i) (bf16x8){vlo[i][0],vlo[i][1],vlo[i][2],vlo[i][3],vhi[i][0],vhi[i][1],vhi[i][2],vhi[i][3]}
  #define PIN(x) asm volatile("":"+v"(x))
  #define MX3(a,b,c) __builtin_fmaxf(__builtin_fmaxf((a),(b)),(c))
  #define GAPA(MF,A0,A1,A2,A3,W0,W1,PW) do{ MF; sacc+=A0; sacc+=A1; sacc+=A2; sacc+=A3; PIN(sacc); W0; W1; PIN(PW); SBAR(); }while(0)
  #define EX(v) __builtin_amdgcn_exp2f(v)
  #define GAPB(MF,X,B) do{ MF; X[B]=EX(X[B]); X[B+1]=EX(X[B+1]); X[B+2]=EX(X[B+2]); X[B+3]=EX(X[B+3]); PIN(X); SBAR(); }while(0)
  #define VRD(i) do{ vlo[i]=vtr(vp_+(((i)>>2)*4096+((i)&3)*1024)); vhi[i]=vtr(vp_+(((i)>>2)*4096+((i)&3)*1024+512)); }while(0)
  #define KRD(G,j) do{ if(G){ kload2(kf,kp0+sl_next,j); SBAR(); } }while(0)
  #define STEP(C0,C1,P0,P1,t,GK,GV,GL) do{ SBAR(); \
    const lds_cptr vp_=vp0+sl_prev; \
    VRD(0); SBAR(); float sacc=(P0[0]+P0[1]); \
    GAPA(C0=__builtin_amdgcn_mfma_f32_32x32x16_bf16(kf[0],qr[0],C0,0,0,0), P0[2],P0[3],P0[4],P0[5],     pw0[0]=PKW(P0,0), pw0[1]=PKW(P0,2), pw0); \
    VRD(4); SBAR(); GAPA(C1=__builtin_amdgcn_mfma_f32_32x32x16_bf16(kf[1],qr[0],C1,0,0,0), P0[6],P0[7],P0[8],P0[9],     pw0[2]=PKW(P0,4), pw0[3]=PKW(P0,6), pw0); \
    VRD(1); SBAR(); GAPA(C0=__builtin_amdgcn_mfma_f32_32x32x16_bf16(kf[2],qr[1],C0,0,0,0),   P0[10],P0[11],P0[12],P0[13], pw1[0]=PKW(P0,8), pw1[1]=PKW(P0,10), pw1); \
    VRD(5); SBAR(); GAPA(C1=__builtin_amdgcn_mfma_f32_32x32x16_bf16(kf[3],qr[1],C1,0,0,0),   P0[14],P0[15],P1[0],P1[1],   pw1[2]=PKW(P0,12),pw1[3]=PKW(P0,14), pw1); \
    VRD(2); SBAR(); GAPA(C0=__builtin_amdgcn_mfma_f32_32x32x16_bf16(kf[4],qr[2],C0,0,0,0),   P1[2],P1[3],P1[4],P1[5],     pw2[0]=PKW(P1,0), pw2[1]=PKW(P1,2), pw2); \
    VRD(6); SBAR(); GAPA(C1=__builtin_amdgcn_mfma_f32_32x32x16_bf16(kf[5],qr[2],C1,0,0,0),   P1[6],P1[7],P1[8],P1[9],     pw2[2]=PKW(P1,4), pw2[3]=PKW(P1,6), pw2); \
    VRD(3); SBAR(); GAPA(C0=__builtin_amdgcn_mfma_f32_32x32x16_bf16(kf[6],qr[3],C0,0,0,0),   P1[10],P1[11],P1[12],P1[13], pw3[0]=PKW(P1,8), pw3[1]=PKW(P1,10), pw3); \
    VRD(7); SBAR(); GAPA(C1=__builtin_amdgcn_mfma_f32_32x32x16_bf16(kf[7],qr[3],C1,0,0,0),   P1[14],P1[15],0.f,0.f,       pw3[2]=PKW(P1,12),pw3[3]=PKW(P1,14), pw3); \
    l_reg+=sacc; \
    if(GK){DMA_K((t)+3,sl_cur);} if(GV){DMA_V((t)+1,sl_next);} \
    CMASK(C0,C1,t); \
    { float a=MX3(C0[0],C0[1],C1[0]),b=MX3(C0[2],C0[3],C1[1]); a=MX3(a,C1[2],C1[3]); \
      _Pragma("unroll") for(int r=4;r<16;r+=4){a=MX3(a,C0[r],C0[r+1]);b=MX3(b,C0[r+2],C0[r+3]);a=MX3(a,C1[r],C1[r+1]);b=MX3(b,C1[r+2],C1[r+3]);} \
      float rm=__builtin_fmaxf(a,b); { auto rr=__builtin_amdgcn_permlane32_swap(__float_as_uint(rm),__float_as_uint(rm),false,false); rm=__builtin_fmaxf(__uint_as_float(rr[0]),__uint_as_float(rr[1])); } \
      resc=false; \
      if(__builtin_expect(__any(rm>(float)THRL),0)){ const float dl=__builtin_fmaxf(rm,0.f); mhat+=dl; \
        _Pragma("unroll") for(int r=0;r<16;++r){C0[r]-=dl;C1[r]-=dl;} \
        nq=fq2-mhat; \
        const float f=__builtin_amdgcn_exp2f(-dl); l_reg*=f; if(hi==0)wsf[r32]=f; resc=true; } } \
    SBAR(); if(GL){INITRD(P0,P1,(t)+1);} SBAR(); \
    GAPB(o[0]=__builtin_amdgcn_mfma_f32_32x32x16_bf16(PAF(0),VFR(0),o[0],0,0,0), C0,0); \
    GAPB(o[1]=__builtin_amdgcn_mfma_f32_32x32x16_bf16(PAF(0),VFR(4),o[1],0,0,0), C0,4); \
    KRD(GL,0); GAPB(o[0]=__builtin_amdgcn_mfma_f32_32x32x16_bf16(PAF(1),VFR(1),o[0],0,0,0), C0,8); \
    KRD(GL,1); GAPB(o[1]=__builtin_amdgcn_mfma_f32_32x32x16_bf16(PAF(1),VFR(5),o[1],0,0,0), C0,12); \
    KRD(GL,2); GAPB(o[0]=__builtin_amdgcn_mfma_f32_32x32x16_bf16(PAF(2),VFR(2),o[0],0,0,0), C1,0); \
    KRD(GL,3); GAPB(o[1]=__builtin_amdgcn_mfma_f32_32x32x16_bf16(PAF(2),VFR(6),o[1],0,0,0), C1,4); \
    GAPB(o[0]=__builtin_amdgcn_mfma_f32_32x32x16_bf16(PAF(3),VFR(3),o[0],0,0,0), C1,8); \
    GAPB(o[1]=__builtin_amdgcn_mfma_f32_32x32x16_bf16(PAF(3),VFR(7),o[1],0,0,0), C1,12); \
    if(GL){INITSUB(P0,P1);} \
    }while(0)
  int t=1;
  #undef CMASK
  #define CMASK(P0,P1,t) do{}while(0)
  for(;t+5<NT;t+=2){
    STEP(pB0,pB1,pA0,pA1,t,true,true,true);     WAIT_BAR(2); RESC(); ROT();
    STEP(pA0,pA1,pB0,pB1,t+1,true,true,true);   WAIT_BAR(2); RESC(); ROT();
  }
  #undef CMASK
  #define CMASK(P0,P1,t) do{int jb_=(t)-(NT-4); if(jb_>=0)cmask(P0,P1,jb_,qrel,hi);}while(0)
  #define ENDW(tt) do{ if((tt)+3<NT){WAIT_BAR(2);} else if((tt)+2<NT){WAIT_BAR(1);} else {WAIT_BAR(0);} }while(0)
  for(;t+1<NT;t+=2){
    STEP(pB0,pB1,pA0,pA1,t,(t+3<NT),(t+1<NT),(t+1<NT));       ENDW(t);   RESC(); ROT();
    STEP(pA0,pA1,pB0,pB1,t+1,(t+4<NT),(t+2<NT),(t+2<NT));     ENDW(t+1); RESC(); ROT();
  }
  STEP(pB0,pB1,pA0,pA1,NT-1,false,false,false); RESC();
  { float sacc=pB0[0]+pB0[1]; _Pragma("unroll") for(int r=2;r<16;++r)sacc+=pB0[r]; _Pragma("unroll") for(int r=0;r<16;++r)sacc+=pB1[r]; l_reg+=sacc;
    pw0=(u32x4){PKW(pB0,0),PKW(pB0,2),PKW(pB0,4),PKW(pB0,6)};pw1=(u32x4){PKW(pB0,8),PKW(pB0,10),PKW(pB0,12),PKW(pB0,14)};pw2=(u32x4){PKW(pB1,0),PKW(pB1,2),PKW(pB1,4),PKW(pB1,6)};pw3=(u32x4){PKW(pB1,8),PKW(pB1,10),PKW(pB1,12),PKW(pB1,14)};
    SBAR(); pv(o,vb0+sl_cur,PAF(0),PAF(1),PAF(2),PAF(3)); }
  #undef PKW
  #undef PAF
  #undef VFR
  #undef PIN
  #undef MX3
  #undef GAPA
  #undef GAPB
  #undef EX
  #undef VRD
  #undef KRD
  #undef STEP
  #undef ENDW
  {auto rr=__builtin_amdgcn_permlane32_swap(__float_as_uint(l_reg),__float_as_uint(l_reg),false,false);l_reg=__uint_as_float(rr[0])+__uint_as_float(rr[1]);}
  if(hi==0)wsf[32+r32]=l_reg;asm volatile("s_waitcnt lgkmcnt(0)":::"memory");
  float rli[16];
  #pragma unroll
  for(int r=0;r<16;++r)rli[r]=__builtin_amdgcn_rcpf(wsf[32+crow(r,hi)]);
  bf16*Ow=O+(rowbase+q0+wid*QBLK)*DM+h*D;
  { bf16*stg=(bf16*)(shm+LDS_OST)+wid*2048;
    #pragma unroll
    for(int r=0;r<16;++r){const int orow=crow(r,hi);
      #pragma unroll
      for(int d0=0;d0<2;++d0)stg[orow*64+d0*32+r32]=__float2bfloat16(o[d0][r]*rli[r]);}
    asm volatile("s_waitcnt lgkmcnt(0)":::"memory");
    #pragma unroll
    for(int i=0;i<4;++i){const int row=i*8+(lane>>3),ch=lane&7; const u32x4 v=*(const u32x4*)(stg+row*64+ch*8); ATTN_STORE16(Ow+(long)row*DM+ch*8,v);} }
  asm volatile("s_waitcnt lgkmcnt(0)\n\ts_barrier":::"memory");
  #undef FKSUB
  #undef INITRD
  #undef INITSUB
  #undef DMA_K
  #undef DMA_V
  #undef CMASK
  #undef START
  #undef RESC
  #undef ROT
}
constexpr int ATTN_LDS_BYTES=LDS_BYTES;
struct AttnTensors { const bf16* Q; const bf16* K; const bf16* V; bf16* O; const float* flog; const float* bf; };
struct AttnUnit { int bh; int qb; };
struct StaticOrder {
  int vcu,G;
  __device__ __forceinline__ explicit StaticOrder(int grid,int v):vcu(v),G(grid){}
  __device__ __forceinline__ bool next(int i,AttnUnit&u)const{
    if(G==256){ if(i>=4)return false; const int s=vcu&1; u.bh=vcu>>1; u.qb=(i==0)?7-s:(i==1)?4+s:(i==2)?3-s:s; return true; }
    const int idx=i*G+vcu; if(idx>=BATCH*NHEAD*NQB)return false; u.bh=idx>>3; u.qb=7-(idx&7); return true; }
  __device__ __forceinline__ void a_ready(const AttnUnit&)const{}
  __device__ __forceinline__ void done(const AttnUnit&)const{}
};
template<class Sched,int THRL=8> __device__ __forceinline__ void attn_phase(char*lds,const AttnTensors&T,const Sched&S){
  AttnUnit u; int prevbh=-1;
  for(int i=0;S.next(i,u);++i){ S.a_ready(u); attn_unit<THRL>(u.bh/NHEAD,u.bh%NHEAD,u.qb,T.Q,T.K,T.V,T.O,lds,T.flog,T.bf[u.bh%NHEAD],u.bh!=prevbh); prevbh=u.bh; S.done(u); }
}
#undef SBAR
#undef WAIT_BAR
}
namespace cg = cooperative_groups;
constexpr int NWAVES = 8;
constexpr int BATCH = 16, SEQ = 2048, DMODEL = 1024, MROWS = BATCH * SEQ, NHEADS = 8, AW = 512, FFH = 2816, NIN = 6912, NINSRC = 6664, DEPTH = 2;
constexpr size_t MiB = 1u << 20, KiB512 = 512u << 10;
constexpr size_t WS_SSQ = 0;
constexpr size_t WS_FLOG = 3 * MiB;
constexpr size_t WS_WIN = 4 * MiB;
constexpr size_t WS_WL = 18 * MiB, WL_STRIDE = 21 * MiB + MiB / 2;
constexpr size_t WL_A = 0, WL_B = 1 * MiB, WL_C = 2 * MiB, WL_OUT = 3 * MiB, WL_GU = 5 * MiB, WL_DN = 16 * MiB;
constexpr size_t WS_XB = 61 * MiB;
constexpr size_t WS_QA = 125 * MiB, WS_K = 157 * MiB, WS_V = 189 * MiB, WS_MIX = 157 * MiB;
constexpr size_t WS_U = 221 * MiB, WS_Z = 253 * MiB, WS_CB = 285 * MiB, WS_G = 317 * MiB;
constexpr size_t WS_ACT = 125 * MiB;
constexpr size_t WS_END = 509 * MiB;
static_assert(WS_K == WS_QA + 32 * MiB && WS_V == WS_QA + 64 * MiB && WS_U == WS_QA + 96 * MiB && WS_Z == WS_QA + 128 * MiB && WS_CB == WS_QA + 160 * MiB, "EpiIn addresses Q|K|V|U|Z|CB as six consecutive blocks");
static_assert(WS_WL + 2 * WL_STRIDE <= WS_XB && WS_G + (size_t)MROWS * 3072 * 2 <= WS_END && WS_ACT + (size_t)MROWS * FFH * 2 <= WS_G, "d_ws map");
constexpr int RING_BYTES = 131072, LDS_BYTES = 147456;

#define GAS __attribute__((address_space(1)))
#define LAS __attribute__((address_space(3)))
typedef unsigned short bf16;
typedef unsigned v4u __attribute__((ext_vector_type(4)));
typedef float f32x4 __attribute__((ext_vector_type(4)));
#define LDS_WAIT() asm volatile("s_waitcnt lgkmcnt(0)" ::: "memory")
__device__ __forceinline__ unsigned f2bf(float f) { unsigned u = __builtin_bit_cast(unsigned, f); return (u + 0x7fffu + ((u >> 16) & 1u)) >> 16; }
typedef float f32x2f_t __attribute__((ext_vector_type(2))); typedef __bf16 bf16x2f_t __attribute__((ext_vector_type(2)));
__device__ __forceinline__ unsigned pk2(float lo, float hi) { const f32x2f_t v = {lo, hi}; const bf16x2f_t b = __builtin_convertvector(v, bf16x2f_t); return __builtin_bit_cast(unsigned, b); }
__device__ __forceinline__ float wave_sum(float v) {
#pragma unroll
    for (int o = 1; o < 64; o <<= 1) v += __shfl_xor(v, o);
    return v;
}
struct CmId { __device__ __forceinline__ int operator()(int n) const { return n; } };
struct CmIn { __device__ __forceinline__ int operator()(int n) const {
    if (n < 1536) return n;
    if (n < 2048) return n + 8;
    if (n < 3072) { const int j = (n - 2048) >> 8, w = (n - 2048) & 255; return w < 128 ? 2056 + 128 * j + w : 3080 + 128 * j + (w - 128); }
    if (n < 3584) return 2568 + (n - 3072);
    if (n < 6656) return n + 8;
    if (n < 6664) return 1536 + (n - 6656);
    return -1; } };
struct CmGU { __device__ __forceinline__ int operator()(int n) const { const int j = n >> 8, w = n & 255; return w < 128 ? 128 * j + w : FFH + 128 * j + (w - 128); } };
__device__ __forceinline__ void wb_item(const float* pool_w, const float* pscale, const float* wpp, bf16* WBt, int item, int lane) {
    const int nb = (item >> 3) & 15, c8 = (item & 7) + 8 * (item >> 7), n = 64 * nb + lane, c0 = 8 * c8, g = c0 >> 7, cl = c0 & 127;
    float a0 = 0.f, a1 = 0.f, a2 = 0.f, a3 = 0.f, a4 = 0.f, a5 = 0.f, a6 = 0.f, a7 = 0.f;
    const float* pw = pool_w + ((size_t)g * 128 + cl) * 128;
#pragma unroll 2
    for (int d = 0; d < 128; d += 4) {
        const f32x4 ps = *(const GAS f32x4*)(pscale + g * 128 + d);
        const float w0 = wpp[(size_t)(g * 128 + d) * 1024 + n] * ps[0], w1 = wpp[(size_t)(g * 128 + d + 1) * 1024 + n] * ps[1], w2 = wpp[(size_t)(g * 128 + d + 2) * 1024 + n] * ps[2], w3 = wpp[(size_t)(g * 128 + d + 3) * 1024 + n] * ps[3];
#define WB_ROW(acc_, j_) { const f32x4 p_ = *(const GAS f32x4*)(pw + (j_) * 128 + d); acc_ += (p_[0] * w0 + p_[1] * w1) + (p_[2] * w2 + p_[3] * w3); }
        WB_ROW(a0, 0) WB_ROW(a1, 1) WB_ROW(a2, 2) WB_ROW(a3, 3) WB_ROW(a4, 4) WB_ROW(a5, 5) WB_ROW(a6, 6) WB_ROW(a7, 7)
#undef WB_ROW
    }
    v4u o; o.x = pk2(a0, a1); o.y = pk2(a2, a3); o.z = pk2(a4, a5); o.w = pk2(a6, a7);
    *(GAS v4u*)(WBt + (size_t)n * 512 + c0) = o;
}

struct Args { const float* in[16]; float* out; unsigned char* ws; int ph_lo, ph_hi; };
#define XB_TMO      128
#define XB_XCNT(j)  (256  + 64 * (j))
#define XB_XSUB(j)  (1280 + 64 * (j))
#define XB_XGEN(j)  (2304 + 64 * (j))
#define XB_TOP      3328
#define XB_TOPGEN   3392
#define XCD_BAR_WORDS 3456
#define XB_SPIN_CAP (1u << 18)

__device__ __forceinline__ unsigned xb_ld(unsigned* p)              { return __hip_atomic_load(p, __ATOMIC_RELAXED, __HIP_MEMORY_SCOPE_AGENT); }
__device__ __forceinline__ unsigned xb_add(unsigned* p, unsigned v) { return __hip_atomic_fetch_add(p, v, __ATOMIC_RELAXED, __HIP_MEMORY_SCOPE_AGENT); }
__device__ __forceinline__ unsigned xb_xcc_id() { return (unsigned)__builtin_amdgcn_s_getreg((3 << 11) | 20) & 0xFu; }
#define XB_SPIN(cond, bar) do { unsigned _sp = 0; while (cond) { __builtin_amdgcn_s_sleep(1); \
    if ((++_sp & 255u) == 0u) { if (xb_ld(&(bar)[XB_TMO])) break; if (_sp > XB_SPIN_CAP) { atomicAdd(&(bar)[XB_TMO], 1u); break; } } } } while (0)

struct XcdBarrier {
    unsigned* bar; unsigned x;
    volatile LAS unsigned* st;
};

__device__ __forceinline__ XcdBarrier xcd_barrier_post(unsigned* bar, volatile LAS unsigned* st) {
    XcdBarrier b; b.bar = bar; b.x = xb_xcc_id(); b.st = st;
    if (threadIdx.x == 0) (void)xb_add(&bar[XB_XCNT(b.x)], 1u);
    return b;
}
__device__ __forceinline__ void xcd_barrier_complete(unsigned* bar, unsigned x, unsigned& nloc, unsigned& nx) {
    const unsigned G = gridDim.x * gridDim.y * gridDim.z;
    unsigned sum, cnt, mine, sp = 0u;
    for (;;) {
        sum = 0u; cnt = 0u; mine = 0u;
#pragma unroll
        for (unsigned j = 0; j < 16; ++j) { const unsigned c = xb_ld(&bar[XB_XCNT(j)]); sum += c; cnt += (c > 0u) ? 1u : 0u; mine = (j == x) ? c : mine; }
        if (sum == G) break;
        __builtin_amdgcn_s_sleep(1);
        if ((++sp & 255u) == 0u) { if (xb_ld(&bar[XB_TMO])) break; if (sp > XB_SPIN_CAP) { atomicAdd(&bar[XB_TMO], 1u); break; } }
    }
    nloc = mine > 0u ? mine : 1u; nx = cnt > 0u ? cnt : 1u;
}

__device__ __forceinline__ void xcd_barrier(const XcdBarrier& b) {
    asm volatile("s_waitcnt vmcnt(0)" ::: "memory");
    __syncthreads();
    if (threadIdx.x == 0) {
        unsigned* bar = b.bar;
        __builtin_amdgcn_s_waitcnt(0);
        unsigned nloc = b.st[0], nx = b.st[1];
        if (nloc == 0u) { xcd_barrier_complete(bar, b.x, nloc, nx); b.st[0] = nloc; b.st[1] = nx; }
        const unsigned old = xb_add(&bar[XB_XSUB(b.x)], 1u);
        const unsigned gen = old / nloc;
        if (old + 1u == (gen + 1u) * nloc) {
            __builtin_amdgcn_fence(__ATOMIC_RELEASE, "agent");
            asm volatile("s_waitcnt vmcnt(0)" ::: "memory");
            const unsigned og = xb_add(&bar[XB_TOP], 1u);
            const unsigned tg = og / nx;
            if (og + 1u == (tg + 1u) * nx) xb_add(&bar[XB_TOPGEN], 1u);
            else XB_SPIN(xb_ld(&bar[XB_TOPGEN]) == tg, bar);
            __builtin_amdgcn_fence(__ATOMIC_ACQUIRE, "agent");
            xb_add(&bar[XB_XGEN(b.x)], 1u);
            asm volatile("s_waitcnt vmcnt(0)" ::: "memory");
        } else {
            XB_SPIN(xb_ld(&bar[XB_XGEN(b.x)]) == gen, bar);
            __builtin_amdgcn_fence(__ATOMIC_ACQUIRE, "agent");
            asm volatile("s_waitcnt vmcnt(0)" ::: "memory");
        }
    }
    __syncthreads();
}

constexpr size_t WS_BAR = 2 * MiB + 512 * 1024;
constexpr int BARLDS_OFF = RING_BYTES;
#ifndef REP_SEAM
#define REP_SEAM 1
#endif
#define GRID_SEAM() for (int rs_ = 0; rs_ < REP_SEAM; ++rs_) xcd_barrier(bar)

struct TrD { const float* W; const float* kscale; bf16* WT; int ldw, K, nblk, cmk, item; };
__device__ __forceinline__ void tr_desc(const Args& a, int it, TrD& d) {
    constexpr int I_IN = 16 * (NIN / 32), I_A = 8 * 32, I_OUT = 16 * 32, I_GU = 16 * (2 * FFH / 32), I_DN = (FFH / 64) * 32, PER_TR = I_IN + 2 * I_A + I_OUT + I_GU + I_DN;
    const int l = it / PER_TR; int r = it - l * PER_TR; unsigned char* wl = a.ws + WS_WL + (size_t)l * WL_STRIDE;
    d.kscale = nullptr; d.cmk = 0; d.ldw = 1024; d.nblk = 32;
    if (r < I_IN) { d.W = a.in[2] + (size_t)l * 1024 * NINSRC; d.ldw = NINSRC; d.K = 1024; d.WT = (l == 0) ? (bf16*)(a.ws + WS_WIN) : (bf16*)((unsigned char*)a.out + 64 * MiB); d.nblk = NIN / 32; d.kscale = a.in[1] + l * 1024; d.cmk = 1; d.item = r; return; } r -= I_IN;
    if (r < I_A) { d.W = a.in[5] + (size_t)l * 512 * 1024; d.K = 512; d.WT = (bf16*)(wl + WL_A); d.item = r; return; } r -= I_A;
    if (r < I_A) { d.W = a.in[10] + (size_t)l * 512 * 1024; d.K = 512; d.WT = (bf16*)(wl + WL_C); d.item = r; return; } r -= I_A;
    if (r < I_OUT) { d.W = a.in[11] + (size_t)l * 1024 * 1024; d.K = 1024; d.WT = (bf16*)(wl + WL_OUT); d.item = r; return; } r -= I_OUT;
    if (r < I_GU) { d.W = a.in[13] + (size_t)l * 1024 * 2 * FFH; d.ldw = 2 * FFH; d.K = 1024; d.WT = (bf16*)(wl + WL_GU); d.nblk = 2 * FFH / 32; d.kscale = a.in[12] + l * 1024; d.cmk = 2; d.item = r; return; } r -= I_GU;
    d.W = a.in[14] + (size_t)l * FFH * 1024; d.K = FFH; d.WT = (bf16*)(wl + WL_DN); d.item = r;
}
__device__ __forceinline__ void tr_load(const TrD& d, int lane, f32x4 (&v)[8]) {
    const int kb = d.item / d.nblk, nb = d.item % d.nblk, k0 = 64 * kb, n0 = 32 * nb, c4 = lane & 7, rr = lane >> 3, nd = n0 + 4 * c4;
    const int sc = d.cmk == 1 ? CmIn()(nd) : (d.cmk == 2 ? CmGU()(nd) : nd);
#pragma unroll
    for (int i = 0; i < 8; ++i) { const int k = k0 + 8 * i + rr; v[i] = (f32x4){0.f, 0.f, 0.f, 0.f}; if (sc >= 0) v[i] = *(const GAS f32x4*)(d.W + (size_t)k * d.ldw + sc); if (d.kscale) v[i] = v[i] * d.kscale[k]; }
}
__device__ __forceinline__ void tr_store(const TrD& d, int lane, const f32x4 (&v)[8], LAS float* scr) {
    const int kb = d.item / d.nblk, nb = d.item % d.nblk, k0 = 64 * kb, n0 = 32 * nb, c4 = lane & 7, rr = lane >> 3;
#pragma unroll
    for (int i = 0; i < 8; ++i) { LAS float* p = scr + (8 * i + rr) * 33 + 4 * c4; p[0] = v[i][0]; p[1] = v[i][1]; p[2] = v[i][2]; p[3] = v[i][3]; }
    LDS_WAIT(); asm volatile("" ::: "memory");
    const int c = lane & 7;
#pragma unroll
    for (int j = 0; j < 4; ++j) { const int n = (lane >> 3) + 8 * j; const LAS float* s = scr + (8 * c) * 33 + n;
        v4u o; o.x = pk2(s[0 * 33], s[1 * 33]); o.y = pk2(s[2 * 33], s[3 * 33]); o.z = pk2(s[4 * 33], s[5 * 33]); o.w = pk2(s[6 * 33], s[7 * 33]);
        *(GAS v4u*)(d.WT + (size_t)(n0 + n) * d.K + k0 + 8 * c) = o; }
    LDS_WAIT(); asm volatile("" ::: "memory");
}
__device__ __forceinline__ void convert_weights(const Args& a, LAS float* scr, int gw, int NGW, int lane, int mode, int lsel) {
    constexpr int I_IN = 16 * (NIN / 32), I_A = 8 * 32, I_OUT = 16 * 32, I_GU = 16 * (2 * FFH / 32), I_DN = (FFH / 64) * 32, PER_TR = I_IN + 2 * I_A + I_OUT + I_GU + I_DN, I_WB = 1024;
    static_assert(I_WB % 8 == 0, "wb_item: items 8k..8k+7 must be the eight waves of one workgroup");
    const int nwb = mode == 2 ? 0 : 2 * I_WB;
    for (int it = gw; it < nwb; it += NGW) { const int l = it / I_WB, r = it - l * I_WB; unsigned char* wl = a.ws + WS_WL + (size_t)l * WL_STRIDE;
        wb_item(a.in[6] + (size_t)l * 4 * 128 * 128, a.in[7] + l * 512, a.in[8] + (size_t)l * 512 * 1024, (bf16*)(wl + WL_B), r, lane); }
    constexpr int I_ACO = 2 * I_A + I_OUT, I_P = I_IN + I_GU, I_S = I_ACO + I_DN;
    const int ntr = mode == 0 ? 2 * PER_TR : (mode == 1 ? 2 * I_P : I_S);
#define TR_MAP(i_) (mode == 0 ? (i_) : (mode == 1 ? ((i_) / I_P) * PER_TR + (((i_) % I_P) < I_IN ? ((i_) % I_P) : ((i_) % I_P) + I_ACO) : lsel * PER_TR + I_IN + ((i_) < I_ACO ? (i_) : (i_) + I_GU)))
    int it = gw; bool h0 = it < ntr, h1 = it + NGW < ntr; TrD d0, d1, d2; f32x4 va[8], vb[8], vc[8];
    if (h0) { tr_desc(a, TR_MAP(it), d0); tr_load(d0, lane, va); }
    if (h1) { tr_desc(a, TR_MAP(it + NGW), d1); tr_load(d1, lane, vb); }
    while (h0) {
        const int it2 = it + 2 * NGW; const bool h2 = it2 < ntr;
        if (h2) { tr_desc(a, TR_MAP(it2), d2); tr_load(d2, lane, vc); }
        tr_store(d0, lane, va, scr);
        d0 = d1; d1 = d2; it += NGW; h0 = h1; h1 = h2;
#pragma unroll
        for (int i = 0; i < 8; ++i) { va[i] = vb[i]; vb[i] = vc[i]; }
    }
#undef TR_MAP
}

__device__ __forceinline__ void x_to_bf16(const Args& a, int gw, int NGW, int lane) {
    const float* x = a.in[0]; bf16* XB = (bf16*)(a.ws + WS_XB);
    const int per = (MROWS + NGW - 1) / NGW;
    for (int m0 = gw * per; m0 < MROWS && m0 < (gw + 1) * per; m0 += 4) {
        f32x4 v[4][4];
#pragma unroll
        for (int r = 0; r < 4; ++r)
#pragma unroll
            for (int j = 0; j < 4; ++j) v[r][j] = *((const GAS f32x4*)(x + (size_t)(m0 + r) * 1024) + lane + 64 * j);
#pragma unroll
        for (int r = 0; r < 4; ++r) { const int m = m0 + r; float s = 0.f;
#pragma unroll
            for (int j = 0; j < 4; ++j) s += (v[r][j].x * v[r][j].x + v[r][j].y * v[r][j].y) + (v[r][j].z * v[r][j].z + v[r][j].w * v[r][j].w);
            s = wave_sum(s);
            GAS unsigned long long* o8 = (GAS unsigned long long*)(XB + (size_t)m * 1024) + lane;
#pragma unroll
            for (int j = 0; j < 4; ++j) o8[64 * j] = (unsigned long long)pk2(v[r][j].x, v[r][j].y) | ((unsigned long long)pk2(v[r][j].z, v[r][j].w) << 32);
            if (lane < 20) { const int bufi = lane >> 2, slot = lane & 3; *(GAS float*)(a.ws + WS_SSQ + (size_t)bufi * KiB512 + ((size_t)slot * MROWS + m) * 4) = (lane == 0) ? s : 0.f; } }
    }
}

__device__ __forceinline__ void unpk8(const v4u w, float (&f)[8]) {
    f[0] = __uint_as_float(w.x << 16); f[1] = __uint_as_float(w.x & 0xffff0000u); f[2] = __uint_as_float(w.y << 16); f[3] = __uint_as_float(w.y & 0xffff0000u);
    f[4] = __uint_as_float(w.z << 16); f[5] = __uint_as_float(w.z & 0xffff0000u); f[6] = __uint_as_float(w.w << 16); f[7] = __uint_as_float(w.w & 0xffff0000u); }
__device__ __forceinline__ v4u pk8(const float (&f)[8]) { v4u o; o.x = pk2(f[0], f[1]); o.y = pk2(f[2], f[3]); o.z = pk2(f[4], f[5]); o.w = pk2(f[6], f[7]); return o; }

__device__ __forceinline__ void pool_conv_phase(const Args& a, int l, int vcu, int G, int tid) {
    const bf16* __restrict__ U = (const bf16*)(a.ws + WS_U); const bf16* __restrict__ Z = (const bf16*)(a.ws + WS_Z); const bf16* __restrict__ CB = (const bf16*)(a.ws + WS_CB);
    bf16* __restrict__ Dp = (bf16*)a.out; bf16* __restrict__ YC = (bf16*)a.out + (size_t)MROWS * 512;
    const float* cw = a.in[9] + (size_t)l * 3 * 512;
    const int cgp = tid & 63, seg = tid >> 6, ch = 8 * cgp, w = 2 << (cgp >> 4);
    float w0[8], w1[8], w2[8];
#pragma unroll
    for (int j = 0; j < 8; ++j) { w0[j] = cw[ch + j]; w1[j] = cw[512 + ch + j]; w2[j] = cw[1024 + ch + j]; }
    for (int chunk = vcu; chunk < MROWS / 128; chunk += G) {
        const int first = chunk * 128 + seg * 16, tb = first & (SEQ - 1);
        { float sum[8], uc[8], t8[8];
#pragma unroll
          for (int j = 0; j < 8; ++j) sum[j] = 0.f;
          for (int j = 1; j < w; ++j) if (tb - j >= 0) { unpk8(*(const GAS v4u*)(U + (size_t)(first - j) * 512 + ch), t8);
#pragma unroll
              for (int q = 0; q < 8; ++q) sum[q] += t8[q]; }
#pragma unroll
          for (int i = 0; i < 16; ++i) { const int row = first + i, t = tb + i;
              unpk8(*(const GAS v4u*)(U + (size_t)row * 512 + ch), uc);
              const float inv = 1.0f / (float)((t + 1) < w ? (t + 1) : w);
#pragma unroll
              for (int q = 0; q < 8; ++q) { sum[q] += uc[q]; t8[q] = sum[q] * inv - uc[q]; }
              *(GAS v4u*)(Dp + (size_t)row * 512 + ch) = pk8(t8);
              if (t - w + 1 >= 0) { unpk8(*(const GAS v4u*)(U + (size_t)(row - w + 1) * 512 + ch), t8);
#pragma unroll
                  for (int q = 0; q < 8; ++q) sum[q] -= t8[q]; } } }
        { float z2[8], z1[8], z0[8], cb[8], y[8];
#pragma unroll
          for (int q = 0; q < 8; ++q) { z2[q] = 0.f; z1[q] = 0.f; }
          if (tb >= 2) unpk8(*(const GAS v4u*)(Z + (size_t)(first - 2) * 512 + ch), z2);
          if (tb >= 1) unpk8(*(const GAS v4u*)(Z + (size_t)(first - 1) * 512 + ch), z1);
#pragma unroll
          for (int i = 0; i < 16; ++i) { const int row = first + i;
              unpk8(*(const GAS v4u*)(Z + (size_t)row * 512 + ch), z0); unpk8(*(const GAS v4u*)(CB + (size_t)row * 512 + ch), cb);
#pragma unroll
              for (int q = 0; q < 8; ++q) { y[q] = cb[q] * (w0[q] * z2[q] + w1[q] * z1[q] + w2[q] * z0[q]); z2[q] = z1[q]; z1[q] = z0[q]; }
              *(GAS v4u*)(YC + (size_t)row * 512 + ch) = pk8(y); } }
    }
}

__device__ __forceinline__ void final_norm_phase(const Args& a, int gw, int NGW, int lane) {
    float* out = a.out; const bf16* XB = (const bf16*)(a.ws + WS_XB); const float* ssq = (const float*)(a.ws + WS_SSQ + 4 * KiB512); const float* gn = a.in[15];
    f32x4 g4[2][2];
#pragma unroll
    for (int j = 0; j < 2; ++j) { g4[j][0] = *(const GAS f32x4*)(gn + 512 * j + 8 * lane); g4[j][1] = *(const GAS f32x4*)(gn + 512 * j + 8 * lane + 4); }
    for (int m = gw; m < MROWS; m += NGW) {
        const float rs = __builtin_amdgcn_rsqf(((ssq[m] + ssq[MROWS + m]) + (ssq[2 * MROWS + m] + ssq[3 * MROWS + m])) * (1.0f / 1024.0f) + 1e-6f);
#pragma unroll
        for (int j = 0; j < 2; ++j) { float v[8]; unpk8(*(const GAS v4u*)(XB + (size_t)m * 1024 + 512 * j + 8 * lane), v);
            GAS f32x4* o = (GAS f32x4*)(out + (size_t)m * 1024 + 512 * j + 8 * lane);
            o[0] = (f32x4){v[0], v[1], v[2], v[3]} * rs * g4[j][0]; o[1] = (f32x4){v[4], v[5], v[6], v[7]} * rs * g4[j][1]; }
    }
}

__global__ void __launch_bounds__(NWAVES * 64, 2) fwd_megakernel(Args a) {
    extern __shared__ __attribute__((aligned(16))) unsigned char lds[];
    cg::grid_group grid = cg::this_grid();
    if (a.ph_lo < 0) grid.sync();
    LAS unsigned char* ldsl = (LAS unsigned char*)lds;
    const int G = gridDim.x, bx = blockIdx.x, vcu = (G % 8 == 0) ? (bx % 8) * (G / 8) + bx / 8 : bx, NGW = G * NWAVES;
#define FRESH_IDS() int tid_ = threadIdx.x; asm volatile("" : "+v"(tid_)); const int tid = tid_, lane = tid & 63, wave = __builtin_amdgcn_readfirstlane(tid >> 6), gw = vcu * NWAVES + wave; LAS float* scr = (LAS float*)(ldsl + wave * 16384); (void)tid; (void)lane; (void)gw; (void)scr
    unsigned char* ws = a.ws;
    bf16* XB = (bf16*)(ws + WS_XB);
    if (threadIdx.x < 2) ((volatile LAS unsigned*)(ldsl + BARLDS_OFF))[threadIdx.x] = 0u;
    __syncthreads();
    const XcdBarrier bar = xcd_barrier_post((unsigned*)(ws + WS_BAR), (volatile LAS unsigned*)(ldsl + BARLDS_OFF));

#define IN(k) (a.ph_lo <= (k) && (k) < a.ph_hi)
#ifndef REP_PRO
#define REP_PRO 1
#endif
#ifndef REP_IN
#define REP_IN 1
#endif
#ifndef REP_PC
#define REP_PC 1
#endif
#ifndef REP_MIX
#define REP_MIX 1
#endif
#ifndef REP_GU
#define REP_GU 1
#endif
#define BOTH(k) (IN(k) && IN((k) + 1))
#ifndef NO_PRO
    for (int rp_ = 0; rp_ < REP_PRO; ++rp_) if (IN(0)) { FRESH_IDS();
    convert_weights(a, scr, gw, NGW, lane, (G == 256) ? 1 : 0, 0);
    x_to_bf16(a, gw, NGW, lane); }
#endif
    if (BOTH(0)) GRID_SEAM();

#pragma unroll 1
    for (int l = 0; l < DEPTH; ++l) {
        unsigned char* wl = ws + WS_WL + (size_t)l * WL_STRIDE; const int p0 = 1 + 6 * l;
        const bf16* WIN = (l == 0) ? (const bf16*)(ws + WS_WIN) : (const bf16*)((unsigned char*)a.out + 64 * MiB);
        const float* ssq_in = (const float*)(ws + WS_SSQ + (size_t)(2 * l) * KiB512);
        float* ssq_mid = (float*)(ws + WS_SSQ + (size_t)(2 * l + 1) * KiB512);
        float* ssq_end = (float*)(ws + WS_SSQ + (size_t)(2 * l + 2) * KiB512);
#ifndef NO_IN
#ifndef STAG_IN
#define STAG_IN 0
#endif
        if (IN(p0) && STAG_IN > 0 && G == 256 && bx >= 128) { const unsigned long long t0_ = __builtin_amdgcn_s_memrealtime(), d_ = (unsigned long long)(1 + ((bx >> 3) % 3)) * STAG_IN; while (__builtin_amdgcn_s_memrealtime() - t0_ < d_) __builtin_amdgcn_s_sleep(32); }
        for (int rp_ = 0; rp_ < REP_IN; ++rp_) if (IN(p0)) { pg8::Gemm g{XB, XB, XB, WIN, WIN, WIN, MROWS, NIN, 1024}; pg8::StaticOrder S; S.init(MROWS, NIN, G, bx);
          pg8::EpiIn E{ssq_in, a.in[4] + (size_t)l * 3072, (bf16*)(ws + WS_QA), (bf16*)(ws + WS_G),
                       (float*)(ws + WS_FLOG), attn_body::C2};
          pg8::gemm_phase<pg8::EpiIn, pg8::StaticOrder, true, true>(ldsl, g, S, E);
          if (rp_ == REP_IN - 1 && G == 256 && bx >= 128) { FRESH_IDS(); convert_weights(a, scr, (bx - 128) * NWAVES + wave, 128 * NWAVES, lane, 2, l); } }
#endif
        if (BOTH(p0 + 0)) GRID_SEAM();
#ifndef NO_PRO
#endif
#ifndef NO_ATT
#ifndef REP_ATT
#define REP_ATT 1
#endif
        bf16* const YA = (bf16*)(ws + WS_QA);
#pragma unroll 1
        for (int st_ = 0; st_ < 2; ++st_) {
        const bool att_now = (st_ == ((vcu >> 1) & 1));
        if (att_now && IN(p0 + 1)) { const attn_body::AttnTensors AT{(const attn_body::bf16*)(ws + WS_QA), (const attn_body::bf16*)(ws + WS_K), (const attn_body::bf16*)(ws + WS_V), (attn_body::bf16*)YA,
                                          (const float*)(ws + WS_FLOG), a.in[3] + l * NHEADS};
          const attn_body::StaticOrder S(G, vcu);
          attn_body::attn_phase<attn_body::StaticOrder>((char*)lds, AT, S); }
#endif
#ifndef NO_PC
        for (int rp_ = 0; rp_ < REP_PC; ++rp_) if (!att_now && IN(p0 + 1)) { FRESH_IDS(); pool_conv_phase(a, l, vcu, G, tid); }
#endif
        }
        if (BOTH(p0 + 1)) GRID_SEAM();
#ifndef NO_MIX
        for (int rp_ = 0; rp_ < REP_MIX; ++rp_) if (IN(p0 + 2)) { pg8::Gemm g{(const bf16*)YA, (const bf16*)a.out, (const bf16*)a.out + (size_t)MROWS * 512, (const bf16*)(wl + WL_A), (const bf16*)(wl + WL_B), (const bf16*)(wl + WL_C), MROWS, 1024, 512};
          pg8::StaticOrder3 S; S.init(MROWS, 1024, G, bx);
          pg8::EpiMix E{(const bf16*)(ws + WS_G), (bf16*)(ws + WS_MIX), (bf16*)(ws + WS_U)};
          pg8::gemm_phase<pg8::EpiMix, pg8::StaticOrder3, true, true>(ldsl, g, S, E); }
#endif
        if (BOTH(p0 + 2)) GRID_SEAM();
#ifndef NO_OUT
#ifndef REP_OUT
#define REP_OUT 1
#endif
        if (IN(p0 + 3)) { const bf16* A = (const bf16*)(ws + WS_MIX); const bf16* B = (const bf16*)(wl + WL_OUT);
          pg8::Gemm g{A, A, A, B, B, B, MROWS, 1024, 1024}; pg8::StaticOrder S; S.init(MROWS, 1024, G, bx);
          pg8::EpiResid E{XB, ssq_mid};
          pg8::gemm_phase<pg8::EpiResid, pg8::StaticOrder, true, true>(ldsl, g, S, E); }
#endif
        if (BOTH(p0 + 3)) GRID_SEAM();
#ifndef NO_GU
        for (int rp_ = 0; rp_ < REP_GU; ++rp_) if (IN(p0 + 4)) { const bf16* B = (const bf16*)(wl + WL_GU);
          pg8::Gemm g{XB, XB, XB, B, B, B, MROWS, 2 * FFH, 1024}; pg8::StaticOrder S; S.init(MROWS, 2 * FFH, G, bx);
          pg8::EpiSwiglu E{ssq_mid, (bf16*)(ws + WS_ACT)};
          pg8::gemm_phase<pg8::EpiSwiglu, pg8::StaticOrder, true, true>(ldsl, g, S, E); }
#endif
        if (BOTH(p0 + 4)) GRID_SEAM();
#ifndef NO_DN
        if (IN(p0 + 5)) { const bf16* A = (const bf16*)(ws + WS_ACT); const bf16* B = (const bf16*)(wl + WL_DN);
          pg8::Gemm g{A, A, A, B, B, B, MROWS, 1024, FFH}; pg8::StaticOrder S; S.init(MROWS, 1024, G, bx);
          pg8::EpiResid E{XB, ssq_end};
          pg8::gemm_phase<pg8::EpiResid, pg8::StaticOrder, true, true>(ldsl, g, S, E); }
#endif
        if (BOTH(p0 + 5)) GRID_SEAM();
    }
    if (IN(13)) { FRESH_IDS(); final_norm_phase(a, gw, NGW, lane); }
}

__global__ void ws_too_small_fill(float* out, int n) { for (int i = blockIdx.x * blockDim.x + threadIdx.x; i < n; i += gridDim.x * blockDim.x) out[i] = 7777.f; }

extern "C" void kernel_launch(void* const* d_in, const int* in_sizes, int n_in, void* d_out, int out_size, void* d_ws, size_t ws_size, hipStream_t stream) {
    static int grid = 0;
    if (grid == 0) {
        int dev = 0, cus = 0, per_cu = 0;
        if (hipGetDevice(&dev) != hipSuccess || hipDeviceGetAttribute(&cus, hipDeviceAttributeMultiprocessorCount, dev) != hipSuccess) { fprintf(stderr, "kernel_launch: device query failed\n"); grid = -1; return; }
        if (hipFuncSetAttribute((const void*)fwd_megakernel, hipFuncAttributeMaxDynamicSharedMemorySize, LDS_BYTES) != hipSuccess) { fprintf(stderr, "kernel_launch: hipFuncSetAttribute failed\n"); grid = -1; return; }
        if (hipOccupancyMaxActiveBlocksPerMultiprocessor(&per_cu, (const void*)fwd_megakernel, NWAVES * 64, LDS_BYTES) != hipSuccess || per_cu < 1) per_cu = 1;
        (void)hipGetLastError();
        grid = cus;
    }
    if (grid < 0) return;
    if (n_in != 16 || out_size != MROWS * DMODEL || ws_size < WS_END) { ws_too_small_fill<<<256, 256, 0, stream>>>((float*)d_out, out_size); return; }
    Args a{};
    for (int i = 0; i < 16; ++i) a.in[i] = (const float*)d_in[i];
    a.out = (float*)d_out; a.ws = (unsigned char*)d_ws;
#ifndef MK_LAUNCHES
#define MK_LAUNCHES 1
#endif
#if MK_LAUNCHES == 1
    a.ph_lo = 0; a.ph_hi = 14;
    if (hipMemsetAsync((unsigned char*)d_ws + WS_BAR, 0, XCD_BAR_WORDS * 4, stream) != hipSuccess) { fprintf(stderr, "kernel_launch: memset of the barrier words failed\n"); return; }
    void* args[] = {&a};
    hipError_t e = hipLaunchCooperativeKernel((const void*)fwd_megakernel, dim3(grid), dim3(NWAVES * 64), args, LDS_BYTES, stream);
    if (e != hipSuccess) fprintf(stderr, "kernel_launch: cooperative launch failed: %s (grid %d)\n", hipGetErrorString(e), grid);
#else
    for (int p = 0; p < 14; ++p) { a.ph_lo = p; a.ph_hi = p + 1; hipLaunchKernelGGL(fwd_megakernel, dim3(grid), dim3(NWAVES * 64), LDS_BYTES, stream, a); }
#endif
}
```

```cpp
#define MK_LAUNCHES 1
#include <hip/hip_runtime.h>
#include <hip/hip_cooperative_groups.h>
#include <cstdio>
#include <cstdint>
namespace pg8 {
#define PG8_LAS __attribute__((address_space(3)))
typedef unsigned short bf16_t;
typedef short bf16x8 __attribute__((ext_vector_type(8)));
typedef float f32x4 __attribute__((ext_vector_type(4)));
typedef unsigned u32x4 __attribute__((ext_vector_type(4)));
constexpr int BM = 256, BK = 64, HALF = 128, HTB = HALF * BK * 2  , STAGE_BYTES = 8 * HTB, NXCD = 8, WGM = 4;

__host__ __device__ __forceinline__ int lds_byte(int r, int c) { const int st = (r >> 4) * 2 + (c >> 5), rr = r & 15, cc = c & 31, ob = rr * 64 + cc * 2; return st * 1024 + (ob ^ (((ob >> 9) & 1) << 5)); }
__host__ __device__ __forceinline__ void stage_rc(int b, int& R, int& C) { const int st = b / 1024, sb = b % 1024, swz = sb ^ (((sb >> 9) & 1) << 5); R = (st >> 1) * 16 + swz / 64; C = (st & 1) * 32 + (swz % 64) / 2; }
__host__ __device__ __forceinline__ int perm32(int rho) { const int n = rho >> 4, i = rho & 15; return 8 * (i >> 2) + 4 * n + (i & 3); }

struct Unit { int pm, pn, sub; };
struct Gemm { const bf16_t *A0, *A1, *A2, *B0, *B1, *B2; int M, N, K; };

struct StaticOrder {
    int nM, nN, nwg, G, c;
    __host__ __device__ void init(int M, int N, int G_, int c_) { nM = M / BM; nN = N / BM; nwg = nM * nN; G = G_; c = c_; }
    __host__ __device__ bool next(int i, Unit& u) const {
        const long L = (long)i * G + c; if (L >= nwg) return false;
        int wgid = (int)L; { const int q = nwg / NXCD, r = nwg % NXCD, xcd = wgid % NXCD, off = wgid / NXCD; wgid = (xcd < r ? xcd * (q + 1) : r * (q + 1) + (xcd - r) * q) + off; }
        const int nig = WGM * nN, gid = wgid / nig, fm = gid * WGM, gsz = (nM - fm) < WGM ? (nM - fm) : WGM;
        u.pm = fm + ((wgid % nig) % gsz); u.pn = (wgid % nig) / gsz; u.sub = 0; return true;
    }
    __device__ __forceinline__ void a_ready(const Unit&) const {}
    __device__ __forceinline__ void done(const Unit&) const {}
};

struct StaticOrder3 {
    StaticOrder b;
    __host__ __device__ void init(int M, int N, int G_, int c_) { b.init(M, N, G_, c_); }
    __host__ __device__ bool next(int i, Unit& u) const { if (!b.next(i / 3, u)) return false; u.sub = i % 3; return true; }
    __device__ __forceinline__ void a_ready(const Unit&) const {}
    __device__ __forceinline__ void done(const Unit&) const {}
};
typedef float f32x2c_t __attribute__((ext_vector_type(2))); typedef __bf16 bf16x2c_t __attribute__((ext_vector_type(2)));
__device__ __forceinline__ unsigned cvt_pk_bf16(float lo, float hi) { const f32x2c_t v = {lo, hi}; const bf16x2c_t b = __builtin_convertvector(v, bf16x2c_t); return __builtin_bit_cast(unsigned, b); }
typedef float f32x2 __attribute__((ext_vector_type(2)));
__device__ __forceinline__ float rstd_of(const float* ssq, int row) { const float s0 = ssq[row], s1 = ssq[32768 + row], s2 = ssq[2 * 32768 + row], s3 = ssq[3 * 32768 + row]; return __builtin_amdgcn_rsqf(((s0 + s1) + (s2 + s3)) * (1.0f / 1024.0f) + 1e-6f); }
__device__ __forceinline__ float sigm(float v) { return __builtin_amdgcn_rcpf(1.0f + __builtin_amdgcn_exp2f(-1.4426950408889634f * v)); }
__device__ __forceinline__ u32x4 pack8(const f32x4 a, const f32x4 b) { u32x4 w; w.x = cvt_pk_bf16(a[0], a[1]); w.y = cvt_pk_bf16(a[2], a[3]); w.z = cvt_pk_bf16(b[0], b[1]); w.w = cvt_pk_bf16(b[2], b[3]); return w; }
__device__ __forceinline__ void st16_nt(void* p, const u32x4 v) { __builtin_nontemporal_store(v, (u32x4*)p); }
__device__ __forceinline__ void unpack8(const u32x4 w, f32x4& a, f32x4& b) {
    a[0] = __uint_as_float(w.x << 16); a[1] = __uint_as_float(w.x & 0xffff0000u); a[2] = __uint_as_float(w.y << 16); a[3] = __uint_as_float(w.y & 0xffff0000u);
    b[0] = __uint_as_float(w.z << 16); b[1] = __uint_as_float(w.z & 0xffff0000u); b[2] = __uint_as_float(w.w << 16); b[3] = __uint_as_float(w.w & 0xffff0000u); }

constexpr int AUX_OFF = 131072 + 1024, AUX_BYTES = 4096 + 1024;
__device__ __forceinline__ void pre_rows(PG8_LAS unsigned char* lds, const float* ssq, int pm, int par, int wid, int lane) {
#pragma unroll
    for (int i = 0; i < 2; ++i) { const int q = wid * 2 + i, slot = q >> 2, r0 = (q & 3) * 64;
        __builtin_amdgcn_global_load_lds((const unsigned*)(ssq + (size_t)slot * 32768 + pm * BM + r0 + lane), (PG8_LAS unsigned*)(lds + AUX_OFF + par * AUX_BYTES + (slot * 256 + r0) * 4), 4, 0, 0); }
}
__device__ __forceinline__ float rstd_lds(const PG8_LAS float* aux, int rl) { return __builtin_amdgcn_rsqf(((aux[rl] + aux[256 + rl]) + (aux[512 + rl] + aux[768 + rl])) * (1.0f / 1024.0f) + 1e-6f); }

struct EpiIn {
    static constexpr bool PERM = true, AFTER_DRAIN = false, PRE = true, SPLIT = false;
    const float* ssq; const float* bgate; bf16_t *Q, *G; float* FLOG; float qscale;
    __device__ __forceinline__ void pre(PG8_LAS unsigned char* lds, const Unit& u, int par, int wid, int lane) const {
        pre_rows(lds, ssq, u.pm, par, wid, lane);
        if (u.pn >= 14 && u.pn < 26 && wid < 4)
            __builtin_amdgcn_global_load_lds((const unsigned*)(bgate + (u.pn - 14) * 256 + wid * 64 + lane), (PG8_LAS unsigned*)(lds + AUX_OFF + par * AUX_BYTES + 4096 + wid * 256), 4, 0, 0);
    }
    template <int AI> __device__ __forceinline__ void part(const f32x4 (&acc)[2][2][4][2], const Unit& u, int wr, int wc, int fr, int fq, PG8_LAS unsigned char* lds, int par) const {
        const PG8_LAS float* aux = (const PG8_LAS float*)(lds + AUX_OFF + par * AUX_BYTES);
        const int rl0 = wr * 64 + fr + AI * HALF, row0 = u.pm * BM + rl0, pn = u.pn, cw = wc * 32 + 8 * fq;
        if (pn < 8 || pn == 12 || pn == 13) {
            const int blk = pn < 8 ? (pn >> 1) : 5, colt = (pn & 1) * 256; const float sc = pn < 2 ? qscale : 1.f;
            bf16_t* base = Q + (size_t)blk * ((size_t)32768 * 512);
#pragma unroll
            for (int m = 0; m < 4; ++m) { const int row = row0 + m * 16; const float rs = rstd_lds(aux, rl0 + m * 16) * sc; bf16_t* rowp = base + (size_t)row * 512 + colt + cw;
#pragma unroll
                for (int bj = 0; bj < 2; ++bj) st16_nt(rowp + bj * HALF, pack8(acc[AI][bj][m][0] * rs, acc[AI][bj][m][1] * rs)); }
        } else if (pn < 12) {
            const int colz = (pn - 8) * 128 + cw;
#pragma unroll
            for (int m = 0; m < 4; ++m) { const int row = row0 + m * 16; const float rs = rstd_lds(aux, rl0 + m * 16), rs2 = rs * rs;
                st16_nt(Q + (size_t)4 * ((size_t)32768 * 512) + (size_t)row * 512 + colz, pack8(acc[AI][0][m][0] * acc[AI][1][m][0] * rs2, acc[AI][0][m][1] * acc[AI][1][m][1] * rs2)); }
        } else if (pn < 26) {
            const int colg = (pn - 14) * 256 + cw;
            f32x4 bv[2][2];
#pragma unroll
            for (int bj = 0; bj < 2; ++bj)
#pragma unroll
                for (int n = 0; n < 2; ++n) bv[bj][n] = *(const PG8_LAS f32x4*)(aux + 1024 + cw + bj * HALF + 4 * n);
#pragma unroll
            for (int m = 0; m < 4; ++m) { const int row = row0 + m * 16; const float rs = rstd_lds(aux, rl0 + m * 16); bf16_t* rowp = G + (size_t)row * 3072 + colg;
#pragma unroll
                for (int bj = 0; bj < 2; ++bj) { f32x4 v0 = acc[AI][bj][m][0] * rs + bv[bj][0], v1 = acc[AI][bj][m][1] * rs + bv[bj][1];
#pragma unroll
                    for (int i = 0; i < 4; ++i) { v0[i] = sigm(v0[i]); v1[i] = sigm(v1[i]); }
                    st16_nt(rowp + bj * HALF, pack8(v0, v1)); } }
        } else {
            if (wc == 0 && fq == 0) {
#pragma unroll
                for (int m = 0; m < 4; ++m) { const int row = row0 + m * 16; const float rs = rstd_lds(aux, rl0 + m * 16);
                    *(f32x4*)(FLOG + (size_t)row * 8) = acc[AI][0][m][0] * rs; *(f32x4*)(FLOG + (size_t)row * 8 + 4) = acc[AI][0][m][1] * rs; }
            }
        }
    }
};

struct EpiResid {
    static constexpr bool PERM = true, AFTER_DRAIN = false, PRE = false, SPLIT = false;
    bf16_t* xb; float* ssq;
    __device__ __forceinline__ void operator()(const f32x4 (&acc)[2][2][4][2], const Unit& u, int wr, int wc, int fr, int fq) const {
        const int row0 = u.pm * BM + wr * 64 + fr, col0 = u.pn * BM + wc * 32 + 8 * fq;
#pragma unroll
        for (int ai = 0; ai < 2; ++ai)
#pragma unroll
            for (int m = 0; m < 4; ++m) { const int row = row0 + ai * HALF + m * 16; bf16_t* p = xb + (size_t)row * 1024 + col0; float ss = 0.f;
#pragma unroll
                for (int bj = 0; bj < 2; ++bj) { f32x4 a, b; unpack8(*(const u32x4*)(p + bj * HALF), a, b);
                    a = a + acc[ai][bj][m][0]; b = b + acc[ai][bj][m][1];
                    ss += ((a[0] * a[0] + a[1] * a[1]) + (a[2] * a[2] + a[3] * a[3])) + ((b[0] * b[0] + b[1] * b[1]) + (b[2] * b[2] + b[3] * b[3]));
                    *(u32x4*)(p + bj * HALF) = pack8(a, b); }
                ss += __shfl_xor(ss, 16); ss += __shfl_xor(ss, 32);
                if (fq == 0) atomicAdd(ssq + (size_t)u.pn * 32768 + row, ss); }
    }
};

__device__ __forceinline__ u32x4 ld16_sc1(const bf16_t* p) {
    const unsigned long long* q = (const unsigned long long*)p;
    const unsigned long long lo = __hip_atomic_load(q, __ATOMIC_RELAXED, __HIP_MEMORY_SCOPE_AGENT), hi = __hip_atomic_load(q + 1, __ATOMIC_RELAXED, __HIP_MEMORY_SCOPE_AGENT);
    u32x4 w; w.x = (unsigned)lo; w.y = (unsigned)(lo >> 32); w.z = (unsigned)hi; w.w = (unsigned)(hi >> 32); return w; }
struct EpiMix {
    static constexpr bool PERM = true, AFTER_DRAIN = false, PRE = false, SPLIT = false;
    const bf16_t* G; bf16_t* MIX; bf16_t* P1;
    __device__ __forceinline__ void operator()(const f32x4 (&acc)[2][2][4][2], const Unit& u, int wr, int wc, int fr, int fq) const {
        const int row0 = u.pm * BM + wr * 64 + fr, col0 = u.pn * BM + wc * 32 + 8 * fq, sub = u.sub;
#pragma unroll
        for (int ai = 0; ai < 2; ++ai)
#pragma unroll
            for (int m = 0; m < 4; ++m) { const int row = row0 + ai * HALF + m * 16;
#pragma unroll
                for (int bj = 0; bj < 2; ++bj) { const int c = col0 + bj * HALF; f32x4 g0, g1; unpack8(*(const u32x4*)(G + (size_t)row * 3072 + sub * 1024 + c), g0, g1);
                    f32x4 v0 = acc[ai][bj][m][0] * g0, v1 = acc[ai][bj][m][1] * g1; const size_t off = (size_t)row * 1024 + c;
                    if (sub == 2) { f32x4 p0, p1; unpack8(*(const u32x4*)(MIX + off), p0, p1); v0 = v0 + p0; v1 = v1 + p1; unpack8(*(const u32x4*)(P1 + off), p0, p1); v0 = v0 + p0; v1 = v1 + p1; }
                    *(u32x4*)((sub == 1 ? P1 : MIX) + off) = pack8(v0, v1); } }
    }
};

struct EpiSwiglu {
    static constexpr bool PERM = true, AFTER_DRAIN = false, PRE = true, SPLIT = true;
    const float* ssq; bf16_t* ACT;
    __device__ __forceinline__ void pre(PG8_LAS unsigned char* lds, const Unit& u, int par, int wid, int lane) const { pre_rows(lds, ssq, u.pm, par, wid, lane); }
    template <int AI> __device__ __forceinline__ void part(const f32x4 (&acc)[2][2][4][2], const Unit& u, int wr, int wc, int fr, int fq, PG8_LAS unsigned char* lds, int par) const {
        const PG8_LAS float* aux = (const PG8_LAS float*)(lds + AUX_OFF + par * AUX_BYTES);
        const int rl0 = wr * 64 + fr + AI * HALF, row0 = u.pm * BM + rl0, colh = u.pn * 128 + wc * 32 + 8 * fq;
#pragma unroll
        for (int m = 0; m < 4; ++m) { const int row = row0 + m * 16; const float rs = rstd_lds(aux, rl0 + m * 16);
            f32x4 h[2];
#pragma unroll
            for (int n = 0; n < 2; ++n) { const f32x4 a = acc[AI][0][m][n] * rs, b = acc[AI][1][m][n] * rs;
#pragma unroll
                for (int i = 0; i < 4; ++i) h[n][i] = a[i] * sigm(a[i]) * b[i]; }
            st16_nt(ACT + (size_t)row * 2816 + colh, pack8(h[0], h[1])); }
    }
};

template <class Epi, class Sched, bool ALIGN_EPI = false, bool SP2 = false>
__device__ __forceinline__ void gemm_phase(PG8_LAS unsigned char* lds, const Gemm g, const Sched& S, const Epi& E) {
    int tid_ = threadIdx.x; asm volatile("" : "+v"(tid_));
    const int tid = tid_, wid = __builtin_amdgcn_readfirstlane(tid >> 6), lane = tid & 63, wr = wid >> 2, wc = wid & 3, fr = lane & 15, fq = lane >> 4;
    const int K = g.K, nt = K / BK;
    unsigned voffA[2], voffB[2];
#pragma unroll
    for (int i = 0; i < 2; ++i) { int R, C; stage_rc(tid * 16 + i * 8192, R, C); const int Rb = Epi::PERM ? ((R & ~31) + perm32(R & 31)) : R;
        voffA[i] = (unsigned)(R * K + C) * 2u; voffB[i] = (unsigned)(Rb * K + C) * 2u; }
    const size_t kstep = (size_t)(BK * 2);
    const size_t hstep = (size_t)HALF * K * 2;
    const size_t tstep = 2 * hstep;
    const unsigned ldsw = (unsigned)wid * 1024u;
    const int aoff = lds_byte(wr * 64 + fr, fq * 8), boff = lds_byte(wc * 32 + fr, fq * 8);
#define PG8_SELA(s) ((const char*)((s) == 0 ? g.A0 : ((s) == 1 ? g.A1 : g.A2)))
#define PG8_SELB(s) ((const char*)((s) == 0 ? g.B0 : ((s) == 1 ? g.B1 : g.B2)))
#define PG8_SA(b, h) (((b) * 2 + (h)) * HTB)
#define PG8_SB(b, h) ((4 + (b) * 2 + (h)) * HTB)
#define PG8_STAGE(bufoff, gbase, voff) do { _Pragma("unroll") for (int _i = 0; _i < 2; ++_i) \
        __builtin_amdgcn_global_load_lds((const unsigned*)((const char*)(gbase) + (voff)[_i]), (PG8_LAS unsigned*)(lds + (bufoff) + ldsw + _i * 8192), 16, 0, 0); } while (0)
#define PG8_LDA(dst, b, h) do { _Pragma("unroll") for (int m = 0; m < 4; ++m) _Pragma("unroll") for (int k = 0; k < 2; ++k) dst[m][k] = *(const PG8_LAS bf16x8*)(lds + PG8_SA(b, h) + aoff + m * 2048 + k * 1024); } while (0)
#define PG8_LDB(dst, b, h) do { _Pragma("unroll") for (int n = 0; n < 2; ++n) _Pragma("unroll") for (int k = 0; k < 2; ++k) dst[n][k] = *(const PG8_LAS bf16x8*)(lds + PG8_SB(b, h) + boff + n * 2048 + k * 1024); } while (0)
#define PG8_MMA(ai, bj, At, Bt) do { __builtin_amdgcn_s_setprio(1); _Pragma("unroll") for (int m = 0; m < 4; ++m) _Pragma("unroll") for (int n = 0; n < 2; ++n) _Pragma("unroll") for (int k = 0; k < 2; ++k) \
        acc[ai][bj][m][n] = __builtin_amdgcn_mfma_f32_16x16x32_bf16(Bt[n][k], At[m][k], acc[ai][bj][m][n], 0, 0, 0); __builtin_amdgcn_s_setprio(0); } while (0)
#define PG8_WAIT_V(n) asm volatile("s_waitcnt vmcnt(" #n ")" ::: "memory")
#define PG8_WAIT_L(n) asm volatile("s_waitcnt lgkmcnt(" #n ")" ::: "memory")
#define PG8_BAR __builtin_amdgcn_s_barrier()
#define PG8_SCHED __builtin_amdgcn_sched_barrier(0)
    Unit cur, nxt; int ui = 0;
    if (!S.next(0, cur)) return;
    f32x4 acc[2][2][4][2];
#pragma unroll
    for (int a = 0; a < 2; ++a)
#pragma unroll
        for (int b = 0; b < 2; ++b)
#pragma unroll
            for (int m = 0; m < 4; ++m)
#pragma unroll
                for (int n = 0; n < 2; ++n) acc[a][b][m][n] = (f32x4){0.f, 0.f, 0.f, 0.f};
    bf16x8 At[4][2], B0[2][2], B1[2][2];
    const char* cA = PG8_SELA(cur.sub) + (size_t)cur.pm * tstep; const char* cB = PG8_SELB(cur.sub) + (size_t)cur.pn * tstep;
    S.a_ready(cur);
    if constexpr (Epi::PRE) E.pre(lds, cur, 0, wid, lane);
    if constexpr (SP2) {
        PG8_STAGE(PG8_SB(0, 0), cB, voffB); PG8_STAGE(PG8_SB(0, 1), cB + hstep, voffB); PG8_STAGE(PG8_SA(0, 0), cA, voffA); PG8_STAGE(PG8_SA(0, 1), cA + hstep, voffA);
        if (wr == 1) PG8_BAR;
        PG8_WAIT_V(2); PG8_BAR;
        PG8_STAGE(PG8_SB(1, 0), cB + kstep, voffB); PG8_STAGE(PG8_SA(1, 0), cA + kstep, voffA); PG8_STAGE(PG8_SB(1, 1), cB + hstep + kstep, voffB);
        PG8_WAIT_V(6); PG8_BAR;
    } else {
        PG8_STAGE(PG8_SB(0, 0), cB, voffB); PG8_STAGE(PG8_SA(0, 0), cA, voffA); PG8_STAGE(PG8_SB(0, 1), cB + hstep, voffB); PG8_STAGE(PG8_SA(0, 1), cA + hstep, voffA);
        if (wr == 1) PG8_BAR;
        PG8_WAIT_V(4); PG8_BAR;
        PG8_STAGE(PG8_SB(1, 0), cB + kstep, voffB); PG8_STAGE(PG8_SA(1, 0), cA + kstep, voffA); PG8_STAGE(PG8_SB(1, 1), cB + hstep + kstep, voffB);
        PG8_WAIT_V(6); PG8_BAR;
    }
    for (;;) {
        const bool has_next = S.next(ui + 1, nxt);
        const char* nA = has_next ? PG8_SELA(nxt.sub) + (size_t)nxt.pm * tstep : cA; const char* nB = has_next ? PG8_SELB(nxt.sub) + (size_t)nxt.pn * tstep : cB;
        for (int t = 0; t < nt; t += 2) {
            const bool last = (t == nt - 2);
            const char* a1 = cA + (size_t)(t + 1) * kstep;
            const char* a2 = last ? nA : cA + (size_t)(t + 2) * kstep; const char* b2 = last ? nB : cB + (size_t)(t + 2) * kstep;
            const char* a3 = a2 + kstep; const char* b3 = b2 + kstep;
            if (last && has_next) { S.a_ready(nxt); if constexpr (Epi::PRE) E.pre(lds, nxt, (ui + 1) & 1, wid, lane); }
            if constexpr (SP2) {
            PG8_LDB(B0, 0, 0); PG8_LDB(B1, 0, 1); PG8_SCHED; PG8_LDA(At, 0, 0); PG8_STAGE(PG8_SA(1, 1), a1 + hstep, voffA);
            PG8_WAIT_V(8); PG8_WAIT_L(0); PG8_BAR; PG8_MMA(0, 0, At, B0); PG8_MMA(0, 1, At, B1); PG8_BAR; PG8_SCHED;
            PG8_LDA(At, 0, 1); PG8_STAGE(PG8_SB(0, 0), b2, voffB); PG8_STAGE(PG8_SB(0, 1), b2 + hstep, voffB); PG8_STAGE(PG8_SA(0, 0), a2, voffA);
            PG8_WAIT_V(8); PG8_WAIT_L(0); PG8_BAR; PG8_MMA(1, 0, At, B0); PG8_MMA(1, 1, At, B1); PG8_BAR; PG8_SCHED;
            PG8_LDB(B0, 1, 0); PG8_LDB(B1, 1, 1); PG8_SCHED; PG8_LDA(At, 1, 0); PG8_STAGE(PG8_SA(0, 1), a2 + hstep, voffA);
            PG8_WAIT_V(8); PG8_WAIT_L(0); PG8_BAR; PG8_MMA(0, 0, At, B0); PG8_MMA(0, 1, At, B1); PG8_BAR; PG8_SCHED;
            PG8_LDA(At, 1, 1); PG8_STAGE(PG8_SB(1, 0), b3, voffB); PG8_STAGE(PG8_SB(1, 1), b3 + hstep, voffB); PG8_STAGE(PG8_SA(1, 0), a3, voffA);
            PG8_WAIT_V(8); PG8_WAIT_L(0); PG8_BAR; PG8_MMA(1, 0, At, B0); PG8_MMA(1, 1, At, B1);
            if constexpr (Epi::SPLIT) { if (last) { PG8_SCHED; E.template part<0>(acc, cur, wr, wc, fr, fq, lds, ui & 1); } }
            PG8_BAR; PG8_SCHED;
            } else {
            PG8_LDB(B0, 0, 0); PG8_SCHED; PG8_LDA(At, 0, 0); PG8_STAGE(PG8_SA(1, 1), a1 + hstep, voffA);
            PG8_WAIT_L(8); PG8_BAR; PG8_WAIT_L(0); PG8_MMA(0, 0, At, B0); PG8_BAR; PG8_SCHED;
            PG8_LDB(B1, 0, 1); PG8_STAGE(PG8_SB(0, 0), b2, voffB);
            PG8_BAR; PG8_WAIT_L(0); PG8_MMA(0, 1, At, B1); PG8_BAR;
            PG8_LDA(At, 0, 1); PG8_STAGE(PG8_SA(0, 0), a2, voffA);
            PG8_BAR; PG8_WAIT_L(0); PG8_MMA(1, 0, At, B0); PG8_BAR; PG8_SCHED;
            PG8_STAGE(PG8_SB(0, 1), b2 + hstep, voffB);
            PG8_WAIT_V(6); PG8_BAR; PG8_MMA(1, 1, At, B1); PG8_BAR;
            PG8_LDB(B0, 1, 0); PG8_SCHED; PG8_LDA(At, 1, 0); PG8_STAGE(PG8_SA(0, 1), a2 + hstep, voffA);
            PG8_WAIT_L(8); PG8_BAR; PG8_WAIT_L(0); PG8_MMA(0, 0, At, B0); PG8_BAR; PG8_SCHED;
            PG8_LDB(B1, 1, 1); PG8_STAGE(PG8_SB(1, 0), b3, voffB);
            PG8_BAR; PG8_WAIT_L(0); PG8_MMA(0, 1, At, B1); PG8_BAR;
            PG8_LDA(At, 1, 1); PG8_STAGE(PG8_SA(1, 0), a3, voffA);
            PG8_BAR; PG8_WAIT_L(0); PG8_MMA(1, 0, At, B0); PG8_BAR; PG8_SCHED;
            PG8_STAGE(PG8_SB(1, 1), b3 + hstep, voffB);
            PG8_WAIT_V(6); PG8_BAR; PG8_MMA(1, 1, At, B1); PG8_BAR;
            }
        }
        if constexpr (ALIGN_EPI) { if (wr == 0) PG8_BAR; }
        if constexpr (Epi::SPLIT) { E.template part<1>(acc, cur, wr, wc, fr, fq, lds, ui & 1); S.done(cur); }
        else if constexpr (Epi::PRE) { E.template part<0>(acc, cur, wr, wc, fr, fq, lds, ui & 1); E.template part<1>(acc, cur, wr, wc, fr, fq, lds, ui & 1); S.done(cur); }
        else if constexpr (!Epi::AFTER_DRAIN) { E(acc, cur, wr, wc, fr, fq); S.done(cur); }
        if (!has_next) break;
#pragma unroll
        for (int a = 0; a < 2; ++a)
#pragma unroll
            for (int b = 0; b < 2; ++b)
#pragma unroll
                for (int m = 0; m < 4; ++m)
#pragma unroll
                    for (int n = 0; n < 2; ++n) acc[a][b][m][n] = (f32x4){0.f, 0.f, 0.f, 0.f};
        cur = nxt; cA = nA; cB = nB; ++ui;
        if constexpr (ALIGN_EPI) { if (wr == 1) PG8_BAR; }
    }
    PG8_WAIT_V(0);
    if constexpr (!ALIGN_EPI) { if (wr == 0) PG8_BAR; }
    PG8_BAR;
    if constexpr (Epi::AFTER_DRAIN) { E.fused(acc, cur, wr, wc, fr, fq, lds, wid, lane); S.done(cur); }
#undef PG8_SA
#undef PG8_SELA
#undef PG8_SELB
#undef PG8_SB
#undef PG8_STAGE
#undef PG8_LDA
#undef PG8_LDB
#undef PG8_MMA
#undef PG8_WAIT_V
#undef PG8_WAIT_L
#undef PG8_BAR
#undef PG8_SCHED
}
}

#include <hip/hip_bf16.h>
#include <cmath>
namespace attn_body {
using bf16=__hip_bfloat16;
using bf16x8=__attribute__((ext_vector_type(8)))short;
using s16x4=__attribute__((ext_vector_type(4)))short;
using f32x16=__attribute__((ext_vector_type(16)))float;
using u32x4=__attribute__((ext_vector_type(4)))unsigned;
constexpr int BATCH=16,NHEAD=8,SEQ=2048,D=64,DM=NHEAD*D;
constexpr int NW=8,QBLK=32,QB=QBLK*NW,KVBLK=64,NQB=SEQ/QB;
constexpr int ATTN_PITCH=DM, ATTN_UNIT_ROWS=QB;
__device__ __forceinline__ int crow(int r,int hi){return (r&3)+8*(r>>2)+4*hi;}
#define SBAR() __builtin_amdgcn_sched_barrier(0)
__device__ __forceinline__ void cmask(f32x16&p0,f32x16&p1,int jb,int qrel,int hi){
  const float NEG=-INFINITY; int kb=64*jb+4*hi;
  #pragma unroll
  for(int r=0;r<16;++r){int kv=kb+(r&3)+8*(r>>2); if(kv>qrel)p0[r]=NEG; if(kv+32>qrel)p1[r]=NEG;}
}

constexpr int NSLOT=3, SLOTB=8192;
constexpr int LDS_K=0, LDS_V=NSLOT*SLOTB, LDS_WS=2*NSLOT*SLOTB, LDS_OST=LDS_WS+NW*64*4, LDS_F=LDS_OST+NW*4096, LDS_FW=LDS_F+SEQ*4, LDS_BYTES=LDS_FW+64;
constexpr float C2=0.125f*1.4426950408889634f;
__device__ __forceinline__ void glds16(const void*gsrc,unsigned lds_dst){unsigned keep;
  asm volatile("s_mov_b32 %0, m0\n\ts_mov_b32 m0, %2\n\ts_nop 0\n\tglobal_load_lds_dwordx4 %1, off\n\ts_mov_b32 m0, %0":"=&s"(keep):"v"(gsrc),"s"(lds_dst):"memory");}
__device__ __forceinline__ float max3f(float a,float b,float c){float r;asm("v_max3_f32 %0, %1, %2, %3":"=v"(r):"v"(a),"v"(b),"v"(c));return r;}
__device__ __forceinline__ float max2f(float a,float b){float r;asm("v_max_f32_e32 %0, %1, %2":"=v"(r):"v"(a),"v"(b));return r;}
__device__ __forceinline__ float fadd_s(float a,float b){float r;asm("v_add_f32_e32 %0, %1, %2":"=v"(r):"v"(a),"v"(b));return r;}
__device__ __forceinline__ float fsub_s(float a,float b){float r;asm("v_sub_f32_e32 %0, %1, %2":"=v"(r):"v"(a),"v"(b));return r;}
typedef float f32x2_t __attribute__((ext_vector_type(2))); typedef __bf16 bf16x2_t __attribute__((ext_vector_type(2)));
__device__ __forceinline__ unsigned cvtpk_s(float lo,float hi){f32x2_t v={lo,hi};bf16x2_t b=__builtin_convertvector(v,bf16x2_t);return __builtin_bit_cast(unsigned,b);}
#define WAIT_BAR(N) asm volatile("s_waitcnt vmcnt(" #N ") lgkmcnt(0)\n\ts_barrier":::"memory")

__device__ __forceinline__ void qkt(f32x16&p0,f32x16&p1,const char*Kslot,const bf16x8*qr,const f32x16&negm,int r32,int hi){
  const char*kb=Kslot+hi*1024+r32*16;
  #pragma unroll
  for(int d0=0;d0<4;++d0){
    const bf16x8 b0=*reinterpret_cast<const bf16x8*>(kb+d0*2048);
    const bf16x8 b1=*reinterpret_cast<const bf16x8*>(kb+d0*2048+512);
    if(d0==0){p0=__builtin_amdgcn_mfma_f32_32x32x16_bf16(b0,qr[0],negm,0,0,0);p1=__builtin_amdgcn_mfma_f32_32x32x16_bf16(b1,qr[0],negm,0,0,0);}
    else{p0=__builtin_amdgcn_mfma_f32_32x32x16_bf16(b0,qr[d0],p0,0,0,0);p1=__builtin_amdgcn_mfma_f32_32x32x16_bf16(b1,qr[d0],p1,0,0,0);}}
}
typedef __attribute__((address_space(3))) const char* lds_cptr;
typedef short v4i16_t __attribute__((ext_vector_type(4)));
__device__ __forceinline__ void kload8(bf16x8*kf,lds_cptr kp){
  kf[0]=*(const __attribute__((address_space(3))) bf16x8*)(kp);      kf[1]=*(const __attribute__((address_space(3))) bf16x8*)(kp+512);
  kf[2]=*(const __attribute__((address_space(3))) bf16x8*)(kp+2048); kf[3]=*(const __attribute__((address_space(3))) bf16x8*)(kp+2560);
  kf[4]=*(const __attribute__((address_space(3))) bf16x8*)(kp+4096); kf[5]=*(const __attribute__((address_space(3))) bf16x8*)(kp+4608);
  kf[6]=*(const __attribute__((address_space(3))) bf16x8*)(kp+6144); kf[7]=*(const __attribute__((address_space(3))) bf16x8*)(kp+6656);
}
__device__ __forceinline__ void kload2(bf16x8*kf,lds_cptr kp,int j){ kf[2*j]=*(const __attribute__((address_space(3))) bf16x8*)(kp+j*2048); kf[2*j+1]=*(const __attribute__((address_space(3))) bf16x8*)(kp+j*2048+512); }
__device__ __forceinline__ s16x4 vtr(lds_cptr p){ return __builtin_bit_cast(s16x4,__builtin_amdgcn_ds_read_tr16_b64_v4i16((__attribute__((address_space(3))) v4i16_t*)p)); }
__device__ __forceinline__ float rowmax(const f32x16&p0,const f32x16&p1){
  float a=max3f(p0[0],p0[1],p1[0]),b=max3f(p0[2],p0[3],p1[1]);a=max3f(a,p1[2],p1[3]);
  #pragma unroll
  for(int r=4;r<16;r+=4){a=max3f(a,p0[r],p0[r+1]);b=max3f(b,p0[r+2],p0[r+3]);a=max3f(a,p1[r],p1[r+1]);b=max3f(b,p1[r+2],p1[r+3]);}
  const float m=max2f(a,b);
  auto rr=__builtin_amdgcn_permlane32_swap(__float_as_uint(m),__float_as_uint(m),false,false);
  return max2f(__uint_as_float(rr[0]),__uint_as_float(rr[1]));
}
__device__ __forceinline__ void pv(f32x16*o,int vb,bf16x8 pa0,bf16x8 pa1,bf16x8 pa2,bf16x8 pa3){
  #pragma unroll
  for(int d0=0;d0<2;++d0){s16x4 lo[4],hi[4];
    #pragma unroll
    for(int ks=0;ks<4;++ks){
      asm volatile("ds_read_b64_tr_b16 %0,%1 offset:%c2":"=&v"(lo[ks]):"v"(vb),"i"(d0*4096+ks*1024):"memory");
      asm volatile("ds_read_b64_tr_b16 %0,%1 offset:%c2":"=&v"(hi[ks]):"v"(vb),"i"(d0*4096+ks*1024+512):"memory");}
    asm volatile("s_waitcnt lgkmcnt(0)":::"memory");SBAR();
    #define PK(k) (bf16x8){lo[k][0],lo[k][1],lo[k][2],lo[k][3],hi[k][0],hi[k][1],hi[k][2],hi[k][3]}
    o[d0]=__builtin_amdgcn_mfma_f32_32x32x16_bf16(pa0,PK(0),o[d0],0,0,0);
    o[d0]=__builtin_amdgcn_mfma_f32_32x32x16_bf16(pa1,PK(1),o[d0],0,0,0);
    o[d0]=__builtin_amdgcn_mfma_f32_32x32x16_bf16(pa2,PK(2),o[d0],0,0,0);
    o[d0]=__builtin_amdgcn_mfma_f32_32x32x16_bf16(pa3,PK(3),o[d0],0,0,0);
    #undef PK
  }
}

#ifndef ATTN_STORE16
#define ATTN_STORE16(p,v) (*(u32x4*)(p)=(v))
#endif
typedef float f32x4v __attribute__((ext_vector_type(4)));
__device__ __forceinline__ float logsig(float x){ return fminf(x,0.f)-__logf(1.f+__expf(-fabsf(x))); }
template<int THRL> __device__ __forceinline__ void attn_unit(int b,int h,int qb,const bf16*Q,const bf16*__restrict__ K,const bf16*__restrict__ V,bf16*O,char*shm,const float*__restrict__ flog,float bfh,bool newbh){
  int tid_=threadIdx.x; asm volatile("":"+v"(tid_)); const int tid=tid_,lane=tid&63,r32=lane&31,hi=lane>>5; const int wid=__builtin_amdgcn_readfirstlane(tid>>6);
  const long rowbase=(long)b*SEQ; const int q0=qb*QB;
  const bf16*Qw=Q+(rowbase+q0+wid*QBLK)*DM+h*D;
  const bf16*Kh=K+rowbase*DM+h*D,*Vh=V+rowbase*DM+h*D;
  const unsigned lds0=(unsigned)(uintptr_t)shm;
  float*wsf=(float*)(shm+LDS_WS)+wid*64;
  const bf16*ksrc=Kh+(long)lane*DM+wid*8;
  const bf16*vsrc=Vh+(long)(16*(wid&3)+(lane>>2))*DM+(wid>>2)*32+(lane&3)*8;
  const unsigned kdst=lds0+LDS_K+wid*1024, vdst=lds0+LDS_V+wid*1024;
  #define DMA_K(t,slot) glds16(ksrc+(long)(t)*KVBLK*DM,(unsigned)__builtin_amdgcn_readfirstlane(kdst+(slot)))
  #define DMA_V(t,slot) glds16(vsrc+(long)(t)*KVBLK*DM,(unsigned)__builtin_amdgcn_readfirstlane(vdst+(slot)))
  const int vb0=(int)(lds0+LDS_V)+((lane>>4)&1)*32+(lane&3)*8+(4*hi+((lane&15)>>2))*64;
  const char*Kbase=shm+LDS_K; bf16x8 kf[8];
  const lds_cptr shm3=(lds_cptr)shm; const lds_cptr kp0=shm3+LDS_K+hi*1024+r32*16; const lds_cptr vp0=shm3+LDS_V+((lane>>4)&1)*32+(lane&3)*8+(4*hi+((lane&15)>>2))*64;
  const int NT=(q0+QB)/KVBLK;
  typedef __attribute__((address_space(3))) float* lds_fptr;
  const lds_fptr fs3=(lds_fptr)(shm3+LDS_F); const lds_fptr fw3=(lds_fptr)(shm3+LDS_FW);
  if(newbh){ float v0=0.f,v1=0.f,v2=0.f,v3=0.f; const int t0=4*tid;
    { const float*fp=flog+(rowbase+t0)*NHEAD+h; v0=logsig(fp[0]+bfh); v1=logsig(fp[NHEAD]+bfh); v2=logsig(fp[2*NHEAD]+bfh); v3=logsig(fp[3*NHEAD]+bfh); }
    v1+=v0; v2+=v1; v3+=v2; float inc=v3;
    #pragma unroll
    for(int o=1;o<64;o<<=1){ const float nb=__shfl_up(inc,o); if(lane>=o)inc+=nb; }
    if(lane==63)fw3[wid]=inc;
    asm volatile("s_waitcnt lgkmcnt(0)\n\ts_barrier":::"memory");
    float woff=0.f;
    #pragma unroll
    for(int w_=0;w_<NW;++w_){ const float tw=fw3[w_]; if(w_<wid)woff+=tw; }
    const float ex=woff+(inc-v3); const float L2E=1.4426950408889634f;
    *(__attribute__((address_space(3))) f32x4v*)(fs3+t0)=(f32x4v){(v0+ex)*L2E,(v1+ex)*L2E,(v2+ex)*L2E,(v3+ex)*L2E};
    asm volatile("s_waitcnt lgkmcnt(0)\n\ts_barrier":::"memory"); }
  const float fq2=fs3[q0+wid*QBLK+r32];
  #define FKSUB(P0,P1,t) do{ const lds_fptr fk_=fs3+(t)*KVBLK+4*hi; \
    _Pragma("unroll") for(int r_=0;r_<16;++r_){ P0[r_]+=nq; P1[r_]+=nq; } \
    _Pragma("unroll") for(int j_=0;j_<4;++j_){ { const f32x4v a_=*(const __attribute__((address_space(3))) f32x4v*)(fk_+8*j_); \
      _Pragma("unroll") for(int i_=0;i_<4;++i_) P0[4*j_+i_]-=a_[i_]; } SBAR(); \
      { const f32x4v b_=*(const __attribute__((address_space(3))) f32x4v*)(fk_+32+8*j_); \
      _Pragma("unroll") for(int i_=0;i_<4;++i_) P1[4*j_+i_]-=b_[i_]; } SBAR(); } }while(0)
  #define INITRD(P0,P1,tt) do{ const lds_fptr fk_=fs3+(tt)*KVBLK+4*hi; \
    _Pragma("unroll") for(int j_=0;j_<4;++j_){ const f32x4v a_=*(const __attribute__((address_space(3))) f32x4v*)(fk_+8*j_); const f32x4v b_=*(const __attribute__((address_space(3))) f32x4v*)(fk_+32+8*j_); \
      _Pragma("unroll") for(int i_=0;i_<4;++i_){ P0[4*j_+i_]=a_[i_]; P1[4*j_+i_]=b_[i_]; } } }while(0)
  #define INITSUB(P0,P1) do{ _Pragma("unroll") for(int r_=0;r_<16;++r_){ P0[r_]=nq-P0[r_]; P1[r_]=nq-P1[r_]; } }while(0)
  DMA_K(0,0);DMA_V(0,0);DMA_K(1,SLOTB);
  bf16x8 qr[4];
  #pragma unroll
  for(int d0=0;d0<4;++d0)qr[d0]=*reinterpret_cast<const bf16x8*>(&Qw[(long)r32*DM+d0*16+hi*8]);
  float mhat=0.f,l_reg=0.f;f32x16 o[2];o[0]=f32x16{};o[1]=f32x16{};const f32x16 negm=f32x16{}; float nq=fq2;
  const int qrel=wid*QBLK+r32;
  #define CMASK(P0,P1,t) do{int jb_=(t)-(NT-4); if(jb_>=0)cmask(P0,P1,jb_,qrel,hi);}while(0)
  bool resc=false;
  #define START(P0,P1) do{ const float rm=rowmax(P0,P1); resc=false; \
    { const float dl=max2f(rm,0.f); mhat=fadd_s(mhat,dl);     \
      _Pragma("unroll") for(int r=0;r<16;++r){P0[r]=fsub_s(P0[r],dl);P1[r]=fsub_s(P1[r],dl);} \
      nq=fq2-mhat; } \
    _Pragma("unroll") for(int r=0;r<16;++r)P0[r]=__builtin_amdgcn_exp2f(P0[r]); }while(0)
  #define RESC() do{ if(resc){ asm volatile("s_waitcnt lgkmcnt(0)":::"memory"); \
      _Pragma("unroll") for(int d_=0;d_<2;++d_) _Pragma("unroll") for(int r=0;r<16;++r)o[d_][r]*=wsf[crow(r,hi)]; } }while(0)
  f32x16 pA0,pA1,pB0,pB1;
  int sl_prev=0,sl_cur=0,sl_next=SLOTB;
  #define ROT() do{sl_prev=sl_cur;sl_cur=sl_next;sl_next=(sl_next==(NSLOT-1)*SLOTB)?0:sl_next+SLOTB;}while(0)
  DMA_K(2,2*SLOTB);
  WAIT_BAR(3);
  qkt(pA0,pA1,Kbase,qr,negm,r32,hi);asm volatile("s_nop 15\n\ts_nop 7":"+v"(pA0),"+v"(pA1));FKSUB(pA0,pA1,0);CMASK(pA0,pA1,0);
  START(pA0,pA1);
  _Pragma("unroll") for(int r=0;r<16;++r)pA1[r]=__builtin_amdgcn_exp2f(pA1[r]);
  INITRD(pB0,pB1,1); INITSUB(pB0,pB1);
  WAIT_BAR(0);
  DMA_K(3,0);DMA_V(1,SLOTB);
  ROT();
  kload8(kf,kp0+sl_cur);
  WAIT_BAR(2);
  s16x4 vlo[8],vhi[8]; u32x4 pw0,pw1,pw2,pw3;
  #define PKW(P,B) cvtpk_s(P[B],P[B+1])
  #define PAF(k) __builtin_bit_cast(bf16x8,pw##k)
  #define VFR(i) (bf16x8){vlo[i][0],vlo[i][1],vlo[i][2],vlo[i][3],vhi[i][0],vhi[i][1],vhi[i][2],vhi[i][3]}
  #define PIN(x) asm volatile("":"+v"(x))
  #define MX3(a,b,c) __builtin_fmaxf(__builtin_fmaxf((a),(b)),(c))
  #define GAPA(MF,A0,A1,A2,A3,W0,W1,PW) do{ MF; sacc+=A0; sacc+=A1; sacc+=A2; sacc+=A3; PIN(sacc); W0; W1; PIN(PW); SBAR(); }while(0)
  #define EX(v) __builtin_amdgcn_exp2f(v)
  #define GAPB(MF,X,B) do{ MF; X[B]=EX(X[B]); X[B+1]=EX(X[B+1]); X[B+2]=EX(X[B+2]); X[B+3]=EX(X[B+3]); PIN(X); SBAR(); }while(0)
  #define VRD(i) do{ vlo[i]=vtr(vp_+(((i)>>2)*4096+((i)&3)*1024)); vhi[i]=vtr(vp_+(((i)>>2)*4096+((i)&3)*1024+512)); }while(0)
  #define KRD(G,j) do{ if(G){ kload2(kf,kp0+sl_next,j); SBAR(); } }while(0)
  #define STEP(C0,C1,P0,P1,t,GK,GV,GL) do{ SBAR(); \
    const lds_cptr vp_=vp0+sl_prev; \
    VRD(0); SBAR(); float sacc=(P0[0]+P0[1]); \
    GAPA(C0=__builtin_amdgcn_mfma_f32_32x32x16_bf16(kf[0],qr[0],C0,0,0,0), P0[2],P0[3],P0[4],P0[5],     pw0[0]=PKW(P0,0), pw0[1]=PKW(P0,2), pw0); \
    VRD(4); SBAR(); GAPA(C1=__builtin_amdgcn_mfma_f32_32x32x16_bf16(kf[1],qr[0],C1,0,0,0), P0[6],P0[7],P0[8],P0[9],     pw0[2]=PKW(P0,4), pw0[3]=PKW(P0,6), pw0); \
    VRD(1); SBAR(); GAPA(C0=__builtin_amdgcn_mfma_f32_32x32x16_bf16(kf[2],qr[1],C0,0,0,0),   P0[10],P0[11],P0[12],P0[13], pw1[0]=PKW(P0,8), pw1[1]=PKW(P0,10), pw1); \
    VRD(5); SBAR(); GAPA(C1=__builtin_amdgcn_mfma_f32_32x32x16_bf16(kf[3],qr[1],C1,0,0,0),   P0[14],P0[15],P1[0],P1[1],   pw1[2]=PKW(P0,12),pw1[3]=PKW(P0,14), pw1); \
    VRD(2); SBAR(); GAPA(C0=__builtin_amdgcn_mfma_f32_32x32x16_bf16(kf[4],qr[2],C0,0,0,0),   P1[2],P1[3],P1[4],P1[5],     pw2[0]=PKW(P1,0), pw2[1]=PKW(P1,2), pw2); \
    VRD(6); SBAR(); GAPA(C1=__builtin_amdgcn_mfma_f32_32x32x16_bf16(kf[5],qr[2],C1,0,0,0),   P1[6],P1[7],P1[8],P1[9],     pw2[2]=PKW(P1,4), pw2[3]=PKW(P1,6), pw2); \
    VRD(3); SBAR(); GAPA(C0=__builtin_amdgcn_mfma_f32_32x32x16_bf16(kf[6],qr[3],C0,0,0,0),   P1[10],P1[11],P1[12],P1[13], pw3[0]=PKW(P1,8), pw3[1]=PKW(P1,10), pw3); \
    VRD(7); SBAR(); GAPA(C1=__builtin_amdgcn_mfma_f32_32x32x16_bf16(kf[7],qr[3],C1,0,0,0),   P1[14],P1[15],0.f,0.f,       pw3[2]=PKW(P1,12),pw3[3]=PKW(P1,14), pw3); \
    l_reg+=sacc; \
    if(GK){DMA_K((t)+3,sl_cur);} if(GV){DMA_V((t)+1,sl_next);} \
    CMASK(C0,C1,t); \
    { float a=MX3(C0[0],C0[1],C1[0]),b=MX3(C0[2],C0[3],C1[1]); a=MX3(a,C1[2],C1[3]); \
      _Pragma("unroll") for(int r=4;r<16;r+=4){a=MX3(a,C0[r],C0[r+1]);b=MX3(b,C0[r+2],C0[r+3]);a=MX3(a,C1[r],C1[r+1]);b=MX3(b,C1[r+2],C1[r+3]);} \
      float rm=__builtin_fmaxf(a,b); { auto rr=__builtin_amdgcn_permlane32_swap(__float_as_uint(rm),__float_as_uint(rm),false,false); rm=__builtin_fmaxf(__uint_as_float(rr[0]),__uint_as_float(rr[1])); } \
      resc=false; \
      if(__builtin_expect(__any(rm>(float)THRL),0)){ const float dl=__builtin_fmaxf(rm,0.f); mhat+=dl; \
        _Pragma("unroll") for(int r=0;r<16;++r){C0[r]-=dl;C1[r]-=dl;} \
        nq=fq2-mhat; \
        const float f=__builtin_amdgcn_exp2f(-dl); l_reg*=f; if(hi==0)wsf[r32]=f; resc=true; } } \
    SBAR(); if(GL){INITRD(P0,P1,(t)+1);} SBAR(); \
    GAPB(o[0]=__builtin_amdgcn_mfma_f32_32x32x16_bf16(PAF(0),VFR(0),o[0],0,0,0), C0,0); \
    GAPB(o[1]=__builtin_amdgcn_mfma_f32_32x32x16_bf16(PAF(0),VFR(4),o[1],0,0,0), C0,4); \
    KRD(GL,0); GAPB(o[0]=__builtin_amdgcn_mfma_f32_32x32x16_bf16(PAF(1),VFR(1),o[0],0,0,0), C0,8); \
    KRD(GL,1); GAPB(o[1]=__builtin_amdgcn_mfma_f32_32x32x16_bf16(PAF(1),VFR(5),o[1],0,0,0), C0,12); \
    KRD(GL,2); GAPB(o[0]=__builtin_amdgcn_mfma_f32_32x32x16_bf16(PAF(2),VFR(2),o[0],0,0,0), C1,0); \
    KRD(GL,3); GAPB(o[1]=__builtin_amdgcn_mfma_f32_32x32x16_bf16(PAF(2),VFR(6),o[1],0,0,0), C1,4); \
    GAPB(o[0]=__builtin_amdgcn_mfma_f32_32x32x16_bf16(PAF(3),VFR(3),o[0],0,0,0), C1,8); \
    GAPB(o[1]=__builtin_amdgcn_mfma_f32_32x32x16_bf16(PAF(3),VFR(7),o[1],0,0,0), C1,12); \
    if(GL){INITSUB(P0,P1);} \
    }while(0)
  int t=1;
  #undef CMASK
  #define CMASK(P0,P1,t) do{}while(0)
  for(;t+5<NT;t+=2){
    STEP(pB0,pB1,pA0,pA1,t,true,true,true);     WAIT_BAR(2); RESC(); ROT();
    STEP(pA0,pA1,pB0,pB1,t+1,true,true,true);   WAIT_BAR(2); RESC(); ROT();
  }
  #undef CMASK
  #define CMASK(P0,P1,t) do{int jb_=(t)-(NT-4); if(jb_>=0)cmask(P0,P1,jb_,qrel,hi);}while(0)
  #define ENDW(tt) do{ if((tt)+3<NT){WAIT_BAR(2);} else if((tt)+2<NT){WAIT_BAR(1);} else {WAIT_BAR(0);} }while(0)
  for(;t+1<NT;t+=2){
    STEP(pB0,pB1,pA0,pA1,t,(t+3<NT),(t+1<NT),(t+1<NT));       ENDW(t);   RESC(); ROT();
    STEP(pA0,pA1,pB0,pB1,t+1,(t+4<NT),(t+2<NT),(t+2<NT));     ENDW(t+1); RESC(); ROT();
  }
  STEP(pB0,pB1,pA0,pA1,NT-1,false,false,false); RESC();
  { float sacc=pB0[0]+pB0[1]; _Pragma("unroll") for(int r=2;r<16;++r)sacc+=pB0[r]; _Pragma("unroll") for(int r=0;r<16;++r)sacc+=pB1[r]; l_reg+=sacc;
    pw0=(u32x4){PKW(pB0,0),PKW(pB0,2),PKW(pB0,4),PKW(pB0,6)};pw1=(u32x4){PKW(pB0,8),PKW(pB0,10),PKW(pB0,12),PKW(pB0,14)};pw2=(u32x4){PKW(pB1,0),PKW(pB1,2),PKW(pB1,4),PKW(pB1,6)};pw3=(u32x4){PKW(pB1,8),PKW(pB1,10),PKW(pB1,12),PKW(pB1,14)};
    SBAR(); pv(o,vb0+sl_cur,PAF(0),PAF(1),PAF(2),PAF(3)); }
  #undef PKW
  #undef PAF
  #undef VFR
  #undef PIN
  #undef MX3
  #undef GAPA
  #undef GAPB
  #undef EX
  #undef VRD
  #undef KRD
  #undef STEP
  #undef ENDW
  {auto rr=__builtin_amdgcn_permlane32_swap(__float_as_uint(l_reg),__float_as_uint(l_reg),false,false);l_reg=__uint_as_float(rr[0])+__uint_as_float(rr[1]);}
  if(hi==0)wsf[32+r32]=l_reg;asm volatile("s_waitcnt lgkmcnt(0)":::"memory");
  float rli[16];
  #pragma unroll
  for(int r=0;r<16;++r)rli[r]=__builtin_amdgcn_rcpf(wsf[32+crow(r,hi)]);
  bf16*Ow=O+(rowbase+q0+wid*QBLK)*DM+h*D;
  { bf16*stg=(bf16*)(shm+LDS_OST)+wid*2048;
    #pragma unroll
    for(int r=0;r<16;++r){const int orow=crow(r,hi);
      #pragma unroll
      for(int d0=0;d0<2;++d0)stg[orow*64+d0*32+r32]=__float2bfloat16(o[d0][r]*rli[r]);}
    asm volatile("s_waitcnt lgkmcnt(0)":::"memory");
    #pragma unroll
    for(int i=0;i<4;++i){const int row=i*8+(lane>>3),ch=lane&7; const u32x4 v=*(const u32x4*)(stg+row*64+ch*8); ATTN_STORE16(Ow+(long)row*DM+ch*8,v);} }
  asm volatile("s_waitcnt lgkmcnt(0)\n\ts_barrier":::"memory");
  #undef FKSUB
  #undef INITRD
  #undef INITSUB
  #undef DMA_K
  #undef DMA_V
  #undef CMASK
  #undef START
  #undef RESC
  #undef ROT
}
constexpr int ATTN_LDS_BYTES=LDS_BYTES;
struct AttnTensors { const bf16* Q; const bf16* K; const bf16* V; bf16* O; const float* flog; const float* bf; };
struct AttnUnit { int bh; int qb; };
struct StaticOrder {
  int vcu,G;
  __device__ __forceinline__ explicit StaticOrder(int grid,int v):vcu(v),G(grid){}
  __device__ __forceinline__ bool next(int i,AttnUnit&u)const{
    if(G==256){ if(i>=4)return false; const int s=vcu&1; u.bh=vcu>>1; u.qb=(i==0)?7-s:(i==1)?4+s:(i==2)?3-s:s; return true; }
    const int idx=i*G+vcu; if(idx>=BATCH*NHEAD*NQB)return false; u.bh=idx>>3; u.qb=7-(idx&7); return true; }
  __device__ __forceinline__ void a_ready(const AttnUnit&)const{}
  __device__ __forceinline__ void done(const AttnUnit&)const{}
};
template<class Sched,int THRL=8> __device__ __forceinline__ void attn_phase(char*lds,const AttnTensors&T,const Sched&S){
  AttnUnit u; int prevbh=-1;
  for(int i=0;S.next(i,u);++i){ S.a_ready(u); attn_unit<THRL>(u.bh/NHEAD,u.bh%NHEAD,u.qb,T.Q,T.K,T.V,T.O,lds,T.flog,T.bf[u.bh%NHEAD],u.bh!=prevbh); prevbh=u.bh; S.done(u); }
}
#undef SBAR
#undef WAIT_BAR
}
namespace cg = cooperative_groups;
constexpr int NWAVES = 8;
constexpr int BATCH = 16, SEQ = 2048, DMODEL = 1024, MROWS = BATCH * SEQ, NHEADS = 8, AW = 512, FFH = 2816, NIN = 6912, NINSRC = 6664, DEPTH = 2;
constexpr size_t MiB = 1u << 20, KiB512 = 512u << 10;
constexpr size_t WS_SSQ = 0;
constexpr size_t WS_FLOG = 3 * MiB;
constexpr size_t WS_WIN = 4 * MiB;
constexpr size_t WS_WL = 18 * MiB, WL_STRIDE = 21 * MiB + MiB / 2;
constexpr size_t WL_A = 0, WL_B = 1 * MiB, WL_C = 2 * MiB, WL_OUT = 3 * MiB, WL_GU = 5 * MiB, WL_DN = 16 * MiB;
constexpr size_t WS_XB = 61 * MiB;
constexpr size_t WS_QA = 125 * MiB, WS_K = 157 * MiB, WS_V = 189 * MiB, WS_MIX = 157 * MiB;
constexpr size_t WS_U = 221 * MiB, WS_Z = 253 * MiB, WS_CB = 285 * MiB, WS_G = 317 * MiB;
constexpr size_t WS_ACT = 125 * MiB;
constexpr size_t WS_END = 509 * MiB;
static_assert(WS_K == WS_QA + 32 * MiB && WS_V == WS_QA + 64 * MiB && WS_U == WS_QA + 96 * MiB && WS_Z == WS_QA + 128 * MiB && WS_CB == WS_QA + 160 * MiB, "EpiIn addresses Q|K|V|U|Z|CB as six consecutive blocks");
static_assert(WS_WL + 2 * WL_STRIDE <= WS_XB && WS_G + (size_t)MROWS * 3072 * 2 <= WS_END && WS_ACT + (size_t)MROWS * FFH * 2 <= WS_G, "d_ws map");
constexpr int RING_BYTES = 131072, LDS_BYTES = 147456;

#define GAS __attribute__((address_space(1)))
#define LAS __attribute__((address_space(3)))
typedef unsigned short bf16;
typedef unsigned v4u __attribute__((ext_vector_type(4)));
typedef float f32x4 __attribute__((ext_vector_type(4)));
#define LDS_WAIT() asm volatile("s_waitcnt lgkmcnt(0)" ::: "memory")
__device__ __forceinline__ unsigned f2bf(float f) { unsigned u = __builtin_bit_cast(unsigned, f); return (u + 0x7fffu + ((u >> 16) & 1u)) >> 16; }
typedef float f32x2f_t __attribute__((ext_vector_type(2))); typedef __bf16 bf16x2f_t __attribute__((ext_vector_type(2)));
__device__ __forceinline__ unsigned pk2(float lo, float hi) { const f32x2f_t v = {lo, hi}; const bf16x2f_t b = __builtin_convertvector(v, bf16x2f_t); return __builtin_bit_cast(unsigned, b); }
__device__ __forceinline__ float wave_sum(float v) {
#pragma unroll
    for (int o = 1; o < 64; o <<= 1) v += __shfl_xor(v, o);
    return v;
}
struct CmId { __device__ __forceinline__ int operator()(int n) const { return n; } };
struct CmIn { __device__ __forceinline__ int operator()(int n) const {
    if (n < 1536) return n;
    if (n < 2048) return n + 8;
    if (n < 3072) { const int j = (n - 2048) >> 8, w = (n - 2048) & 255; return w < 128 ? 2056 + 128 * j + w : 3080 + 128 * j + (w - 128); }
    if (n < 3584) return 2568 + (n - 3072);
    if (n < 6656) return n + 8;
    if (n < 6664) return 1536 + (n - 6656);
    return -1; } };
struct CmGU { __device__ __forceinline__ int operator()(int n) const { const int j = n >> 8, w = n & 255; return w < 128 ? 128 * j + w : FFH + 128 * j + (w - 128); } };
__device__ __forceinline__ void wb_item(const float* pool_w, const float* pscale, const float* wpp, bf16* WBt, int item, int lane) {
    const int nb = (item >> 3) & 15, c8 = (item & 7) + 8 * (item >> 7), n = 64 * nb + lane, c0 = 8 * c8, g = c0 >> 7, cl = c0 & 127;
    float a0 = 0.f, a1 = 0.f, a2 = 0.f, a3 = 0.f, a4 = 0.f, a5 = 0.f, a6 = 0.f, a7 = 0.f;
    const float* pw = pool_w + ((size_t)g * 128 + cl) * 128;
#pragma unroll 2
    for (int d = 0; d < 128; d += 4) {
        const f32x4 ps = *(const GAS f32x4*)(pscale + g * 128 + d);
        const float w0 = wpp[(size_t)(g * 128 + d) * 1024 + n] * ps[0], w1 = wpp[(size_t)(g * 128 + d + 1) * 1024 + n] * ps[1], w2 = wpp[(size_t)(g * 128 + d + 2) * 1024 + n] * ps[2], w3 = wpp[(size_t)(g * 128 + d + 3) * 1024 + n] * ps[3];
#define WB_ROW(acc_, j_) { const f32x4 p_ = *(const GAS f32x4*)(pw + (j_) * 128 + d); acc_ += (p_[0] * w0 + p_[1] * w1) + (p_[2] * w2 + p_[3] * w3); }
        WB_ROW(a0, 0) WB_ROW(a1, 1) WB_ROW(a2, 2) WB_ROW(a3, 3) WB_ROW(a4, 4) WB_ROW(a5, 5) WB_ROW(a6, 6) WB_ROW(a7, 7)
#undef WB_ROW
    }
    v4u o; o.x = pk2(a0, a1); o.y = pk2(a2, a3); o.z = pk2(a4, a5); o.w = pk2(a6, a7);
    *(GAS v4u*)(WBt + (size_t)n * 512 + c0) = o;
}

struct Args { const float* in[16]; float* out; unsigned char* ws; int ph_lo, ph_hi; };
#define XB_TMO      128
#define XB_XCNT(j)  (256  + 64 * (j))
#define XB_XSUB(j)  (1280 + 64 * (j))
#define XB_XGEN(j)  (2304 + 64 * (j))
#define XB_TOP      3328
#define XB_TOPGEN   3392
#define XCD_BAR_WORDS 3456
#define XB_SPIN_CAP (1u << 18)

__device__ __forceinline__ unsigned xb_ld(unsigned* p)              { return __hip_atomic_load(p, __ATOMIC_RELAXED, __HIP_MEMORY_SCOPE_AGENT); }
__device__ __forceinline__ unsigned xb_add(unsigned* p, unsigned v) { return __hip_atomic_fetch_add(p, v, __ATOMIC_RELAXED, __HIP_MEMORY_SCOPE_AGENT); }
__device__ __forceinline__ unsigned xb_xcc_id() { return (unsigned)__builtin_amdgcn_s_getreg((3 << 11) | 20) & 0xFu; }
#define XB_SPIN(cond, bar) do { unsigned _sp = 0; while (cond) { __builtin_amdgcn_s_sleep(1); \
    if ((++_sp & 255u) == 0u) { if (xb_ld(&(bar)[XB_TMO])) break; if (_sp > XB_SPIN_CAP) { atomicAdd(&(bar)[XB_TMO], 1u); break; } } } } while (0)

struct XcdBarrier {
    unsigned* bar; unsigned x;
    volatile LAS unsigned* st;
};

__device__ __forceinline__ XcdBarrier xcd_barrier_post(unsigned* bar, volatile LAS unsigned* st) {
    XcdBarrier b; b.bar = bar; b.x = xb_xcc_id(); b.st = st;
    if (threadIdx.x == 0) (void)xb_add(&bar[XB_XCNT(b.x)], 1u);
    return b;
}
__device__ __forceinline__ void xcd_barrier_complete(unsigned* bar, unsigned x, unsigned& nloc, unsigned& nx) {
    const unsigned G = gridDim.x * gridDim.y * gridDim.z;
    unsigned sum, cnt, mine, sp = 0u;
    for (;;) {
        sum = 0u; cnt = 0u; mine = 0u;
#pragma unroll
        for (unsigned j = 0; j < 16; ++j) { const unsigned c = xb_ld(&bar[XB_XCNT(j)]); sum += c; cnt += (c > 0u) ? 1u : 0u; mine = (j == x) ? c : mine; }
        if (sum == G) break;
        __builtin_amdgcn_s_sleep(1);
        if ((++sp & 255u) == 0u) { if (xb_ld(&bar[XB_TMO])) break; if (sp > XB_SPIN_CAP) { atomicAdd(&bar[XB_TMO], 1u); break; } }
    }
    nloc = mine > 0u ? mine : 1u; nx = cnt > 0u ? cnt : 1u;
}

__device__ __forceinline__ void xcd_barrier(const XcdBarrier& b) {
    asm volatile("s_waitcnt vmcnt(0)" ::: "memory");
    __syncthreads();
    if (threadIdx.x == 0) {
        unsigned* bar = b.bar;
        __builtin_amdgcn_s_waitcnt(0);
        unsigned nloc = b.st[0], nx = b.st[1];
        if (nloc == 0u) { xcd_barrier_complete(bar, b.x, nloc, nx); b.st[0] = nloc; b.st[1] = nx; }
        const unsigned old = xb_add(&bar[XB_XSUB(b.x)], 1u);
        const unsigned gen = old / nloc;
        if (old + 1u == (gen + 1u) * nloc) {
            __builtin_amdgcn_fence(__ATOMIC_RELEASE, "agent");
            asm volatile("s_waitcnt vmcnt(0)" ::: "memory");
            const unsigned og = xb_add(&bar[XB_TOP], 1u);
            const unsigned tg = og / nx;
            if (og + 1u == (tg + 1u) * nx) xb_add(&bar[XB_TOPGEN], 1u);
            else XB_SPIN(xb_ld(&bar[XB_TOPGEN]) == tg, bar);
            __builtin_amdgcn_fence(__ATOMIC_ACQUIRE, "agent");
            xb_add(&bar[XB_XGEN(b.x)], 1u);
            asm volatile("s_waitcnt vmcnt(0)" ::: "memory");
        } else {
            XB_SPIN(xb_ld(&bar[XB_XGEN(b.x)]) == gen, bar);
            __builtin_amdgcn_fence(__ATOMIC_ACQUIRE, "agent");
            asm volatile("s_waitcnt vmcnt(0)" ::: "memory");
        }
    }
    __syncthreads();
}

constexpr size_t WS_BAR = 2 * MiB + 512 * 1024;
constexpr int BARLDS_OFF = RING_BYTES;
#ifndef REP_SEAM
#define REP_SEAM 1
#endif
#define GRID_SEAM() for (int rs_ = 0; rs_ < REP_SEAM; ++rs_) xcd_barrier(bar)

struct TrD { const float* W; const float* kscale; bf16* WT; int ldw, K, nblk, cmk, item; };
__device__ __forceinline__ void tr_desc(const Args& a, int it, TrD& d) {
    constexpr int I_IN = 16 * (NIN / 32), I_A = 8 * 32, I_OUT = 16 * 32, I_GU = 16 * (2 * FFH / 32), I_DN = (FFH / 64) * 32, PER_TR = I_IN + 2 * I_A + I_OUT + I_GU + I_DN;
    const int l = it / PER_TR; int r = it - l * PER_TR; unsigned char* wl = a.ws + WS_WL + (size_t)l * WL_STRIDE;
    d.kscale = nullptr; d.cmk = 0; d.ldw = 1024; d.nblk = 32;
    if (r < I_IN) { d.W = a.in[2] + (size_t)l * 1024 * NINSRC; d.ldw = NINSRC; d.K = 1024; d.WT = (l == 0) ? (bf16*)(a.ws + WS_WIN) : (bf16*)((unsigned char*)a.out + 64 * MiB); d.nblk = NIN / 32; d.kscale = a.in[1] + l * 1024; d.cmk = 1; d.item = r; return; } r -= I_IN;
    if (r < I_A) { d.W = a.in[5] + (size_t)l * 512 * 1024; d.K = 512; d.WT = (bf16*)(wl + WL_A); d.item = r; return; } r -= I_A;
    if (r < I_A) { d.W = a.in[10] + (size_t)l * 512 * 1024; d.K = 512; d.WT = (bf16*)(wl + WL_C); d.item = r; return; } r -= I_A;
    if (r < I_OUT) { d.W = a.in[11] + (size_t)l * 1024 * 1024; d.K = 1024; d.WT = (bf16*)(wl + WL_OUT); d.item = r; return; } r -= I_OUT;
    if (r < I_GU) { d.W = a.in[13] + (size_t)l * 1024 * 2 * FFH; d.ldw = 2 * FFH; d.K = 1024; d.WT = (bf16*)(wl + WL_GU); d.nblk = 2 * FFH / 32; d.kscale = a.in[12] + l * 1024; d.cmk = 2; d.item = r; return; } r -= I_GU;
    d.W = a.in[14] + (size_t)l * FFH * 1024; d.K = FFH; d.WT = (bf16*)(wl + WL_DN); d.item = r;
}
__device__ __forceinline__ void tr_load(const TrD& d, int lane, f32x4 (&v)[8]) {
    const int kb = d.item / d.nblk, nb = d.item % d.nblk, k0 = 64 * kb, n0 = 32 * nb, c4 = lane & 7, rr = lane >> 3, nd = n0 + 4 * c4;
    const int sc = d.cmk == 1 ? CmIn()(nd) : (d.cmk == 2 ? CmGU()(nd) : nd);
#pragma unroll
    for (int i = 0; i < 8; ++i) { const int k = k0 + 8 * i + rr; v[i] = (f32x4){0.f, 0.f, 0.f, 0.f}; if (sc >= 0) v[i] = *(const GAS f32x4*)(d.W + (size_t)k * d.ldw + sc); if (d.kscale) v[i] = v[i] * d.kscale[k]; }
}
__device__ __forceinline__ void tr_store(const TrD& d, int lane, const f32x4 (&v)[8], LAS float* scr) {
    const int kb = d.item / d.nblk, nb = d.item % d.nblk, k0 = 64 * kb, n0 = 32 * nb, c4 = lane & 7, rr = lane >> 3;
#pragma unroll
    for (int i = 0; i < 8; ++i) { LAS float* p = scr + (8 * i + rr) * 33 + 4 * c4; p[0] = v[i][0]; p[1] = v[i][1]; p[2] = v[i][2]; p[3] = v[i][3]; }
    LDS_WAIT(); asm volatile("" ::: "memory");
    const int c = lane & 7;
#pragma unroll
    for (int j = 0; j < 4; ++j) { const int n = (lane >> 3) + 8 * j; const LAS float* s = scr + (8 * c) * 33 + n;
        v4u o; o.x = pk2(s[0 * 33], s[1 * 33]); o.y = pk2(s[2 * 33], s[3 * 33]); o.z = pk2(s[4 * 33], s[5 * 33]); o.w = pk2(s[6 * 33], s[7 * 33]);
        *(GAS v4u*)(d.WT + (size_t)(n0 + n) * d.K + k0 + 8 * c) = o; }
    LDS_WAIT(); asm volatile("" ::: "memory");
}
__device__ __forceinline__ void convert_weights(const Args& a, LAS float* scr, int gw, int NGW, int lane, int mode, int lsel) {
    constexpr int I_IN = 16 * (NIN / 32), I_A = 8 * 32, I_OUT = 16 * 32, I_GU = 16 * (2 * FFH / 32), I_DN = (FFH / 64) * 32, PER_TR = I_IN + 2 * I_A + I_OUT + I_GU + I_DN, I_WB = 1024;
    static_assert(I_WB % 8 == 0, "wb_item: items 8k..8k+7 must be the eight waves of one workgroup");
    const int nwb = mode == 2 ? 0 : 2 * I_WB;
    for (int it = gw; it < nwb; it += NGW) { const int l = it / I_WB, r = it - l * I_WB; unsigned char* wl = a.ws + WS_WL + (size_t)l * WL_STRIDE;
        wb_item(a.in[6] + (size_t)l * 4 * 128 * 128, a.in[7] + l * 512, a.in[8] + (size_t)l * 512 * 1024, (bf16*)(wl + WL_B), r, lane); }
    constexpr int I_ACO = 2 * I_A + I_OUT, I_P = I_IN + I_GU, I_S = I_ACO + I_DN;
    const int ntr = mode == 0 ? 2 * PER_TR : (mode == 1 ? 2 * I_P : I_S);
#define TR_MAP(i_) (mode == 0 ? (i_) : (mode == 1 ? ((i_) / I_P) * PER_TR + (((i_) % I_P) < I_IN ? ((i_) % I_P) : ((i_) % I_P) + I_ACO) : lsel * PER_TR + I_IN + ((i_) < I_ACO ? (i_) : (i_) + I_GU)))
    int it = gw; bool h0 = it < ntr, h1 = it + NGW < ntr; TrD d0, d1, d2; f32x4 va[8], vb[8], vc[8];
    if (h0) { tr_desc(a, TR_MAP(it), d0); tr_load(d0, lane, va); }
    if (h1) { tr_desc(a, TR_MAP(it + NGW), d1); tr_load(d1, lane, vb); }
    while (h0) {
        const int it2 = it + 2 * NGW; const bool h2 = it2 < ntr;
        if (h2) { tr_desc(a, TR_MAP(it2), d2); tr_load(d2, lane, vc); }
        tr_store(d0, lane, va, scr);
        d0 = d1; d1 = d2; it += NGW; h0 = h1; h1 = h2;
#pragma unroll
        for (int i = 0; i < 8; ++i) { va[i] = vb[i]; vb[i] = vc[i]; }
    }
#undef TR_MAP
}

__device__ __forceinline__ void x_to_bf16(const Args& a, int gw, int NGW, int lane) {
    const float* x = a.in[0]; bf16* XB = (bf16*)(a.ws + WS_XB);
    const int per = (MROWS + NGW - 1) / NGW;
    for (int m0 = gw * per; m0 < MROWS && m0 < (gw + 1) * per; m0 += 4) {
        f32x4 v[4][4];
#pragma unroll
        for (int r = 0; r < 4; ++r)
#pragma unroll
            for (int j = 0; j < 4; ++j) v[r][j] = *((const GAS f32x4*)(x + (size_t)(m0 + r) * 1024) + lane + 64 * j);
#pragma unroll
        for (int r = 0; r < 4; ++r) { const int m = m0 + r; float s = 0.f;
#pragma unroll
            for (int j = 0; j < 4; ++j) s += (v[r][j].x * v[r][j].x + v[r][j].y * v[r][j].y) + (v[r][j].z * v[r][j].z + v[r][j].w * v[r][j].w);
            s = wave_sum(s);
            GAS unsigned long long* o8 = (GAS unsigned long long*)(XB + (size_t)m * 1024) + lane;
#pragma unroll
            for (int j = 0; j < 4; ++j) o8[64 * j] = (unsigned long long)pk2(v[r][j].x, v[r][j].y) | ((unsigned long long)pk2(v[r][j].z, v[r][j].w) << 32);
            if (lane < 20) { const int bufi = lane >> 2, slot = lane & 3; *(GAS float*)(a.ws + WS_SSQ + (size_t)bufi * KiB512 + ((size_t)slot * MROWS + m) * 4) = (lane == 0) ? s : 0.f; } }
    }
}

__device__ __forceinline__ void unpk8(const v4u w, float (&f)[8]) {
    f[0] = __uint_as_float(w.x << 16); f[1] = __uint_as_float(w.x & 0xffff0000u); f[2] = __uint_as_float(w.y << 16); f[3] = __uint_as_float(w.y & 0xffff0000u);
    f[4] = __uint_as_float(w.z << 16); f[5] = __uint_as_float(w.z & 0xffff0000u); f[6] = __uint_as_float(w.w << 16); f[7] = __uint_as_float(w.w & 0xffff0000u); }
__device__ __forceinline__ v4u pk8(const float (&f)[8]) { v4u o; o.x = pk2(f[0], f[1]); o.y = pk2(f[2], f[3]); o.z = pk2(f[4], f[5]); o.w = pk2(f[6], f[7]); return o; }

__device__ __forceinline__ void pool_conv_phase(const Args& a, int l, int vcu, int G, int tid) {
    const bf16* __restrict__ U = (const bf16*)(a.ws + WS_U); const bf16* __restrict__ Z = (const bf16*)(a.ws + WS_Z); const bf16* __restrict__ CB = (const bf16*)(a.ws + WS_CB);
    bf16* __restrict__ Dp = (bf16*)a.out; bf16* __restrict__ YC = (bf16*)a.out + (size_t)MROWS * 512;
    const float* cw = a.in[9] + (size_t)l * 3 * 512;
    const int cgp = tid & 63, seg = tid >> 6, ch = 8 * cgp, w = 2 << (cgp >> 4);
    float w0[8], w1[8], w2[8];
#pragma unroll
    for (int j = 0; j < 8; ++j) { w0[j] = cw[ch + j]; w1[j] = cw[512 + ch + j]; w2[j] = cw[1024 + ch + j]; }
    for (int chunk = vcu; chunk < MROWS / 128; chunk += G) {
        const int first = chunk * 128 + seg * 16, tb = first & (SEQ - 1);
        { float sum[8], uc[8], t8[8];
#pragma unroll
          for (int j = 0; j < 8; ++j) sum[j] = 0.f;
          for (int j = 1; j < w; ++j) if (tb - j >= 0) { unpk8(*(const GAS v4u*)(U + (size_t)(first - j) * 512 + ch), t8);
#pragma unroll
              for (int q = 0; q < 8; ++q) sum[q] += t8[q]; }
#pragma unroll
          for (int i = 0; i < 16; ++i) { const int row = first + i, t = tb + i;
              unpk8(*(const GAS v4u*)(U + (size_t)row * 512 + ch), uc);
              const float inv = 1.0f / (float)((t + 1) < w ? (t + 1) : w);
#pragma unroll
              for (int q = 0; q < 8; ++q) { sum[q] += uc[q]; t8[q] = sum[q] * inv - uc[q]; }
              *(GAS v4u*)(Dp + (size_t)row * 512 + ch) = pk8(t8);
              if (t - w + 1 >= 0) { unpk8(*(const GAS v4u*)(U + (size_t)(row - w + 1) * 512 + ch), t8);
#pragma unroll
                  for (int q = 0; q < 8; ++q) sum[q] -= t8[q]; } } }
        { float z2[8], z1[8], z0[8], cb[8], y[8];
#pragma unroll
          for (int q = 0; q < 8; ++q) { z2[q] = 0.f; z1[q] = 0.f; }
          if (tb >= 2) unpk8(*(const GAS v4u*)(Z + (size_t)(first - 2) * 512 + ch), z2);
          if (tb >= 1) unpk8(*(const GAS v4u*)(Z + (size_t)(first - 1) * 512 + ch), z1);
#pragma unroll
          for (int i = 0; i < 16; ++i) { const int row = first + i;
              unpk8(*(const GAS v4u*)(Z + (size_t)row * 512 + ch), z0); unpk8(*(const GAS v4u*)(CB + (size_t)row * 512 + ch), cb);
#pragma unroll
              for (int q = 0; q < 8; ++q) { y[q] = cb[q] * (w0[q] * z2[q] + w1[q] * z1[q] + w2[q] * z0[q]); z2[q] = z1[q]; z1[q] = z0[q]; }
              *(GAS v4u*)(YC + (size_t)row * 512 + ch) = pk8(y); } }
    }
}

__device__ __forceinline__ void final_norm_phase(const Args& a, int gw, int NGW, int lane) {
    float* out = a.out; const bf16* XB = (const bf16*)(a.ws + WS_XB); const float* ssq = (const float*)(a.ws + WS_SSQ + 4 * KiB512); const float* gn = a.in[15];
    f32x4 g4[2][2];
#pragma unroll
    for (int j = 0; j < 2; ++j) { g4[j][0] = *(const GAS f32x4*)(gn + 512 * j + 8 * lane); g4[j][1] = *(const GAS f32x4*)(gn + 512 * j + 8 * lane + 4); }
    for (int m = gw; m < MROWS; m += NGW) {
        const float rs = __builtin_amdgcn_rsqf(((ssq[m] + ssq[MROWS + m]) + (ssq[2 * MROWS + m] + ssq[3 * MROWS + m])) * (1.0f / 1024.0f) + 1e-6f);
#pragma unroll
        for (int j = 0; j < 2; ++j) { float v[8]; unpk8(*(const GAS v4u*)(XB + (size_t)m * 1024 + 512 * j + 8 * lane), v);
            GAS f32x4* o = (GAS f32x4*)(out + (size_t)m * 1024 + 512 * j + 8 * lane);
            o[0] = (f32x4){v[0], v[1], v[2], v[3]} * rs * g4[j][0]; o[1] = (f32x4){v[4], v[5], v[6], v[7]} * rs * g4[j][1]; }
    }
}

__global__ void __launch_bounds__(NWAVES * 64, 2) fwd_megakernel(Args a) {
    extern __shared__ __attribute__((aligned(16))) unsigned char lds[];
    cg::grid_group grid = cg::this_grid();
    if (a.ph_lo < 0) grid.sync();
    LAS unsigned char* ldsl = (LAS unsigned char*)lds;
    const int G = gridDim.x, bx = blockIdx.x, vcu = (G % 8 == 0) ? (bx % 8) * (G / 8) + bx / 8 : bx, NGW = G * NWAVES;
#define FRESH_IDS() int tid_ = threadIdx.x; asm volatile("" : "+v"(tid_)); const int tid = tid_, lane = tid & 63, wave = __builtin_amdgcn_readfirstlane(tid >> 6), gw = vcu * NWAVES + wave; LAS float* scr = (LAS float*)(ldsl + wave * 16384); (void)tid; (void)lane; (void)gw; (void)scr
    unsigned char* ws = a.ws;
    bf16* XB = (bf16*)(ws + WS_XB);
    if (threadIdx.x < 2) ((volatile LAS unsigned*)(ldsl + BARLDS_OFF))[threadIdx.x] = 0u;
    __syncthreads();
    const XcdBarrier bar = xcd_barrier_post((unsigned*)(ws + WS_BAR), (volatile LAS unsigned*)(ldsl + BARLDS_OFF));

#define IN(k) (a.ph_lo <= (k) && (k) < a.ph_hi)
#ifndef REP_PRO
#define REP_PRO 1
#endif
#ifndef REP_IN
#define REP_IN 1
#endif
#ifndef REP_PC
#define REP_PC 1
#endif
#ifndef REP_MIX
#define REP_MIX 1
#endif
#ifndef REP_GU
#define REP_GU 1
#endif
#define BOTH(k) (IN(k) && IN((k) + 1))
#ifndef NO_PRO
    for (int rp_ = 0; rp_ < REP_PRO; ++rp_) if (IN(0)) { FRESH_IDS();
    convert_weights(a, scr, gw, NGW, lane, (G == 256) ? 1 : 0, 0);
    x_to_bf16(a, gw, NGW, lane); }
#endif
    if (BOTH(0)) GRID_SEAM();

#pragma unroll 1
    for (int l = 0; l < DEPTH; ++l) {
        unsigned char* wl = ws + WS_WL + (size_t)l * WL_STRIDE; const int p0 = 1 + 6 * l;
        const bf16* WIN = (l == 0) ? (const bf16*)(ws + WS_WIN) : (const bf16*)((unsigned char*)a.out + 64 * MiB);
        const float* ssq_in = (const float*)(ws + WS_SSQ + (size_t)(2 * l) * KiB512);
        float* ssq_mid = (float*)(ws + WS_SSQ + (size_t)(2 * l + 1) * KiB512);
        float* ssq_end = (float*)(ws + WS_SSQ + (size_t)(2 * l + 2) * KiB512);
#ifndef NO_IN
#ifndef STAG_IN
#define STAG_IN 0
#endif
        if (IN(p0) && STAG_IN > 0 && G == 256 && bx >= 128) { const unsigned long long t0_ = __builtin_amdgcn_s_memrealtime(), d_ = (unsigned long long)(1 + ((bx >> 3) % 3)) * STAG_IN; while (__builtin_amdgcn_s_memrealtime() - t0_ < d_) __builtin_amdgcn_s_sleep(32); }
        for (int rp_ = 0; rp_ < REP_IN; ++rp_) if (IN(p0)) { pg8::Gemm g{XB, XB, XB, WIN, WIN, WIN, MROWS, NIN, 1024}; pg8::StaticOrder S; S.init(MROWS, NIN, G, bx);
          pg8::EpiIn E{ssq_in, a.in[4] + (size_t)l * 3072, (bf16*)(ws + WS_QA), (bf16*)(ws + WS_G),
                       (float*)(ws + WS_FLOG), attn_body::C2};
          pg8::gemm_phase<pg8::EpiIn, pg8::StaticOrder, true, true>(ldsl, g, S, E);
          if (rp_ == REP_IN - 1 && G == 256 && bx >= 128) { FRESH_IDS(); convert_weights(a, scr, (bx - 128) * NWAVES + wave, 128 * NWAVES, lane, 2, l); } }
#endif
        if (BOTH(p0 + 0)) GRID_SEAM();
#ifndef NO_PRO
#endif
#ifndef NO_ATT
#ifndef REP_ATT
#define REP_ATT 1
#endif
        bf16* const YA = (bf16*)(ws + WS_QA);
#pragma unroll 1
        for (int st_ = 0; st_ < 2; ++st_) {
        const bool att_now = (st_ == ((vcu >> 1) & 1));
        if (att_now && IN(p0 + 1)) { const attn_body::AttnTensors AT{(const attn_body::bf16*)(ws + WS_QA), (const attn_body::bf16*)(ws + WS_K), (const attn_body::bf16*)(ws + WS_V), (attn_body::bf16*)YA,
                                          (const float*)(ws + WS_FLOG), a.in[3] + l * NHEADS};
          const attn_body::StaticOrder S(G, vcu);
          attn_body::attn_phase<attn_body::StaticOrder>((char*)lds, AT, S); }
#endif
#ifndef NO_PC
        for (int rp_ = 0; rp_ < REP_PC; ++rp_) if (!att_now && IN(p0 + 1)) { FRESH_IDS(); pool_conv_phase(a, l, vcu, G, tid); }
#endif
        }
        if (BOTH(p0 + 1)) GRID_SEAM();
#ifndef NO_MIX
        for (int rp_ = 0; rp_ < REP_MIX; ++rp_) if (IN(p0 + 2)) { pg8::Gemm g{(const bf16*)YA, (const bf16*)a.out, (const bf16*)a.out + (size_t)MROWS * 512, (const bf16*)(wl + WL_A), (const bf16*)(wl + WL_B), (const bf16*)(wl + WL_C), MROWS, 1024, 512};
          pg8::StaticOrder3 S; S.init(MROWS, 1024, G, bx);
          pg8::EpiMix E{(const bf16*)(ws + WS_G), (bf16*)(ws + WS_MIX), (bf16*)(ws + WS_U)};
          pg8::gemm_phase<pg8::EpiMix, pg8::StaticOrder3, true, true>(ldsl, g, S, E); }
#endif
        if (BOTH(p0 + 2)) GRID_SEAM();
#ifndef NO_OUT
#ifndef REP_OUT
#define REP_OUT 1
#endif
        if (IN(p0 + 3)) { const bf16* A = (const bf16*)(ws + WS_MIX); const bf16* B = (const bf16*)(wl + WL_OUT);
          pg8::Gemm g{A, A, A, B, B, B, MROWS, 1024, 1024}; pg8::StaticOrder S; S.init(MROWS, 1024, G, bx);
          pg8::EpiResid E{XB, ssq_mid};
          pg8::gemm_phase<pg8::EpiResid, pg8::StaticOrder, true, true>(ldsl, g, S, E); }
#endif
        if (BOTH(p0 + 3)) GRID_SEAM();
#ifndef NO_GU
        for (int rp_ = 0; rp_ < REP_GU; ++rp_) if (IN(p0 + 4)) { const bf16* B = (const bf16*)(wl + WL_GU);
          pg8::Gemm g{XB, XB, XB, B, B, B, MROWS, 2 * FFH, 1024}; pg8::StaticOrder S; S.init(MROWS, 2 * FFH, G, bx);
          pg8::EpiSwiglu E{ssq_mid, (bf16*)(ws + WS_ACT)};
          pg8::gemm_phase<pg8::EpiSwiglu, pg8::StaticOrder, true, true>(ldsl, g, S, E); }
#endif
        if (BOTH(p0 + 4)) GRID_SEAM();
#ifndef NO_DN
        if (IN(p0 + 5)) { const bf16* A = (const bf16*)(ws + WS_ACT); const bf16* B = (const bf16*)(wl + WL_DN);
          pg8::Gemm g{A, A, A, B, B, B, MROWS, 1024, FFH}; pg8::StaticOrder S; S.init(MROWS, 1024, G, bx);
          pg8::EpiResid E{XB, ssq_end};
          pg8::gemm_phase<pg8::EpiResid, pg8::StaticOrder, true, true>(ldsl, g, S, E); }
#endif
        if (BOTH(p0 + 5)) GRID_SEAM();
    }
    if (IN(13)) { FRESH_IDS(); final_norm_phase(a, gw, NGW, lane); }
}

__global__ void ws_too_small_fill(float* out, int n) { for (int i = blockIdx.x * blockDim.x + threadIdx.x; i < n; i += gridDim.x * blockDim.x) out[i] = 7777.f; }

extern "C" void kernel_launch(void* const* d_in, const int* in_sizes, int n_in, void* d_out, int out_size, void* d_ws, size_t ws_size, hipStream_t stream) {
    static int grid = 0;
    if (grid == 0) {
        int dev = 0, cus = 0, per_cu = 0;
        if (hipGetDevice(&dev) != hipSuccess || hipDeviceGetAttribute(&cus, hipDeviceAttributeMultiprocessorCount, dev) != hipSuccess) { fprintf(stderr, "kernel_launch: device query failed\n"); grid = -1; return; }
        if (hipFuncSetAttribute((const void*)fwd_megakernel, hipFuncAttributeMaxDynamicSharedMemorySize, LDS_BYTES) != hipSuccess) { fprintf(stderr, "kernel_launch: hipFuncSetAttribute failed\n"); grid = -1; return; }
        if (hipOccupancyMaxActiveBlocksPerMultiprocessor(&per_cu, (const void*)fwd_megakernel, NWAVES * 64, LDS_BYTES) != hipSuccess || per_cu < 1) per_cu = 1;
        (void)hipGetLastError();
        grid = cus;
    }
    if (grid < 0) return;
    if (n_in != 16 || out_size != MROWS * DMODEL || ws_size < WS_END) { ws_too_small_fill<<<256, 256, 0, stream>>>((float*)d_out, out_size); return; }
    Args a{};
    for (int i = 0; i < 16; ++i) a.in[i] = (const float*)d_in[i];
    a.out = (float*)d_out; a.ws = (unsigned char*)d_ws;
#ifndef MK_LAUNCHES
#define MK_LAUNCHES 1
#endif
#if MK_LAUNCHES == 1
    a.ph_lo = 0; a.ph_hi = 14;
    if (hipMemsetAsync((unsigned char*)d_ws + WS_BAR, 0, XCD_BAR_WORDS * 4, stream) != hipSuccess) { fprintf(stderr, "kernel_launch: memset of the barrier words failed\n"); return; }
    void* args[] = {&a};
    hipError_t e = hipLaunchCooperativeKernel((const void*)fwd_megakernel, dim3(grid), dim3(NWAVES * 64), args, LDS_BYTES, stream);
    if (e != hipSuccess) fprintf(stderr, "kernel_launch: cooperative launch failed: %s (grid %d)\n", hipGetErrorString(e), grid);
#else
    for (int p = 0; p < 14; ++p) { a.ph_lo = p; a.ph_hi = p + 1; hipLaunchKernelGGL(fwd_megakernel, dim3(grid), dim3(NWAVES * 64), LDS_BYTES, stream, a); }
#endif
}
```

```cpp
#define MK_LAUNCHES 1
#include <hip/hip_runtime.h>
#include <hip/hip_cooperative_groups.h>
#include <cstdio>
#include <cstdint>
namespace pg8 {
#define PG8_LAS __attribute__((address_space(3)))
typedef unsigned short bf16_t;
typedef short bf16x8 __attribute__((ext_vector_type(8)));
typedef float f32x4 __attribute__((ext_vector_type(4)));
typedef unsigned u32x4 __attribute__((ext_vector_type(4)));
constexpr int BM = 256, BK = 64, HALF = 128, HTB = HALF * BK * 2  , STAGE_BYTES = 8 * HTB, NXCD = 8, WGM = 4;

__host__ __device__ __forceinline__ int lds_byte(int r, int c) { const int st = (r >> 4) * 2 + (c >> 5), rr = r & 15, cc = c & 31, ob = rr * 64 + cc * 2; return st * 1024 + (ob ^ (((ob >> 9) & 1) << 5)); }
__host__ __device__ __forceinline__ void stage_rc(int b, int& R, int& C) { const int st = b / 1024, sb = b % 1024, swz = sb ^ (((sb >> 9) & 1) << 5); R = (st >> 1) * 16 + swz / 64; C = (st & 1) * 32 + (swz % 64) / 2; }
__host__ __device__ __forceinline__ int perm32(int rho) { const int n = rho >> 4, i = rho & 15; return 8 * (i >> 2) + 4 * n + (i & 3); }

struct Unit { int pm, pn, sub; };
struct Gemm { const bf16_t *A0, *A1, *A2, *B0, *B1, *B2; int M, N, K; };

struct StaticOrder {
    int nM, nN, nwg, G, c, wg;
    __host__ __device__ void init(int M, int N, int G_, int c_, int wg_ = WGM) { nM = M / BM; nN = N / BM; nwg = nM * nN; G = G_; c = c_; wg = wg_; }
    __host__ __device__ bool next(int i, Unit& u) const {
        const long L = (long)i * G + c; if (L >= nwg) return false;
        int wgid = (int)L; { const int q = nwg / NXCD, r = nwg % NXCD, xcd = wgid % NXCD, off = wgid / NXCD; wgid = (xcd < r ? xcd * (q + 1) : r * (q + 1) + (xcd - r) * q) + off; }
        const int nig = wg * nN, gid = wgid / nig, fm = gid * wg, gsz = (nM - fm) < wg ? (nM - fm) : wg;
        u.pm = fm + ((wgid % nig) % gsz); u.pn = (wgid % nig) / gsz; u.sub = 0; return true;
    }
    __device__ __forceinline__ void a_ready(const Unit&) const {}
    __device__ __forceinline__ void done(const Unit&) const {}
};

struct StaticOrder3 {
    StaticOrder b;
    __host__ __device__ void init(int M, int N, int G_, int c_) { b.init(M, N, G_, c_); }
    __host__ __device__ bool next(int i, Unit& u) const { if (!b.next(i / 3, u)) return false; u.sub = i % 3; return true; }
    __device__ __forceinline__ void a_ready(const Unit&) const {}
    __device__ __forceinline__ void done(const Unit&) const {}
};
typedef float f32x2c_t __attribute__((ext_vector_type(2))); typedef __bf16 bf16x2c_t __attribute__((ext_vector_type(2)));
__device__ __forceinline__ unsigned cvt_pk_bf16(float lo, float hi) { const f32x2c_t v = {lo, hi}; const bf16x2c_t b = __builtin_convertvector(v, bf16x2c_t); return __builtin_bit_cast(unsigned, b); }
typedef float f32x2 __attribute__((ext_vector_type(2)));
__device__ __forceinline__ float rstd_of(const float* ssq, int row) { const float s0 = ssq[row], s1 = ssq[32768 + row], s2 = ssq[2 * 32768 + row], s3 = ssq[3 * 32768 + row]; return __builtin_amdgcn_rsqf(((s0 + s1) + (s2 + s3)) * (1.0f / 1024.0f) + 1e-6f); }
__device__ __forceinline__ float sigm(float v) { return __builtin_amdgcn_rcpf(1.0f + __builtin_amdgcn_exp2f(-1.4426950408889634f * v)); }
__device__ __forceinline__ u32x4 pack8(const f32x4 a, const f32x4 b) { u32x4 w; w.x = cvt_pk_bf16(a[0], a[1]); w.y = cvt_pk_bf16(a[2], a[3]); w.z = cvt_pk_bf16(b[0], b[1]); w.w = cvt_pk_bf16(b[2], b[3]); return w; }
__device__ __forceinline__ void st16_nt(void* p, const u32x4 v) { __builtin_nontemporal_store(v, (u32x4*)p); }
__device__ __forceinline__ void unpack8(const u32x4 w, f32x4& a, f32x4& b) {
    a[0] = __uint_as_float(w.x << 16); a[1] = __uint_as_float(w.x & 0xffff0000u); a[2] = __uint_as_float(w.y << 16); a[3] = __uint_as_float(w.y & 0xffff0000u);
    b[0] = __uint_as_float(w.z << 16); b[1] = __uint_as_float(w.z & 0xffff0000u); b[2] = __uint_as_float(w.w << 16); b[3] = __uint_as_float(w.w & 0xffff0000u); }

constexpr int AUX_OFF = 131072 + 1024, AUX_BYTES = 4096 + 1024;
__device__ __forceinline__ void pre_rows(PG8_LAS unsigned char* lds, const float* ssq, int pm, int par, int wid, int lane) {
#pragma unroll
    for (int i = 0; i < 2; ++i) { const int q = wid * 2 + i, slot = q >> 2, r0 = (q & 3) * 64;
        __builtin_amdgcn_global_load_lds((const unsigned*)(ssq + (size_t)slot * 32768 + pm * BM + r0 + lane), (PG8_LAS unsigned*)(lds + AUX_OFF + par * AUX_BYTES + (slot * 256 + r0) * 4), 4, 0, 0); }
}
__device__ __forceinline__ float rstd_lds(const PG8_LAS float* aux, int rl) { return __builtin_amdgcn_rsqf(((aux[rl] + aux[256 + rl]) + (aux[512 + rl] + aux[768 + rl])) * (1.0f / 1024.0f) + 1e-6f); }

struct EpiIn {
    static constexpr bool PERM = true, AFTER_DRAIN = false, PRE = true, SPLIT = false;
    const float* ssq; const float* bgate; bf16_t *Q, *G; float* FLOG; float qscale;
    __device__ __forceinline__ void pre(PG8_LAS unsigned char* lds, const Unit& u, int par, int wid, int lane) const {
        pre_rows(lds, ssq, u.pm, par, wid, lane);
        if (u.pn >= 14 && u.pn < 26 && wid < 4)
            __builtin_amdgcn_global_load_lds((const unsigned*)(bgate + (u.pn - 14) * 256 + wid * 64 + lane), (PG8_LAS unsigned*)(lds + AUX_OFF + par * AUX_BYTES + 4096 + wid * 256), 4, 0, 0);
    }
    template <int AI> __device__ __forceinline__ void part(const f32x4 (&acc)[2][2][4][2], const Unit& u, int wr, int wc, int fr, int fq, PG8_LAS unsigned char* lds, int par) const {
        const PG8_LAS float* aux = (const PG8_LAS float*)(lds + AUX_OFF + par * AUX_BYTES);
        const int rl0 = wr * 64 + fr + AI * HALF, row0 = u.pm * BM + rl0, pn = u.pn, cw = wc * 32 + 8 * fq;
        if (pn < 8 || pn == 12 || pn == 13) {
            const int blk = pn < 8 ? (pn >> 1) : 5, colt = (pn & 1) * 256; const float sc = pn < 2 ? qscale : 1.f;
            bf16_t* base = Q + (size_t)blk * ((size_t)32768 * 512);
#pragma unroll
            for (int m = 0; m < 4; ++m) { const int row = row0 + m * 16; const float rs = rstd_lds(aux, rl0 + m * 16) * sc; bf16_t* rowp = base + (size_t)row * 512 + colt + cw;
#pragma unroll
                for (int bj = 0; bj < 2; ++bj) st16_nt(rowp + bj * HALF, pack8(acc[AI][bj][m][0] * rs, acc[AI][bj][m][1] * rs)); }
        } else if (pn < 12) {
            const int colz = (pn - 8) * 128 + cw;
#pragma unroll
            for (int m = 0; m < 4; ++m) { const int row = row0 + m * 16; const float rs = rstd_lds(aux, rl0 + m * 16), rs2 = rs * rs;
                st16_nt(Q + (size_t)4 * ((size_t)32768 * 512) + (size_t)row * 512 + colz, pack8(acc[AI][0][m][0] * acc[AI][1][m][0] * rs2, acc[AI][0][m][1] * acc[AI][1][m][1] * rs2)); }
        } else if (pn < 26) {
            const int colg = (pn - 14) * 256 + cw;
            f32x4 bv[2][2];
#pragma unroll
            for (int bj = 0; bj < 2; ++bj)
#pragma unroll
                for (int n = 0; n < 2; ++n) bv[bj][n] = *(const PG8_LAS f32x4*)(aux + 1024 + cw + bj * HALF + 4 * n);
#pragma unroll
            for (int m = 0; m < 4; ++m) { const int row = row0 + m * 16; const float rs = rstd_lds(aux, rl0 + m * 16); bf16_t* rowp = G + (size_t)row * 3072 + colg;
#pragma unroll
                for (int bj = 0; bj < 2; ++bj) { f32x4 v0 = acc[AI][bj][m][0] * rs + bv[bj][0], v1 = acc[AI][bj][m][1] * rs + bv[bj][1];
#pragma unroll
                    for (int i = 0; i < 4; ++i) { v0[i] = sigm(v0[i]); v1[i] = sigm(v1[i]); }
                    st16_nt(rowp + bj * HALF, pack8(v0, v1)); } }
        } else {
            if (wc == 0 && fq == 0) {
#pragma unroll
                for (int m = 0; m < 4; ++m) { const int row = row0 + m * 16; const float rs = rstd_lds(aux, rl0 + m * 16);
                    *(f32x4*)(FLOG + (size_t)row * 8) = acc[AI][0][m][0] * rs; *(f32x4*)(FLOG + (size_t)row * 8 + 4) = acc[AI][0][m][1] * rs; }
            }
        }
    }
};

struct EpiResid {
    static constexpr bool PERM = true, AFTER_DRAIN = false, PRE = false, SPLIT = false;
    bf16_t* xb; float* ssq;
    __device__ __forceinline__ void operator()(const f32x4 (&acc)[2][2][4][2], const Unit& u, int wr, int wc, int fr, int fq) const {
        const int row0 = u.pm * BM + wr * 64 + fr, col0 = u.pn * BM + wc * 32 + 8 * fq;
#pragma unroll
        for (int ai = 0; ai < 2; ++ai)
#pragma unroll
            for (int m = 0; m < 4; ++m) { const int row = row0 + ai * HALF + m * 16; bf16_t* p = xb + (size_t)row * 1024 + col0; float ss = 0.f;
#pragma unroll
                for (int bj = 0; bj < 2; ++bj) { f32x4 a, b; unpack8(*(const u32x4*)(p + bj * HALF), a, b);
                    a = a + acc[ai][bj][m][0]; b = b + acc[ai][bj][m][1];
                    ss += ((a[0] * a[0] + a[1] * a[1]) + (a[2] * a[2] + a[3] * a[3])) + ((b[0] * b[0] + b[1] * b[1]) + (b[2] * b[2] + b[3] * b[3]));
                    *(u32x4*)(p + bj * HALF) = pack8(a, b); }
                ss += __shfl_xor(ss, 16); ss += __shfl_xor(ss, 32);
                if (fq == 0) atomicAdd(ssq + (size_t)u.pn * 32768 + row, ss); }
    }
};

__device__ __forceinline__ u32x4 ld16_sc1(const bf16_t* p) {
    const unsigned long long* q = (const unsigned long long*)p;
    const unsigned long long lo = __hip_atomic_load(q, __ATOMIC_RELAXED, __HIP_MEMORY_SCOPE_AGENT), hi = __hip_atomic_load(q + 1, __ATOMIC_RELAXED, __HIP_MEMORY_SCOPE_AGENT);
    u32x4 w; w.x = (unsigned)lo; w.y = (unsigned)(lo >> 32); w.z = (unsigned)hi; w.w = (unsigned)(hi >> 32); return w; }
struct EpiMix {
    static constexpr bool PERM = true, AFTER_DRAIN = false, PRE = false, SPLIT = false;
    const bf16_t* G; bf16_t* MIX; bf16_t* P1;
    __device__ __forceinline__ void operator()(const f32x4 (&acc)[2][2][4][2], const Unit& u, int wr, int wc, int fr, int fq) const {
        const int row0 = u.pm * BM + wr * 64 + fr, col0 = u.pn * BM + wc * 32 + 8 * fq, sub = u.sub;
#pragma unroll
        for (int ai = 0; ai < 2; ++ai)
#pragma unroll
            for (int m = 0; m < 4; ++m) { const int row = row0 + ai * HALF + m * 16;
#pragma unroll
                for (int bj = 0; bj < 2; ++bj) { const int c = col0 + bj * HALF; f32x4 g0, g1; unpack8(*(const u32x4*)(G + (size_t)row * 3072 + sub * 1024 + c), g0, g1);
                    f32x4 v0 = acc[ai][bj][m][0] * g0, v1 = acc[ai][bj][m][1] * g1; const size_t off = (size_t)row * 1024 + c;
                    if (sub == 2) { f32x4 p0, p1; unpack8(*(const u32x4*)(MIX + off), p0, p1); v0 = v0 + p0; v1 = v1 + p1; unpack8(*(const u32x4*)(P1 + off), p0, p1); v0 = v0 + p0; v1 = v1 + p1; }
                    *(u32x4*)((sub == 1 ? P1 : MIX) + off) = pack8(v0, v1); } }
    }
};

struct EpiSwiglu {
    static constexpr bool PERM = true, AFTER_DRAIN = false, PRE = true, SPLIT = true;
    const float* ssq; bf16_t* ACT;
    __device__ __forceinline__ void pre(PG8_LAS unsigned char* lds, const Unit& u, int par, int wid, int lane) const { pre_rows(lds, ssq, u.pm, par, wid, lane); }
    template <int AI> __device__ __forceinline__ void part(const f32x4 (&acc)[2][2][4][2], const Unit& u, int wr, int wc, int fr, int fq, PG8_LAS unsigned char* lds, int par) const {
        const PG8_LAS float* aux = (const PG8_LAS float*)(lds + AUX_OFF + par * AUX_BYTES);
        const int rl0 = wr * 64 + fr + AI * HALF, row0 = u.pm * BM + rl0, colh = u.pn * 128 + wc * 32 + 8 * fq;
#pragma unroll
        for (int m = 0; m < 4; ++m) { const int row = row0 + m * 16; const float rs = rstd_lds(aux, rl0 + m * 16);
            f32x4 h[2];
#pragma unroll
            for (int n = 0; n < 2; ++n) { const f32x4 a = acc[AI][0][m][n] * rs, b = acc[AI][1][m][n] * rs;
#pragma unroll
                for (int i = 0; i < 4; ++i) h[n][i] = a[i] * sigm(a[i]) * b[i]; }
            st16_nt(ACT + (size_t)row * 2816 + colh, pack8(h[0], h[1])); }
    }
};

template <class Epi, class Sched, bool ALIGN_EPI = false, bool SP2 = false>
__device__ __forceinline__ void gemm_phase(PG8_LAS unsigned char* lds, const Gemm g, const Sched& S, const Epi& E) {
    int tid_ = threadIdx.x; asm volatile("" : "+v"(tid_));
    const int tid = tid_, wid = __builtin_amdgcn_readfirstlane(tid >> 6), lane = tid & 63, wr = wid >> 2, wc = wid & 3, fr = lane & 15, fq = lane >> 4;
    const int K = g.K, nt = K / BK;
    unsigned voffA[2], voffB[2];
#pragma unroll
    for (int i = 0; i < 2; ++i) { int R, C; stage_rc(tid * 16 + i * 8192, R, C); const int Rb = Epi::PERM ? ((R & ~31) + perm32(R & 31)) : R;
        voffA[i] = (unsigned)(R * K + C) * 2u; voffB[i] = (unsigned)(Rb * K + C) * 2u; }
    const size_t kstep = (size_t)(BK * 2);
    const size_t hstep = (size_t)HALF * K * 2;
    const size_t tstep = 2 * hstep;
    const unsigned ldsw = (unsigned)wid * 1024u;
    const int aoff = lds_byte(wr * 64 + fr, fq * 8), boff = lds_byte(wc * 32 + fr, fq * 8);
#define PG8_SELA(s) ((const char*)((s) == 0 ? g.A0 : ((s) == 1 ? g.A1 : g.A2)))
#define PG8_SELB(s) ((const char*)((s) == 0 ? g.B0 : ((s) == 1 ? g.B1 : g.B2)))
#define PG8_SA(b, h) (((b) * 2 + (h)) * HTB)
#define PG8_SB(b, h) ((4 + (b) * 2 + (h)) * HTB)
#define PG8_STAGE(bufoff, gbase, voff) do { _Pragma("unroll") for (int _i = 0; _i < 2; ++_i) \
        __builtin_amdgcn_global_load_lds((const unsigned*)((const char*)(gbase) + (voff)[_i]), (PG8_LAS unsigned*)(lds + (bufoff) + ldsw + _i * 8192), 16, 0, 0); } while (0)
#define PG8_LDA(dst, b, h) do { _Pragma("unroll") for (int m = 0; m < 4; ++m) _Pragma("unroll") for (int k = 0; k < 2; ++k) dst[m][k] = *(const PG8_LAS bf16x8*)(lds + PG8_SA(b, h) + aoff + m * 2048 + k * 1024); } while (0)
#define PG8_LDB(dst, b, h) do { _Pragma("unroll") for (int n = 0; n < 2; ++n) _Pragma("unroll") for (int k = 0; k < 2; ++k) dst[n][k] = *(const PG8_LAS bf16x8*)(lds + PG8_SB(b, h) + boff + n * 2048 + k * 1024); } while (0)
#define PG8_MMA(ai, bj, At, Bt) do { __builtin_amdgcn_s_setprio(1); _Pragma("unroll") for (int m = 0; m < 4; ++m) _Pragma("unroll") for (int n = 0; n < 2; ++n) _Pragma("unroll") for (int k = 0; k < 2; ++k) \
        acc[ai][bj][m][n] = __builtin_amdgcn_mfma_f32_16x16x32_bf16(Bt[n][k], At[m][k], acc[ai][bj][m][n], 0, 0, 0); __builtin_amdgcn_s_setprio(0); } while (0)
#define PG8_WAIT_V(n) asm volatile("s_waitcnt vmcnt(" #n ")" ::: "memory")
#define PG8_WAIT_L(n) asm volatile("s_waitcnt lgkmcnt(" #n ")" ::: "memory")
#define PG8_BAR __builtin_amdgcn_s_barrier()
#define PG8_SCHED __builtin_amdgcn_sched_barrier(0)
    Unit cur, nxt; int ui = 0;
    if (!S.next(0, cur)) return;
    f32x4 acc[2][2][4][2];
#pragma unroll
    for (int a = 0; a < 2; ++a)
#pragma unroll
        for (int b = 0; b < 2; ++b)
#pragma unroll
            for (int m = 0; m < 4; ++m)
#pragma unroll
                for (int n = 0; n < 2; ++n) acc[a][b][m][n] = (f32x4){0.f, 0.f, 0.f, 0.f};
    bf16x8 At[4][2], B0[2][2], B1[2][2];
    const char* cA = PG8_SELA(cur.sub) + (size_t)cur.pm * tstep; const char* cB = PG8_SELB(cur.sub) + (size_t)cur.pn * tstep;
    S.a_ready(cur);
    if constexpr (Epi::PRE) E.pre(lds, cur, 0, wid, lane);
    if constexpr (SP2) {
        PG8_STAGE(PG8_SB(0, 0), cB, voffB); PG8_STAGE(PG8_SB(0, 1), cB + hstep, voffB); PG8_STAGE(PG8_SA(0, 0), cA, voffA); PG8_STAGE(PG8_SA(0, 1), cA + hstep, voffA);
        if (wr == 1) PG8_BAR;
        PG8_WAIT_V(2); PG8_BAR;
        PG8_STAGE(PG8_SB(1, 0), cB + kstep, voffB); PG8_STAGE(PG8_SA(1, 0), cA + kstep, voffA); PG8_STAGE(PG8_SB(1, 1), cB + hstep + kstep, voffB);
        PG8_WAIT_V(6); PG8_BAR;
    } else {
        PG8_STAGE(PG8_SB(0, 0), cB, voffB); PG8_STAGE(PG8_SA(0, 0), cA, voffA); PG8_STAGE(PG8_SB(0, 1), cB + hstep, voffB); PG8_STAGE(PG8_SA(0, 1), cA + hstep, voffA);
        if (wr == 1) PG8_BAR;
        PG8_WAIT_V(4); PG8_BAR;
        PG8_STAGE(PG8_SB(1, 0), cB + kstep, voffB); PG8_STAGE(PG8_SA(1, 0), cA + kstep, voffA); PG8_STAGE(PG8_SB(1, 1), cB + hstep + kstep, voffB);
        PG8_WAIT_V(6); PG8_BAR;
    }
    for (;;) {
        const bool has_next = S.next(ui + 1, nxt);
        const char* nA = has_next ? PG8_SELA(nxt.sub) + (size_t)nxt.pm * tstep : cA; const char* nB = has_next ? PG8_SELB(nxt.sub) + (size_t)nxt.pn * tstep : cB;
        for (int t = 0; t < nt; t += 2) {
            const bool last = (t == nt - 2);
            const char* a1 = cA + (size_t)(t + 1) * kstep;
            const char* a2 = last ? nA : cA + (size_t)(t + 2) * kstep; const char* b2 = last ? nB : cB + (size_t)(t + 2) * kstep;
            const char* a3 = a2 + kstep; const char* b3 = b2 + kstep;
            if (last && has_next) { S.a_ready(nxt); if constexpr (Epi::PRE) E.pre(lds, nxt, (ui + 1) & 1, wid, lane); }
            if constexpr (SP2) {
            PG8_LDB(B0, 0, 0); PG8_LDB(B1, 0, 1); PG8_SCHED; PG8_LDA(At, 0, 0); PG8_STAGE(PG8_SA(1, 1), a1 + hstep, voffA);
            PG8_WAIT_V(8); PG8_WAIT_L(0); PG8_BAR; PG8_MMA(0, 0, At, B0); PG8_MMA(0, 1, At, B1); PG8_BAR; PG8_SCHED;
            PG8_LDA(At, 0, 1); PG8_STAGE(PG8_SB(0, 0), b2, voffB); PG8_STAGE(PG8_SB(0, 1), b2 + hstep, voffB); PG8_STAGE(PG8_SA(0, 0), a2, voffA);
            PG8_WAIT_V(8); PG8_WAIT_L(0); PG8_BAR; PG8_MMA(1, 0, At, B0); PG8_MMA(1, 1, At, B1); PG8_BAR; PG8_SCHED;
            PG8_LDB(B0, 1, 0); PG8_LDB(B1, 1, 1); PG8_SCHED; PG8_LDA(At, 1, 0); PG8_STAGE(PG8_SA(0, 1), a2 + hstep, voffA);
            PG8_WAIT_V(8); PG8_WAIT_L(0); PG8_BAR; PG8_MMA(0, 0, At, B0); PG8_MMA(0, 1, At, B1); PG8_BAR; PG8_SCHED;
            PG8_LDA(At, 1, 1); PG8_STAGE(PG8_SB(1, 0), b3, voffB); PG8_STAGE(PG8_SB(1, 1), b3 + hstep, voffB); PG8_STAGE(PG8_SA(1, 0), a3, voffA);
            PG8_WAIT_V(8); PG8_WAIT_L(0); PG8_BAR; PG8_MMA(1, 0, At, B0); PG8_MMA(1, 1, At, B1);
            if constexpr (Epi::SPLIT) { if (last) { PG8_SCHED; E.template part<0>(acc, cur, wr, wc, fr, fq, lds, ui & 1); } }
            PG8_BAR; PG8_SCHED;
            } else {
            PG8_LDB(B0, 0, 0); PG8_SCHED; PG8_LDA(At, 0, 0); PG8_STAGE(PG8_SA(1, 1), a1 + hstep, voffA);
            PG8_WAIT_L(8); PG8_BAR; PG8_WAIT_L(0); PG8_MMA(0, 0, At, B0); PG8_BAR; PG8_SCHED;
            PG8_LDB(B1, 0, 1); PG8_STAGE(PG8_SB(0, 0), b2, voffB);
            PG8_BAR; PG8_WAIT_L(0); PG8_MMA(0, 1, At, B1); PG8_BAR;
            PG8_LDA(At, 0, 1); PG8_STAGE(PG8_SA(0, 0), a2, voffA);
            PG8_BAR; PG8_WAIT_L(0); PG8_MMA(1, 0, At, B0); PG8_BAR; PG8_SCHED;
            PG8_STAGE(PG8_SB(0, 1), b2 + hstep, voffB);
            PG8_WAIT_V(6); PG8_BAR; PG8_MMA(1, 1, At, B1); PG8_BAR;
            PG8_LDB(B0, 1, 0); PG8_SCHED; PG8_LDA(At, 1, 0); PG8_STAGE(PG8_SA(0, 1), a2 + hstep, voffA);
            PG8_WAIT_L(8); PG8_BAR; PG8_WAIT_L(0); PG8_MMA(0, 0, At, B0); PG8_BAR; PG8_SCHED;
            PG8_LDB(B1, 1, 1); PG8_STAGE(PG8_SB(1, 0), b3, voffB);
            PG8_BAR; PG8_WAIT_L(0); PG8_MMA(0, 1, At, B1); PG8_BAR;
            PG8_LDA(At, 1, 1); PG8_STAGE(PG8_SA(1, 0), a3, voffA);
            PG8_BAR; PG8_WAIT_L(0); PG8_MMA(1, 0, At, B0); PG8_BAR; PG8_SCHED;
            PG8_STAGE(PG8_SB(1, 1), b3 + hstep, voffB);
            PG8_WAIT_V(6); PG8_BAR; PG8_MMA(1, 1, At, B1); PG8_BAR;
            }
        }
        if constexpr (ALIGN_EPI) { if (wr == 0) PG8_BAR; }
        if constexpr (Epi::SPLIT) { E.template part<1>(acc, cur, wr, wc, fr, fq, lds, ui & 1); S.done(cur); }
        else if constexpr (Epi::PRE) { E.template part<0>(acc, cur, wr, wc, fr, fq, lds, ui & 1); E.template part<1>(acc, cur, wr, wc, fr, fq, lds, ui & 1); S.done(cur); }
        else if constexpr (!Epi::AFTER_DRAIN) { E(acc, cur, wr, wc, fr, fq); S.done(cur); }
        if (!has_next) break;
#pragma unroll
        for (int a = 0; a < 2; ++a)
#pragma unroll
            for (int b = 0; b < 2; ++b)
#pragma unroll
                for (int m = 0; m < 4; ++m)
#pragma unroll
                    for (int n = 0; n < 2; ++n) acc[a][b][m][n] = (f32x4){0.f, 0.f, 0.f, 0.f};
        cur = nxt; cA = nA; cB = nB; ++ui;
        if constexpr (ALIGN_EPI) { if (wr == 1) PG8_BAR; }
    }
    PG8_WAIT_V(0);
    if constexpr (!ALIGN_EPI) { if (wr == 0) PG8_BAR; }
    PG8_BAR;
    if constexpr (Epi::AFTER_DRAIN) { E.fused(acc, cur, wr, wc, fr, fq, lds, wid, lane); S.done(cur); }
#undef PG8_SA
#undef PG8_SELA
#undef PG8_SELB
#undef PG8_SB
#undef PG8_STAGE
#undef PG8_LDA
#undef PG8_LDB
#undef PG8_MMA
#undef PG8_WAIT_V
#undef PG8_WAIT_L
#undef PG8_BAR
#undef PG8_SCHED
}
}

#include <hip/hip_bf16.h>
#include <cmath>
namespace attn_body {
using bf16=__hip_bfloat16;
using bf16x8=__attribute__((ext_vector_type(8)))short;
using s16x4=__attribute__((ext_vector_type(4)))short;
using f32x16=__attribute__((ext_vector_type(16)))float;
using u32x4=__attribute__((ext_vector_type(4)))unsigned;
constexpr int BATCH=16,NHEAD=8,SEQ=2048,D=64,DM=NHEAD*D;
constexpr int NW=8,QBLK=32,QB=QBLK*NW,KVBLK=64,NQB=SEQ/QB;
constexpr int ATTN_PITCH=DM, ATTN_UNIT_ROWS=QB;
__device__ __forceinline__ int crow(int r,int hi){return (r&3)+8*(r>>2)+4*hi;}
#define SBAR() __builtin_amdgcn_sched_barrier(0)
__device__ __forceinline__ void cmask(f32x16&p0,f32x16&p1,int jb,int qrel,int hi){
  const float NEG=-INFINITY; int kb=64*jb+4*hi;
  #pragma unroll
  for(int r=0;r<16;++r){int kv=kb+(r&3)+8*(r>>2); if(kv>qrel)p0[r]=NEG; if(kv+32>qrel)p1[r]=NEG;}
}

constexpr int NSLOT=3, SLOTB=8192;
constexpr int LDS_K=0, LDS_V=NSLOT*SLOTB, LDS_WS=2*NSLOT*SLOTB, LDS_OST=LDS_WS+NW*64*4, LDS_F=LDS_OST+NW*4096, LDS_FW=LDS_F+SEQ*4, LDS_BYTES=LDS_FW+64;
constexpr float C2=0.125f*1.4426950408889634f;
__device__ __forceinline__ void glds16(const void*gsrc,unsigned lds_dst){unsigned keep;
  asm volatile("s_mov_b32 %0, m0\n\ts_mov_b32 m0, %2\n\ts_nop 0\n\tglobal_load_lds_dwordx4 %1, off\n\ts_mov_b32 m0, %0":"=&s"(keep):"v"(gsrc),"s"(lds_dst):"memory");}
__device__ __forceinline__ float max3f(float a,float b,float c){float r;asm("v_max3_f32 %0, %1, %2, %3":"=v"(r):"v"(a),"v"(b),"v"(c));return r;}
__device__ __forceinline__ float max2f(float a,float b){float r;asm("v_max_f32_e32 %0, %1, %2":"=v"(r):"v"(a),"v"(b));return r;}
__device__ __forceinline__ float fadd_s(float a,float b){float r;asm("v_add_f32_e32 %0, %1, %2":"=v"(r):"v"(a),"v"(b));return r;}
__device__ __forceinline__ float fsub_s(float a,float b){float r;asm("v_sub_f32_e32 %0, %1, %2":"=v"(r):"v"(a),"v"(b));return r;}
typedef float f32x2_t __attribute__((ext_vector_type(2))); typedef __bf16 bf16x2_t __attribute__((ext_vector_type(2)));
__device__ __forceinline__ unsigned cvtpk_s(float lo,float hi){f32x2_t v={lo,hi};bf16x2_t b=__builtin_convertvector(v,bf16x2_t);return __builtin_bit_cast(unsigned,b);}
#define WAIT_BAR(N) asm volatile("s_waitcnt vmcnt(" #N ") lgkmcnt(0)\n\ts_barrier":::"memory")

__device__ __forceinline__ void qkt(f32x16&p0,f32x16&p1,const char*Kslot,const bf16x8*qr,const f32x16&negm,int r32,int hi){
  const char*kb=Kslot+hi*1024+r32*16;
  #pragma unroll
  for(int d0=0;d0<4;++d0){
    const bf16x8 b0=*reinterpret_cast<const bf16x8*>(kb+d0*2048);
    const bf16x8 b1=*reinterpret_cast<const bf16x8*>(kb+d0*2048+512);
    if(d0==0){p0=__builtin_amdgcn_mfma_f32_32x32x16_bf16(b0,qr[0],negm,0,0,0);p1=__builtin_amdgcn_mfma_f32_32x32x16_bf16(b1,qr[0],negm,0,0,0);}
    else{p0=__builtin_amdgcn_mfma_f32_32x32x16_bf16(b0,qr[d0],p0,0,0,0);p1=__builtin_amdgcn_mfma_f32_32x32x16_bf16(b1,qr[d0],p1,0,0,0);}}
}
typedef __attribute__((address_space(3))) const char* lds_cptr;
typedef short v4i16_t __attribute__((ext_vector_type(4)));
__device__ __forceinline__ void kload8(bf16x8*kf,lds_cptr kp){
  kf[0]=*(const __attribute__((address_space(3))) bf16x8*)(kp);      kf[1]=*(const __attribute__((address_space(3))) bf16x8*)(kp+512);
  kf[2]=*(const __attribute__((address_space(3))) bf16x8*)(kp+2048); kf[3]=*(const __attribute__((address_space(3))) bf16x8*)(kp+2560);
  kf[4]=*(const __attribute__((address_space(3))) bf16x8*)(kp+4096); kf[5]=*(const __attribute__((address_space(3))) bf16x8*)(kp+4608);
  kf[6]=*(const __attribute__((address_space(3))) bf16x8*)(kp+6144); kf[7]=*(const __attribute__((address_space(3))) bf16x8*)(kp+6656);
}
__device__ __forceinline__ void kload2(bf16x8*kf,lds_cptr kp,int j){ kf[2*j]=*(const __attribute__((address_space(3))) bf16x8*)(kp+j*2048); kf[2*j+1]=*(const __attribute__((address_space(3))) bf16x8*)(kp+j*2048+512); }
__device__ __forceinline__ s16x4 vtr(lds_cptr p){ return __builtin_bit_cast(s16x4,__builtin_amdgcn_ds_read_tr16_b64_v4i16((__attribute__((address_space(3))) v4i16_t*)p)); }
__device__ __forceinline__ float rowmax(const f32x16&p0,const f32x16&p1){
  float a=max3f(p0[0],p0[1],p1[0]),b=max3f(p0[2],p0[3],p1[1]);a=max3f(a,p1[2],p1[3]);
  #pragma unroll
  for(int r=4;r<16;r+=4){a=max3f(a,p0[r],p0[r+1]);b=max3f(b,p0[r+2],p0[r+3]);a=max3f(a,p1[r],p1[r+1]);b=max3f(b,p1[r+2],p1[r+3]);}
  const float m=max2f(a,b);
  auto rr=__builtin_amdgcn_permlane32_swap(__float_as_uint(m),__float_as_uint(m),false,false);
  return max2f(__uint_as_float(rr[0]),__uint_as_float(rr[1]));
}
__device__ __forceinline__ void pv(f32x16*o,int vb,bf16x8 pa0,bf16x8 pa1,bf16x8 pa2,bf16x8 pa3){
  #pragma unroll
  for(int d0=0;d0<2;++d0){s16x4 lo[4],hi[4];
    #pragma unroll
    for(int ks=0;ks<4;++ks){
      asm volatile("ds_read_b64_tr_b16 %0,%1 offset:%c2":"=&v"(lo[ks]):"v"(vb),"i"(d0*4096+ks*1024):"memory");
      asm volatile("ds_read_b64_tr_b16 %0,%1 offset:%c2":"=&v"(hi[ks]):"v"(vb),"i"(d0*4096+ks*1024+512):"memory");}
    asm volatile("s_waitcnt lgkmcnt(0)":::"memory");SBAR();
    #define PK(k) (bf16x8){lo[k][0],lo[k][1],lo[k][2],lo[k][3],hi[k][0],hi[k][1],hi[k][2],hi[k][3]}
    o[d0]=__builtin_amdgcn_mfma_f32_32x32x16_bf16(pa0,PK(0),o[d0],0,0,0);
    o[d0]=__builtin_amdgcn_mfma_f32_32x32x16_bf16(pa1,PK(1),o[d0],0,0,0);
    o[d0]=__builtin_amdgcn_mfma_f32_32x32x16_bf16(pa2,PK(2),o[d0],0,0,0);
    o[d0]=__builtin_amdgcn_mfma_f32_32x32x16_bf16(pa3,PK(3),o[d0],0,0,0);
    #undef PK
  }
}

#ifndef ATTN_STORE16
#define ATTN_STORE16(p,v) (*(u32x4*)(p)=(v))
#endif
typedef float f32x4v __attribute__((ext_vector_type(4)));
__device__ __forceinline__ float logsig(float x){ return fminf(x,0.f)-__logf(1.f+__expf(-fabsf(x))); }
template<int THRL> __device__ __forceinline__ void attn_unit(int b,int h,int qb,const bf16*Q,const bf16*__restrict__ K,const bf16*__restrict__ V,bf16*O,char*shm,const float*__restrict__ flog,float bfh,bool newbh){
  int tid_=threadIdx.x; asm volatile("":"+v"(tid_)); const int tid=tid_,lane=tid&63,r32=lane&31,hi=lane>>5; const int wid=__builtin_amdgcn_readfirstlane(tid>>6);
  const long rowbase=(long)b*SEQ; const int q0=qb*QB;
  const bf16*Qw=Q+(rowbase+q0+wid*QBLK)*DM+h*D;
  const bf16*Kh=K+rowbase*DM+h*D,*Vh=V+rowbase*DM+h*D;
  const unsigned lds0=(unsigned)(uintptr_t)shm;
  float*wsf=(float*)(shm+LDS_WS)+wid*64;
  const bf16*ksrc=Kh+(long)lane*DM+wid*8;
  const bf16*vsrc=Vh+(long)(16*(wid&3)+(lane>>2))*DM+(wid>>2)*32+(lane&3)*8;
  const unsigned kdst=lds0+LDS_K+wid*1024, vdst=lds0+LDS_V+wid*1024;
  #define DMA_K(t,slot) glds16(ksrc+(long)(t)*KVBLK*DM,(unsigned)__builtin_amdgcn_readfirstlane(kdst+(slot)))
  #define DMA_V(t,slot) glds16(vsrc+(long)(t)*KVBLK*DM,(unsigned)__builtin_amdgcn_readfirstlane(vdst+(slot)))
  const int vb0=(int)(lds0+LDS_V)+((lane>>4)&1)*32+(lane&3)*8+(4*hi+((lane&15)>>2))*64;
  const char*Kbase=shm+LDS_K; bf16x8 kf[8];
  const lds_cptr shm3=(lds_cptr)shm; const lds_cptr kp0=shm3+LDS_K+hi*1024+r32*16; const lds_cptr vp0=shm3+LDS_V+((lane>>4)&1)*32+(lane&3)*8+(4*hi+((lane&15)>>2))*64;
  const int NT=(q0+QB)/KVBLK;
  typedef __attribute__((address_space(3))) float* lds_fptr;
  const lds_fptr fs3=(lds_fptr)(shm3+LDS_F); const lds_fptr fw3=(lds_fptr)(shm3+LDS_FW);
  if(newbh){ float v0=0.f,v1=0.f,v2=0.f,v3=0.f; const int t0=4*tid;
    { const float*fp=flog+(rowbase+t0)*NHEAD+h; v0=logsig(fp[0]+bfh); v1=logsig(fp[NHEAD]+bfh); v2=logsig(fp[2*NHEAD]+bfh); v3=logsig(fp[3*NHEAD]+bfh); }
    v1+=v0; v2+=v1; v3+=v2; float inc=v3;
    #pragma unroll
    for(int o=1;o<64;o<<=1){ const float nb=__shfl_up(inc,o); if(lane>=o)inc+=nb; }
    if(lane==63)fw3[wid]=inc;
    asm volatile("s_waitcnt lgkmcnt(0)\n\ts_barrier":::"memory");
    float woff=0.f;
    #pragma unroll
    for(int w_=0;w_<NW;++w_){ const float tw=fw3[w_]; if(w_<wid)woff+=tw; }
    const float ex=woff+(inc-v3); const float L2E=1.4426950408889634f;
    *(__attribute__((address_space(3))) f32x4v*)(fs3+t0)=(f32x4v){(v0+ex)*L2E,(v1+ex)*L2E,(v2+ex)*L2E,(v3+ex)*L2E};
    asm volatile("s_waitcnt lgkmcnt(0)\n\ts_barrier":::"memory"); }
  const float fq2=fs3[q0+wid*QBLK+r32];
  #define FKSUB(P0,P1,t) do{ const lds_fptr fk_=fs3+(t)*KVBLK+4*hi; \
    _Pragma("unroll") for(int r_=0;r_<16;++r_){ P0[r_]+=nq; P1[r_]+=nq; } \
    _Pragma("unroll") for(int j_=0;j_<4;++j_){ { const f32x4v a_=*(const __attribute__((address_space(3))) f32x4v*)(fk_+8*j_); \
      _Pragma("unroll") for(int i_=0;i_<4;++i_) P0[4*j_+i_]-=a_[i_]; } SBAR(); \
      { const f32x4v b_=*(const __attribute__((address_space(3))) f32x4v*)(fk_+32+8*j_); \
      _Pragma("unroll") for(int i_=0;i_<4;++i_) P1[4*j_+i_]-=b_[i_]; } SBAR(); } }while(0)
  #define INITRD(P0,P1,tt) do{ const lds_fptr fk_=fs3+(tt)*KVBLK+4*hi; \
    _Pragma("unroll") for(int j_=0;j_<4;++j_){ const f32x4v a_=*(const __attribute__((address_space(3))) f32x4v*)(fk_+8*j_); const f32x4v b_=*(const __attribute__((address_space(3))) f32x4v*)(fk_+32+8*j_); \
      _Pragma("unroll") for(int i_=0;i_<4;++i_){ P0[4*j_+i_]=a_[i_]; P1[4*j_+i_]=b_[i_]; } } }while(0)
  #define INITSUB(P0,P1) do{ _Pragma("unroll") for(int r_=0;r_<16;++r_){ P0[r_]=nq-P0[r_]; P1[r_]=nq-P1[r_]; } }while(0)
  DMA_K(0,0);DMA_V(0,0);DMA_K(1,SLOTB);
  bf16x8 qr[4];
  #pragma unroll
  for(int d0=0;d0<4;++d0)qr[d0]=*reinterpret_cast<const bf16x8*>(&Qw[(long)r32*DM+d0*16+hi*8]);
  float mhat=0.f,l_reg=0.f;f32x16 o[2];o[0]=f32x16{};o[1]=f32x16{};const f32x16 negm=f32x16{}; float nq=fq2;
  const int qrel=wid*QBLK+r32;
  #define CMASK(P0,P1,t) do{int jb_=(t)-(NT-4); if(jb_>=0)cmask(P0,P1,jb_,qrel,hi);}while(0)
  bool resc=false;
  #define START(P0,P1) do{ const float rm=rowmax(P0,P1); resc=false; \
    { const float dl=max2f(rm,0.f); mhat=fadd_s(mhat,dl);     \
      _Pragma("unroll") for(int r=0;r<16;++r){P0[r]=fsub_s(P0[r],dl);P1[r]=fsub_s(P1[r],dl);} \
      nq=fq2-mhat; } \
    _Pragma("unroll") for(int r=0;r<16;++r)P0[r]=__builtin_amdgcn_exp2f(P0[r]); }while(0)
  #define RESC() do{ if(resc){ asm volatile("s_waitcnt lgkmcnt(0)":::"memory"); \
      _Pragma("unroll") for(int d_=0;d_<2;++d_) _Pragma("unroll") for(int r=0;r<16;++r)o[d_][r]*=wsf[crow(r,hi)]; } }while(0)
  f32x16 pA0,pA1,pB0,pB1;
  int sl_prev=0,sl_cur=0,sl_next=SLOTB;
  #define ROT() do{sl_prev=sl_cur;sl_cur=sl_next;sl_next=(sl_next==(NSLOT-1)*SLOTB)?0:sl_next+SLOTB;}while(0)
  DMA_K(2,2*SLOTB);
  WAIT_BAR(3);
  qkt(pA0,pA1,Kbase,qr,negm,r32,hi);asm volatile("s_nop 15\n\ts_nop 7":"+v"(pA0),"+v"(pA1));FKSUB(pA0,pA1,0);CMASK(pA0,pA1,0);
  START(pA0,pA1);
  _Pragma("unroll") for(int r=0;r<16;++r)pA1[r]=__builtin_amdgcn_exp2f(pA1[r]);
  INITRD(pB0,pB1,1); INITSUB(pB0,pB1);
  WAIT_BAR(0);
  DMA_K(3,0);DMA_V(1,SLOTB);
  ROT();
  kload8(kf,kp0+sl_cur);
  WAIT_BAR(2);
  s16x4 vlo[8],vhi[8]; u32x4 pw0,pw1,pw2,pw3;
  #define PKW(P,B) cvtpk_s(P[B],P[B+1])
  #define PAF(k) __builtin_bit_cast(bf16x8,pw##k)
  #define VFR(i) (bf16x8){vlo[i][0],vlo[i][1],vlo[i][2],vlo[i][3],vhi[i][0],vhi[i][1],vhi[i][2],vhi[i][3]}
  #define PIN(x) asm volatile("":"+v"(x))
  #define MX3(a,b,c) __builtin_fmaxf(__builtin_fmaxf((a),(b)),(c))
  #define GAPA(MF,A0,A1,A2,A3,W0,W1,PW) do{ MF; sacc+=A0; sacc+=A1; sacc+=A2; sacc+=A3; PIN(sacc); W0; W1; PIN(PW); SBAR(); }while(0)
  #define EX(v) __builtin_amdgcn_exp2f(v)
  #define GAPB(MF,X,B) do{ MF; X[B]=EX(X[B]); X[B+1]=EX(X[B+1]); X[B+2]=EX(X[B+2]); X[B+3]=EX(X[B+3]); PIN(X); SBAR(); }while(0)
  #define VRD(i) do{ vlo[i]=vtr(vp_+(((i)>>2)*4096+((i)&3)*1024)); vhi[i]=vtr(vp_+(((i)>>2)*4096+((i)&3)*1024+512)); }while(0)
  #define KRD(G,j) do{ if(G){ kload2(kf,kp0+sl_next,j); SBAR(); } }while(0)
  #define STEP(C0,C1,P0,P1,t,GK,GV,GL) do{ SBAR(); \
    const lds_cptr vp_=vp0+sl_prev; \
    VRD(0); SBAR(); float sacc=(P0[0]+P0[1]); \
    GAPA(C0=__builtin_amdgcn_mfma_f32_32x32x16_bf16(kf[0],qr[0],C0,0,0,0), P0[2],P0[3],P0[4],P0[5],     pw0[0]=PKW(P0,0), pw0[1]=PKW(P0,2), pw0); \
    VRD(4); SBAR(); GAPA(C1=__builtin_amdgcn_mfma_f32_32x32x16_bf16(kf[1],qr[0],C1,0,0,0), P0[6],P0[7],P0[8],P0[9],     pw0[2]=PKW(P0,4), pw0[3]=PKW(P0,6), pw0); \
    VRD(1); SBAR(); GAPA(C0=__builtin_amdgcn_mfma_f32_32x32x16_bf16(kf[2],qr[1],C0,0,0,0),   P0[10],P0[11],P0[12],P0[13], pw1[0]=PKW(P0,8), pw1[1]=PKW(P0,10), pw1); \
    VRD(5); SBAR(); GAPA(C1=__builtin_amdgcn_mfma_f32_32x32x16_bf16(kf[3],qr[1],C1,0,0,0),   P0[14],P0[15],P1[0],P1[1],   pw1[2]=PKW(P0,12),pw1[3]=PKW(P0,14), pw1); \
    VRD(2); SBAR(); GAPA(C0=__builtin_amdgcn_mfma_f32_32x32x16_bf16(kf[4],qr[2],C0,0,0,0),   P1[2],P1[3],P1[4],P1[5],     pw2[0]=PKW(P1,0), pw2[1]=PKW(P1,2), pw2); \
    VRD(6); SBAR(); GAPA(C1=__builtin_amdgcn_mfma_f32_32x32x16_bf16(kf[5],qr[2],C1,0,0,0),   P1[6],P1[7],P1[8],P1[9],     pw2[2]=PKW(P1,4), pw2[3]=PKW(P1,6), pw2); \
    VRD(3); SBAR(); GAPA(C0=__builtin_amdgcn_mfma_f32_32x32x16_bf16(kf[6],qr[3],C0,0,0,0),   P1[10],P1[11],P1[12],P1[13], pw3[0]=PKW(P1,8), pw3[1]=PKW(P1,10), pw3); \
    VRD(7); SBAR(); GAPA(C1=__builtin_amdgcn_mfma_f32_32x32x16_bf16(kf[7],qr[3],C1,0,0,0),   P1[14],P1[15],0.f,0.f,       pw3[2]=PKW(P1,12),pw3[3]=PKW(P1,14), pw3); \
    l_reg+=sacc; \
    if(GK){DMA_K((t)+3,sl_cur);} if(GV){DMA_V((t)+1,sl_next);} \
    CMASK(C0,C1,t); \
    { float a=MX3(C0[0],C0[1],C1[0]),b=MX3(C0[2],C0[3],C1[1]); a=MX3(a,C1[2],C1[3]); \
      _Pragma("unroll") for(int r=4;r<16;r+=4){a=MX3(a,C0[r],C0[r+1]);b=MX3(b,C0[r+2],C0[r+3]);a=MX3(a,C1[r],C1[r+1]);b=MX3(b,C1[r+2],C1[r+3]);} \
      float rm=__builtin_fmaxf(a,b); { auto rr=__builtin_amdgcn_permlane32_swap(__float_as_uint(rm),__float_as_uint(rm),false,false); rm=__builtin_fmaxf(__uint_as_float(rr[0]),__uint_as_float(rr[1])); } \
      resc=false; \
      if(__builtin_expect(__any(rm>(float)THRL),0)){ const float dl=__builtin_fmaxf(rm,0.f); mhat+=dl; \
        _Pragma("unroll") for(int r=0;r<16;++r){C0[r]-=dl;C1[r]-=dl;} \
        nq=fq2-mhat; \
        const float f=__builtin_amdgcn_exp2f(-dl); l_reg*=f; if(hi==0)wsf[r32]=f; resc=true; } } \
    SBAR(); if(GL){INITRD(P0,P1,(t)+1);} SBAR(); \
    GAPB(o[0]=__builtin_amdgcn_mfma_f32_32x32x16_bf16(PAF(0),VFR(0),o[0],0,0,0), C0,0); \
    GAPB(o[1]=__builtin_amdgcn_mfma_f32_32x32x16_bf16(PAF(0),VFR(4),o[1],0,0,0), C0,4); \
    KRD(GL,0); GAPB(o[0]=__builtin_amdgcn_mfma_f32_32x32x16_bf16(PAF(1),VFR(1),o[0],0,0,0), C0,8); \
    KRD(GL,1); GAPB(o[1]=__builtin_amdgcn_mfma_f32_32x32x16_bf16(PAF(1),VFR(5),o[1],0,0,0), C0,12); \
    KRD(GL,2); GAPB(o[0]=__builtin_amdgcn_mfma_f32_32x32x16_bf16(PAF(2),VFR(2),o[0],0,0,0), C1,0); \
    KRD(GL,3); GAPB(o[1]=__builtin_amdgcn_mfma_f32_32x32x16_bf16(PAF(2),VFR(6),o[1],0,0,0), C1,4); \
    GAPB(o[0]=__builtin_amdgcn_mfma_f32_32x32x16_bf16(PAF(3),VFR(3),o[0],0,0,0), C1,8); \
    GAPB(o[1]=__builtin_amdgcn_mfma_f32_32x32x16_bf16(PAF(3),VFR(7),o[1],0,0,0), C1,12); \
    if(GL){INITSUB(P0,P1);} \
    }while(0)
  int t=1;
  #undef CMASK
  #define CMASK(P0,P1,t) do{}while(0)
  for(;t+5<NT;t+=2){
    STEP(pB0,pB1,pA0,pA1,t,true,true,true);     WAIT_BAR(2); RESC(); ROT();
    STEP(pA0,pA1,pB0,pB1,t+1,true,true,true);   WAIT_BAR(2); RESC(); ROT();
  }
  #undef CMASK
  #define CMASK(P0,P1,t) do{int jb_=(t)-(NT-4); if(jb_>=0)cmask(P0,P1,jb_,qrel,hi);}while(0)
  #define ENDW(tt) do{ if((tt)+3<NT){WAIT_BAR(2);} else if((tt)+2<NT){WAIT_BAR(1);} else {WAIT_BAR(0);} }while(0)
  for(;t+1<NT;t+=2){
    STEP(pB0,pB1,pA0,pA1,t,(t+3<NT),(t+1<NT),(t+1<NT));       ENDW(t);   RESC(); ROT();
    STEP(pA0,pA1,pB0,pB1,t+1,(t+4<NT),(t+2<NT),(t+2<NT));     ENDW(t+1); RESC(); ROT();
  }
  STEP(pB0,pB1,pA0,pA1,NT-1,false,false,false); RESC();
  { float sacc=pB0[0]+pB0[1]; _Pragma("unroll") for(int r=2;r<16;++r)sacc+=pB0[r]; _Pragma("unroll") for(int r=0;r<16;++r)sacc+=pB1[r]; l_reg+=sacc;
    pw0=(u32x4){PKW(pB0,0),PKW(pB0,2),PKW(pB0,4),PKW(pB0,6)};pw1=(u32x4){PKW(pB0,8),PKW(pB0,10),PKW(pB0,12),PKW(pB0,14)};pw2=(u32x4){PKW(pB1,0),PKW(pB1,2),PKW(pB1,4),PKW(pB1,6)};pw3=(u32x4){PKW(pB1,8),PKW(pB1,10),PKW(pB1,12),PKW(pB1,14)};
    SBAR(); pv(o,vb0+sl_cur,PAF(0),PAF(1),PAF(2),PAF(3)); }
  #undef PKW
  #undef PAF
  #undef VFR
  #undef PIN
  #undef MX3
  #undef GAPA
  #undef GAPB
  #undef EX
  #undef VRD
  #undef KRD
  #undef STEP
  #undef ENDW
  {auto rr=__builtin_amdgcn_permlane32_swap(__float_as_uint(l_reg),__float_as_uint(l_reg),false,false);l_reg=__uint_as_float(rr[0])+__uint_as_float(rr[1]);}
  if(hi==0)wsf[32+r32]=l_reg;asm volatile("s_waitcnt lgkmcnt(0)":::"memory");
  float rli[16];
  #pragma unroll
  for(int r=0;r<16;++r)rli[r]=__builtin_amdgcn_rcpf(wsf[32+crow(r,hi)]);
  bf16*Ow=O+(rowbase+q0+wid*QBLK)*DM+h*D;
  { bf16*stg=(bf16*)(shm+LDS_OST)+wid*2048;
    #pragma unroll
    for(int r=0;r<16;++r){const int orow=crow(r,hi);
      #pragma unroll
      for(int d0=0;d0<2;++d0)stg[orow*64+d0*32+r32]=__float2bfloat16(o[d0][r]*rli[r]);}
    asm volatile("s_waitcnt lgkmcnt(0)":::"memory");
    #pragma unroll
    for(int i=0;i<4;++i){const int row=i*8+(lane>>3),ch=lane&7; const u32x4 v=*(const u32x4*)(stg+row*64+ch*8); ATTN_STORE16(Ow+(long)row*DM+ch*8,v);} }
  asm volatile("s_waitcnt lgkmcnt(0)\n\ts_barrier":::"memory");
  #undef FKSUB
  #undef INITRD
  #undef INITSUB
  #undef DMA_K
  #undef DMA_V
  #undef CMASK
  #undef START
  #undef RESC
  #undef ROT
}
constexpr int ATTN_LDS_BYTES=LDS_BYTES;
struct AttnTensors { const bf16* Q; const bf16* K; const bf16* V; bf16* O; const float* flog; const float* bf; };
struct AttnUnit { int bh; int qb; };
struct StaticOrder {
  int vcu,G;
  __device__ __forceinline__ explicit StaticOrder(int grid,int v):vcu(v),G(grid){}
  __device__ __forceinline__ bool next(int i,AttnUnit&u)const{
    if(G==256){ if(i>=4)return false; const int s=vcu&1; u.bh=vcu>>1; u.qb=(i==0)?7-s:(i==1)?4+s:(i==2)?3-s:s; return true; }
    const int idx=i*G+vcu; if(idx>=BATCH*NHEAD*NQB)return false; u.bh=idx>>3; u.qb=7-(idx&7); return true; }
  __device__ __forceinline__ void a_ready(const AttnUnit&)const{}
  __device__ __forceinline__ void done(const AttnUnit&)const{}
};
template<class Sched,int THRL=8> __device__ __forceinline__ void attn_phase(char*lds,const AttnTensors&T,const Sched&S){
  AttnUnit u; int prevbh=-1;
  for(int i=0;S.next(i,u);++i){ S.a_ready(u); attn_unit<THRL>(u.bh/NHEAD,u.bh%NHEAD,u.qb,T.Q,T.K,T.V,T.O,lds,T.flog,T.bf[u.bh%NHEAD],u.bh!=prevbh); prevbh=u.bh; S.done(u); }
}
#undef SBAR
#undef WAIT_BAR
}
namespace cg = cooperative_groups;
constexpr int NWAVES = 8;
constexpr int BATCH = 16, SEQ = 2048, DMODEL = 1024, MROWS = BATCH * SEQ, NHEADS = 8, AW = 512, FFH = 2816, NIN = 6912, NINSRC = 6664, DEPTH = 2;
constexpr size_t MiB = 1u << 20, KiB512 = 512u << 10;
constexpr size_t WS_SSQ = 0;
constexpr size_t WS_FLOG = 3 * MiB;
constexpr size_t WS_WIN = 4 * MiB;
constexpr size_t WS_WL = 18 * MiB, WL_STRIDE = 21 * MiB + MiB / 2;
constexpr size_t WL_A = 0, WL_B = 1 * MiB, WL_C = 2 * MiB, WL_OUT = 3 * MiB, WL_GU = 5 * MiB, WL_DN = 16 * MiB;
constexpr size_t WS_XB = 61 * MiB;
constexpr size_t WS_QA = 125 * MiB, WS_K = 157 * MiB, WS_V = 189 * MiB, WS_MIX = 157 * MiB;
constexpr size_t WS_U = 221 * MiB, WS_Z = 253 * MiB, WS_CB = 285 * MiB, WS_G = 317 * MiB;
constexpr size_t WS_ACT = 125 * MiB;
constexpr size_t WS_END = 509 * MiB;
static_assert(WS_K == WS_QA + 32 * MiB && WS_V == WS_QA + 64 * MiB && WS_U == WS_QA + 96 * MiB && WS_Z == WS_QA + 128 * MiB && WS_CB == WS_QA + 160 * MiB, "EpiIn addresses Q|K|V|U|Z|CB as six consecutive blocks");
static_assert(WS_WL + 2 * WL_STRIDE <= WS_XB && WS_G + (size_t)MROWS * 3072 * 2 <= WS_END && WS_ACT + (size_t)MROWS * FFH * 2 <= WS_G, "d_ws map");
constexpr int RING_BYTES = 131072, LDS_BYTES = 147456;

#define GAS __attribute__((address_space(1)))
#define LAS __attribute__((address_space(3)))
typedef unsigned short bf16;
typedef unsigned v4u __attribute__((ext_vector_type(4)));
typedef float f32x4 __attribute__((ext_vector_type(4)));
#define LDS_WAIT() asm volatile("s_waitcnt lgkmcnt(0)" ::: "memory")
__device__ __forceinline__ unsigned f2bf(float f) { unsigned u = __builtin_bit_cast(unsigned, f); return (u + 0x7fffu + ((u >> 16) & 1u)) >> 16; }
typedef float f32x2f_t __attribute__((ext_vector_type(2))); typedef __bf16 bf16x2f_t __attribute__((ext_vector_type(2)));
__device__ __forceinline__ unsigned pk2(float lo, float hi) { const f32x2f_t v = {lo, hi}; const bf16x2f_t b = __builtin_convertvector(v, bf16x2f_t); return __builtin_bit_cast(unsigned, b); }
__device__ __forceinline__ float wave_sum(float v) {
#pragma unroll
    for (int o = 1; o < 64; o <<= 1) v += __shfl_xor(v, o);
    return v;
}
struct CmId { __device__ __forceinline__ int operator()(int n) const { return n; } };
struct CmIn { __device__ __forceinline__ int operator()(int n) const {
    if (n < 1536) return n;
    if (n < 2048) return n + 8;
    if (n < 3072) { const int j = (n - 2048) >> 8, w = (n - 2048) & 255; return w < 128 ? 2056 + 128 * j + w : 3080 + 128 * j + (w - 128); }
    if (n < 3584) return 2568 + (n - 3072);
    if (n < 6656) return n + 8;
    if (n < 6664) return 1536 + (n - 6656);
    return -1; } };
struct CmGU { __device__ __forceinline__ int operator()(int n) const { const int j = n >> 8, w = n & 255; return w < 128 ? 128 * j + w : FFH + 128 * j + (w - 128); } };
__device__ __forceinline__ void wb_item(const float* pool_w, const float* pscale, const float* wpp, bf16* WBt, int item, int lane) {
    const int nb = (item >> 3) & 15, c8 = (item & 7) + 8 * (item >> 7), n = 64 * nb + lane, c0 = 8 * c8, g = c0 >> 7, cl = c0 & 127;
    float a0 = 0.f, a1 = 0.f, a2 = 0.f, a3 = 0.f, a4 = 0.f, a5 = 0.f, a6 = 0.f, a7 = 0.f;
    const float* pw = pool_w + ((size_t)g * 128 + cl) * 128;
#pragma unroll 2
    for (int d = 0; d < 128; d += 4) {
        const f32x4 ps = *(const GAS f32x4*)(pscale + g * 128 + d);
        const float w0 = wpp[(size_t)(g * 128 + d) * 1024 + n] * ps[0], w1 = wpp[(size_t)(g * 128 + d + 1) * 1024 + n] * ps[1], w2 = wpp[(size_t)(g * 128 + d + 2) * 1024 + n] * ps[2], w3 = wpp[(size_t)(g * 128 + d + 3) * 1024 + n] * ps[3];
#define WB_ROW(acc_, j_) { const f32x4 p_ = *(const GAS f32x4*)(pw + (j_) * 128 + d); acc_ += (p_[0] * w0 + p_[1] * w1) + (p_[2] * w2 + p_[3] * w3); }
        WB_ROW(a0, 0) WB_ROW(a1, 1) WB_ROW(a2, 2) WB_ROW(a3, 3) WB_ROW(a4, 4) WB_ROW(a5, 5) WB_ROW(a6, 6) WB_ROW(a7, 7)
#undef WB_ROW
    }
    v4u o; o.x = pk2(a0, a1); o.y = pk2(a2, a3); o.z = pk2(a4, a5); o.w = pk2(a6, a7);
    *(GAS v4u*)(WBt + (size_t)n * 512 + c0) = o;
}

struct Args { const float* in[16]; float* out; unsigned char* ws; int ph_lo, ph_hi; };
#define XB_TMO      128
#define XB_XCNT(j)  (256  + 64 * (j))
#define XB_XSUB(j)  (1280 + 64 * (j))
#define XB_XGEN(j)  (2304 + 64 * (j))
#define XB_TOP      3328
#define XB_TOPGEN   3392
#define XCD_BAR_WORDS 3456
#define XB_SPIN_CAP (1u << 18)

__device__ __forceinline__ unsigned xb_ld(unsigned* p)              { return __hip_atomic_load(p, __ATOMIC_RELAXED, __HIP_MEMORY_SCOPE_AGENT); }
__device__ __forceinline__ unsigned xb_add(unsigned* p, unsigned v) { return __hip_atomic_fetch_add(p, v, __ATOMIC_RELAXED, __HIP_MEMORY_SCOPE_AGENT); }
__device__ __forceinline__ unsigned xb_xcc_id() { return (unsigned)__builtin_amdgcn_s_getreg((3 << 11) | 20) & 0xFu; }
#define XB_SPIN(cond, bar) do { unsigned _sp = 0; while (cond) { __builtin_amdgcn_s_sleep(1); \
    if ((++_sp & 255u) == 0u) { if (xb_ld(&(bar)[XB_TMO])) break; if (_sp > XB_SPIN_CAP) { atomicAdd(&(bar)[XB_TMO], 1u); break; } } } } while (0)

struct XcdBarrier {
    unsigned* bar; unsigned x;
    volatile LAS unsigned* st;
};

__device__ __forceinline__ XcdBarrier xcd_barrier_post(unsigned* bar, volatile LAS unsigned* st) {
    XcdBarrier b; b.bar = bar; b.x = xb_xcc_id(); b.st = st;
    if (threadIdx.x == 0) (void)xb_add(&bar[XB_XCNT(b.x)], 1u);
    return b;
}
__device__ __forceinline__ void xcd_barrier_complete(unsigned* bar, unsigned x, unsigned& nloc, unsigned& nx) {
    const unsigned G = gridDim.x * gridDim.y * gridDim.z;
    unsigned sum, cnt, mine, sp = 0u;
    for (;;) {
        sum = 0u; cnt = 0u; mine = 0u;
#pragma unroll
        for (unsigned j = 0; j < 16; ++j) { const unsigned c = xb_ld(&bar[XB_XCNT(j)]); sum += c; cnt += (c > 0u) ? 1u : 0u; mine = (j == x) ? c : mine; }
        if (sum == G) break;
        __builtin_amdgcn_s_sleep(1);
        if ((++sp & 255u) == 0u) { if (xb_ld(&bar[XB_TMO])) break; if (sp > XB_SPIN_CAP) { atomicAdd(&bar[XB_TMO], 1u); break; } }
    }
    nloc = mine > 0u ? mine : 1u; nx = cnt > 0u ? cnt : 1u;
}

__device__ __forceinline__ void xcd_barrier(const XcdBarrier& b) {
    asm volatile("s_waitcnt vmcnt(0)" ::: "memory");
    __syncthreads();
    if (threadIdx.x == 0) {
        unsigned* bar = b.bar;
        __builtin_amdgcn_s_waitcnt(0);
        unsigned nloc = b.st[0], nx = b.st[1];
        if (nloc == 0u) { xcd_barrier_complete(bar, b.x, nloc, nx); b.st[0] = nloc; b.st[1] = nx; }
        const unsigned old = xb_add(&bar[XB_XSUB(b.x)], 1u);
        const unsigned gen = old / nloc;
        if (old + 1u == (gen + 1u) * nloc) {
            __builtin_amdgcn_fence(__ATOMIC_RELEASE, "agent");
            asm volatile("s_waitcnt vmcnt(0)" ::: "memory");
            const unsigned og = xb_add(&bar[XB_TOP], 1u);
            const unsigned tg = og / nx;
            if (og + 1u == (tg + 1u) * nx) xb_add(&bar[XB_TOPGEN], 1u);
            else XB_SPIN(xb_ld(&bar[XB_TOPGEN]) == tg, bar);
            __builtin_amdgcn_fence(__ATOMIC_ACQUIRE, "agent");
            xb_add(&bar[XB_XGEN(b.x)], 1u);
            asm volatile("s_waitcnt vmcnt(0)" ::: "memory");
        } else {
            XB_SPIN(xb_ld(&bar[XB_XGEN(b.x)]) == gen, bar);
            __builtin_amdgcn_fence(__ATOMIC_ACQUIRE, "agent");
            asm volatile("s_waitcnt vmcnt(0)" ::: "memory");
        }
    }
    __syncthreads();
}

constexpr size_t WS_BAR = 2 * MiB + 512 * 1024;
constexpr int BARLDS_OFF = RING_BYTES;
#ifndef REP_SEAM
#define REP_SEAM 1
#endif
#define GRID_SEAM() for (int rs_ = 0; rs_ < REP_SEAM; ++rs_) xcd_barrier(bar)

struct TrD { const float* W; const float* kscale; bf16* WT; int ldw, K, nblk, cmk, item; };
__device__ __forceinline__ void tr_desc(const Args& a, int it, TrD& d) {
    constexpr int I_IN = 16 * (NIN / 32), I_A = 8 * 32, I_OUT = 16 * 32, I_GU = 16 * (2 * FFH / 32), I_DN = (FFH / 64) * 32, PER_TR = I_IN + 2 * I_A + I_OUT + I_GU + I_DN;
    const int l = it / PER_TR; int r = it - l * PER_TR; unsigned char* wl = a.ws + WS_WL + (size_t)l * WL_STRIDE;
    d.kscale = nullptr; d.cmk = 0; d.ldw = 1024; d.nblk = 32;
    if (r < I_IN) { d.W = a.in[2] + (size_t)l * 1024 * NINSRC; d.ldw = NINSRC; d.K = 1024; d.WT = (l == 0) ? (bf16*)(a.ws + WS_WIN) : (bf16*)((unsigned char*)a.out + 64 * MiB); d.nblk = NIN / 32; d.kscale = a.in[1] + l * 1024; d.cmk = 1; d.item = r; return; } r -= I_IN;
    if (r < I_A) { d.W = a.in[5] + (size_t)l * 512 * 1024; d.K = 512; d.WT = (bf16*)(wl + WL_A); d.item = r; return; } r -= I_A;
    if (r < I_A) { d.W = a.in[10] + (size_t)l * 512 * 1024; d.K = 512; d.WT = (bf16*)(wl + WL_C); d.item = r; return; } r -= I_A;
    if (r < I_OUT) { d.W = a.in[11] + (size_t)l * 1024 * 1024; d.K = 1024; d.WT = (bf16*)(wl + WL_OUT); d.item = r; return; } r -= I_OUT;
    if (r < I_GU) { d.W = a.in[13] + (size_t)l * 1024 * 2 * FFH; d.ldw = 2 * FFH; d.K = 1024; d.WT = (bf16*)(wl + WL_GU); d.nblk = 2 * FFH / 32; d.kscale = a.in[12] + l * 1024; d.cmk = 2; d.item = r; return; } r -= I_GU;
    d.W = a.in[14] + (size_t)l * FFH * 1024; d.K = FFH; d.WT = (bf16*)(wl + WL_DN); d.item = r;
}
__device__ __forceinline__ void tr_load(const TrD& d, int lane, f32x4 (&v)[8]) {
    const int kb = d.item / d.nblk, nb = d.item % d.nblk, k0 = 64 * kb, n0 = 32 * nb, c4 = lane & 7, rr = lane >> 3, nd = n0 + 4 * c4;
    const int sc = d.cmk == 1 ? CmIn()(nd) : (d.cmk == 2 ? CmGU()(nd) : nd);
#pragma unroll
    for (int i = 0; i < 8; ++i) { const int k = k0 + 8 * i + rr; v[i] = (f32x4){0.f, 0.f, 0.f, 0.f}; if (sc >= 0) v[i] = *(const GAS f32x4*)(d.W + (size_t)k * d.ldw + sc); if (d.kscale) v[i] = v[i] * d.kscale[k]; }
}
__device__ __forceinline__ void tr_store(const TrD& d, int lane, const f32x4 (&v)[8], LAS float* scr) {
    const int kb = d.item / d.nblk, nb = d.item % d.nblk, k0 = 64 * kb, n0 = 32 * nb, c4 = lane & 7, rr = lane >> 3;
#pragma unroll
    for (int i = 0; i < 8; ++i) { LAS float* p = scr + (8 * i + rr) * 33 + 4 * c4; p[0] = v[i][0]; p[1] = v[i][1]; p[2] = v[i][2]; p[3] = v[i][3]; }
    LDS_WAIT(); asm volatile("" ::: "memory");
    const int c = lane & 7;
#pragma unroll
    for (int j = 0; j < 4; ++j) { const int n = (lane >> 3) + 8 * j; const LAS float* s = scr + (8 * c) * 33 + n;
        v4u o; o.x = pk2(s[0 * 33], s[1 * 33]); o.y = pk2(s[2 * 33], s[3 * 33]); o.z = pk2(s[4 * 33], s[5 * 33]); o.w = pk2(s[6 * 33], s[7 * 33]);
        *(GAS v4u*)(d.WT + (size_t)(n0 + n) * d.K + k0 + 8 * c) = o; }
    LDS_WAIT(); asm volatile("" ::: "memory");
}
__device__ __forceinline__ void convert_weights(const Args& a, LAS float* scr, int gw, int NGW, int lane, int mode, int lsel) {
    constexpr int I_IN = 16 * (NIN / 32), I_A = 8 * 32, I_OUT = 16 * 32, I_GU = 16 * (2 * FFH / 32), I_DN = (FFH / 64) * 32, PER_TR = I_IN + 2 * I_A + I_OUT + I_GU + I_DN, I_WB = 1024;
    static_assert(I_WB % 8 == 0, "wb_item: items 8k..8k+7 must be the eight waves of one workgroup");
    const int nwb = mode == 2 ? 0 : 2 * I_WB;
    for (int it = gw; it < nwb; it += NGW) { const int l = it / I_WB, r = it - l * I_WB; unsigned char* wl = a.ws + WS_WL + (size_t)l * WL_STRIDE;
        wb_item(a.in[6] + (size_t)l * 4 * 128 * 128, a.in[7] + l * 512, a.in[8] + (size_t)l * 512 * 1024, (bf16*)(wl + WL_B), r, lane); }
    constexpr int I_ACO = 2 * I_A + I_OUT, I_P = I_IN + I_GU, I_S = I_ACO + I_DN;
    const int ntr = mode == 0 ? 2 * PER_TR : (mode == 1 ? 2 * I_P : I_S);
#define TR_MAP(i_) (mode == 0 ? (i_) : (mode == 1 ? ((i_) / I_P) * PER_TR + (((i_) % I_P) < I_IN ? ((i_) % I_P) : ((i_) % I_P) + I_ACO) : lsel * PER_TR + I_IN + ((i_) < I_ACO ? (i_) : (i_) + I_GU)))
    int it = gw; bool h0 = it < ntr, h1 = it + NGW < ntr; TrD d0, d1, d2; f32x4 va[8], vb[8], vc[8];
    if (h0) { tr_desc(a, TR_MAP(it), d0); tr_load(d0, lane, va); }
    if (h1) { tr_desc(a, TR_MAP(it + NGW), d1); tr_load(d1, lane, vb); }
    while (h0) {
        const int it2 = it + 2 * NGW; const bool h2 = it2 < ntr;
        if (h2) { tr_desc(a, TR_MAP(it2), d2); tr_load(d2, lane, vc); }
        tr_store(d0, lane, va, scr);
        d0 = d1; d1 = d2; it += NGW; h0 = h1; h1 = h2;
#pragma unroll
        for (int i = 0; i < 8; ++i) { va[i] = vb[i]; vb[i] = vc[i]; }
    }
#undef TR_MAP
}

__device__ __forceinline__ void x_to_bf16(const Args& a, int gw, int NGW, int lane) {
    const float* x = a.in[0]; bf16* XB = (bf16*)(a.ws + WS_XB);
    const int per = (MROWS + NGW - 1) / NGW;
    for (int m0 = gw * per; m0 < MROWS && m0 < (gw + 1) * per; m0 += 4) {
        f32x4 v[4][4];
#pragma unroll
        for (int r = 0; r < 4; ++r)
#pragma unroll
            for (int j = 0; j < 4; ++j) v[r][j] = *((const GAS f32x4*)(x + (size_t)(m0 + r) * 1024) + lane + 64 * j);
#pragma unroll
        for (int r = 0; r < 4; ++r) { const int m = m0 + r; float s = 0.f;
#pragma unroll
            for (int j = 0; j < 4; ++j) s += (v[r][j].x * v[r][j].x + v[r][j].y * v[r][j].y) + (v[r][j].z * v[r][j].z + v[r][j].w * v[r][j].w);
            s = wave_sum(s);
            GAS unsigned long long* o8 = (GAS unsigned long long*)(XB + (size_t)m * 1024) + lane;
#pragma unroll
            for (int j = 0; j < 4; ++j) o8[64 * j] = (unsigned long long)pk2(v[r][j].x, v[r][j].y) | ((unsigned long long)pk2(v[r][j].z, v[r][j].w) << 32);
            if (lane < 20) { const int bufi = lane >> 2, slot = lane & 3; *(GAS float*)(a.ws + WS_SSQ + (size_t)bufi * KiB512 + ((size_t)slot * MROWS + m) * 4) = (lane == 0) ? s : 0.f; } }
    }
}

__device__ __forceinline__ void unpk8(const v4u w, float (&f)[8]) {
    f[0] = __uint_as_float(w.x << 16); f[1] = __uint_as_float(w.x & 0xffff0000u); f[2] = __uint_as_float(w.y << 16); f[3] = __uint_as_float(w.y & 0xffff0000u);
    f[4] = __uint_as_float(w.z << 16); f[5] = __uint_as_float(w.z & 0xffff0000u); f[6] = __uint_as_float(w.w << 16); f[7] = __uint_as_float(w.w & 0xffff0000u); }
__device__ __forceinline__ v4u pk8(const float (&f)[8]) { v4u o; o.x = pk2(f[0], f[1]); o.y = pk2(f[2], f[3]); o.z = pk2(f[4], f[5]); o.w = pk2(f[6], f[7]); return o; }

__device__ __forceinline__ void pool_conv_phase(const Args& a, int l, int vcu, int G, int tid) {
    const bf16* __restrict__ U = (const bf16*)(a.ws + WS_U); const bf16* __restrict__ Z = (const bf16*)(a.ws + WS_Z); const bf16* __restrict__ CB = (const bf16*)(a.ws + WS_CB);
    bf16* __restrict__ Dp = (bf16*)a.out; bf16* __restrict__ YC = (bf16*)a.out + (size_t)MROWS * 512;
    const float* cw = a.in[9] + (size_t)l * 3 * 512;
    const int cgp = tid & 63, seg = tid >> 6, ch = 8 * cgp, w = 2 << (cgp >> 4);
    float w0[8], w1[8], w2[8];
#pragma unroll
    for (int j = 0; j < 8; ++j) { w0[j] = cw[ch + j]; w1[j] = cw[512 + ch + j]; w2[j] = cw[1024 + ch + j]; }
    for (int chunk = vcu; chunk < MROWS / 128; chunk += G) {
        const int first = chunk * 128 + seg * 16, tb = first & (SEQ - 1);
        { float sum[8], uc[8], t8[8];
#pragma unroll
          for (int j = 0; j < 8; ++j) sum[j] = 0.f;
          for (int j = 1; j < w; ++j) if (tb - j >= 0) { unpk8(*(const GAS v4u*)(U + (size_t)(first - j) * 512 + ch), t8);
#pragma unroll
              for (int q = 0; q < 8; ++q) sum[q] += t8[q]; }
#pragma unroll
          for (int i = 0; i < 16; ++i) { const int row = first + i, t = tb + i;
              unpk8(*(const GAS v4u*)(U + (size_t)row * 512 + ch), uc);
              const float inv = 1.0f / (float)((t + 1) < w ? (t + 1) : w);
#pragma unroll
              for (int q = 0; q < 8; ++q) { sum[q] += uc[q]; t8[q] = sum[q] * inv - uc[q]; }
              *(GAS v4u*)(Dp + (size_t)row * 512 + ch) = pk8(t8);
              if (t - w + 1 >= 0) { unpk8(*(const GAS v4u*)(U + (size_t)(row - w + 1) * 512 + ch), t8);
#pragma unroll
                  for (int q = 0; q < 8; ++q) sum[q] -= t8[q]; } } }
        { float z2[8], z1[8], z0[8], cb[8], y[8];
#pragma unroll
          for (int q = 0; q < 8; ++q) { z2[q] = 0.f; z1[q] = 0.f; }
          if (tb >= 2) unpk8(*(const GAS v4u*)(Z + (size_t)(first - 2) * 512 + ch), z2);
          if (tb >= 1) unpk8(*(const GAS v4u*)(Z + (size_t)(first - 1) * 512 + ch), z1);
#pragma unroll
          for (int i = 0; i < 16; ++i) { const int row = first + i;
              unpk8(*(const GAS v4u*)(Z + (size_t)row * 512 + ch), z0); unpk8(*(const GAS v4u*)(CB + (size_t)row * 512 + ch), cb);
#pragma unroll
              for (int q = 0; q < 8; ++q) { y[q] = cb[q] * (w0[q] * z2[q] + w1[q] * z1[q] + w2[q] * z0[q]); z2[q] = z1[q]; z1[q] = z0[q]; }
              *(GAS v4u*)(YC + (size_t)row * 512 + ch) = pk8(y); } }
    }
}

__device__ __forceinline__ void final_norm_phase(const Args& a, int gw, int NGW, int lane) {
    float* out = a.out; const bf16* XB = (const bf16*)(a.ws + WS_XB); const float* ssq = (const float*)(a.ws + WS_SSQ + 4 * KiB512); const float* gn = a.in[15];
    f32x4 g4[2][2];
#pragma unroll
    for (int j = 0; j < 2; ++j) { g4[j][0] = *(const GAS f32x4*)(gn + 512 * j + 8 * lane); g4[j][1] = *(const GAS f32x4*)(gn + 512 * j + 8 * lane + 4); }
    v4u xc[2], xn[2]; float sc[4], sn[4];
#define FN_LOAD(xd, sd, m_) do { _Pragma("unroll") for (int j = 0; j < 2; ++j) xd[j] = *(const GAS v4u*)(XB + (size_t)(m_) * 1024 + 512 * j + 8 * lane); \
        _Pragma("unroll") for (int s = 0; s < 4; ++s) sd[s] = *(const GAS float*)(ssq + (size_t)s * MROWS + (m_)); } while (0)
    if (gw < MROWS) FN_LOAD(xc, sc, gw);
    for (int m = gw; m < MROWS; m += NGW) {
        const int mn = m + NGW;
        if (mn < MROWS) FN_LOAD(xn, sn, mn);
        const float rs = __builtin_amdgcn_rsqf(((sc[0] + sc[1]) + (sc[2] + sc[3])) * (1.0f / 1024.0f) + 1e-6f);
#pragma unroll
        for (int j = 0; j < 2; ++j) { float v[8]; unpk8(xc[j], v);
            GAS f32x4* o = (GAS f32x4*)(out + (size_t)m * 1024 + 512 * j + 8 * lane);
            o[0] = (f32x4){v[0], v[1], v[2], v[3]} * rs * g4[j][0]; o[1] = (f32x4){v[4], v[5], v[6], v[7]} * rs * g4[j][1]; }
#pragma unroll
        for (int j = 0; j < 2; ++j) xc[j] = xn[j];
#pragma unroll
        for (int s = 0; s < 4; ++s) sc[s] = sn[s];
    }
#undef FN_LOAD
}

__global__ void __launch_bounds__(NWAVES * 64, 2) fwd_megakernel(Args a) {
    extern __shared__ __attribute__((aligned(16))) unsigned char lds[];
    cg::grid_group grid = cg::this_grid();
    if (a.ph_lo < 0) grid.sync();
    LAS unsigned char* ldsl = (LAS unsigned char*)lds;
    const int G = gridDim.x, bx = blockIdx.x, vcu = (G % 8 == 0) ? (bx % 8) * (G / 8) + bx / 8 : bx, NGW = G * NWAVES;
#define FRESH_IDS() int tid_ = threadIdx.x; asm volatile("" : "+v"(tid_)); const int tid = tid_, lane = tid & 63, wave = __builtin_amdgcn_readfirstlane(tid >> 6), gw = vcu * NWAVES + wave; LAS float* scr = (LAS float*)(ldsl + wave * 16384); (void)tid; (void)lane; (void)gw; (void)scr
    unsigned char* ws = a.ws;
    bf16* XB = (bf16*)(ws + WS_XB);
    if (threadIdx.x < 2) ((volatile LAS unsigned*)(ldsl + BARLDS_OFF))[threadIdx.x] = 0u;
    __syncthreads();
    const XcdBarrier bar = xcd_barrier_post((unsigned*)(ws + WS_BAR), (volatile LAS unsigned*)(ldsl + BARLDS_OFF));

#define IN(k) (a.ph_lo <= (k) && (k) < a.ph_hi)
#ifndef REP_PRO
#define REP_PRO 1
#endif
#ifndef REP_IN
#define REP_IN 1
#endif
#ifndef REP_PC
#define REP_PC 1
#endif
#ifndef REP_MIX
#define REP_MIX 1
#endif
#ifndef REP_GU
#define REP_GU 1
#endif
#define BOTH(k) (IN(k) && IN((k) + 1))
#ifndef NO_PRO
    for (int rp_ = 0; rp_ < REP_PRO; ++rp_) if (IN(0)) { FRESH_IDS();
    convert_weights(a, scr, gw, NGW, lane, (G == 256) ? 1 : 0, 0);
    x_to_bf16(a, gw, NGW, lane); }
#endif
    if (BOTH(0)) GRID_SEAM();

#pragma unroll 1
    for (int l = 0; l < DEPTH; ++l) {
        unsigned char* wl = ws + WS_WL + (size_t)l * WL_STRIDE; const int p0 = 1 + 6 * l;
        const bf16* WIN = (l == 0) ? (const bf16*)(ws + WS_WIN) : (const bf16*)((unsigned char*)a.out + 64 * MiB);
        const float* ssq_in = (const float*)(ws + WS_SSQ + (size_t)(2 * l) * KiB512);
        float* ssq_mid = (float*)(ws + WS_SSQ + (size_t)(2 * l + 1) * KiB512);
        float* ssq_end = (float*)(ws + WS_SSQ + (size_t)(2 * l + 2) * KiB512);
#ifndef NO_IN
#ifndef WGM_GU
#define WGM_GU 4
#endif
#ifndef STAG_IN
#define STAG_IN 0
#endif
        if (IN(p0) && STAG_IN > 0 && G == 256 && bx >= 128) { const unsigned long long t0_ = __builtin_amdgcn_s_memrealtime(), d_ = (unsigned long long)(1 + ((bx >> 3) % 3)) * STAG_IN; while (__builtin_amdgcn_s_memrealtime() - t0_ < d_) __builtin_amdgcn_s_sleep(32); }
        for (int rp_ = 0; rp_ < REP_IN; ++rp_) if (IN(p0)) { pg8::Gemm g{XB, XB, XB, WIN, WIN, WIN, MROWS, NIN, 1024}; pg8::StaticOrder S; S.init(MROWS, NIN, G, bx);
          pg8::EpiIn E{ssq_in, a.in[4] + (size_t)l * 3072, (bf16*)(ws + WS_QA), (bf16*)(ws + WS_G),
                       (float*)(ws + WS_FLOG), attn_body::C2};
          pg8::gemm_phase<pg8::EpiIn, pg8::StaticOrder, true, true>(ldsl, g, S, E);
          if (rp_ == REP_IN - 1 && G == 256 && bx >= 128) { FRESH_IDS(); convert_weights(a, scr, (bx - 128) * NWAVES + wave, 128 * NWAVES, lane, 2, l); } }
#endif
        if (BOTH(p0 + 0)) GRID_SEAM();
#ifndef NO_PRO
#endif
#ifndef NO_ATT
#ifndef REP_ATT
#define REP_ATT 1
#endif
        bf16* const YA = (bf16*)(ws + WS_QA);
#pragma unroll 1
        for (int st_ = 0; st_ < 2; ++st_) {
        const bool att_now = (st_ == ((vcu >> 1) & 1));
        if (att_now && IN(p0 + 1)) { const attn_body::AttnTensors AT{(const attn_body::bf16*)(ws + WS_QA), (const attn_body::bf16*)(ws + WS_K), (const attn_body::bf16*)(ws + WS_V), (attn_body::bf16*)YA,
                                          (const float*)(ws + WS_FLOG), a.in[3] + l * NHEADS};
          const attn_body::StaticOrder S(G, vcu);
          attn_body::attn_phase<attn_body::StaticOrder>((char*)lds, AT, S); }
#endif
#ifndef NO_PC
        for (int rp_ = 0; rp_ < REP_PC; ++rp_) if (!att_now && IN(p0 + 1)) { FRESH_IDS(); pool_conv_phase(a, l, vcu, G, tid); }
#endif
        }
        if (BOTH(p0 + 1)) GRID_SEAM();
#ifndef NO_MIX
        for (int rp_ = 0; rp_ < REP_MIX; ++rp_) if (IN(p0 + 2)) { pg8::Gemm g{(const bf16*)YA, (const bf16*)a.out, (const bf16*)a.out + (size_t)MROWS * 512, (const bf16*)(wl + WL_A), (const bf16*)(wl + WL_B), (const bf16*)(wl + WL_C), MROWS, 1024, 512};
          pg8::StaticOrder3 S; S.init(MROWS, 1024, G, bx);
          pg8::EpiMix E{(const bf16*)(ws + WS_G), (bf16*)(ws + WS_MIX), (bf16*)(ws + WS_U)};
          pg8::gemm_phase<pg8::EpiMix, pg8::StaticOrder3, true, true>(ldsl, g, S, E); }
#endif
        if (BOTH(p0 + 2)) GRID_SEAM();
#ifndef NO_OUT
#ifndef REP_OUT
#define REP_OUT 1
#endif
        if (IN(p0 + 3)) { const bf16* A = (const bf16*)(ws + WS_MIX); const bf16* B = (const bf16*)(wl + WL_OUT);
          pg8::Gemm g{A, A, A, B, B, B, MROWS, 1024, 1024}; pg8::StaticOrder S; S.init(MROWS, 1024, G, bx);
          pg8::EpiResid E{XB, ssq_mid};
          pg8::gemm_phase<pg8::EpiResid, pg8::StaticOrder, true, true>(ldsl, g, S, E); }
#endif
        if (BOTH(p0 + 3)) GRID_SEAM();
#ifndef NO_GU
        for (int rp_ = 0; rp_ < REP_GU; ++rp_) if (IN(p0 + 4)) { const bf16* B = (const bf16*)(wl + WL_GU);
          pg8::Gemm g{XB, XB, XB, B, B, B, MROWS, 2 * FFH, 1024}; pg8::StaticOrder S; S.init(MROWS, 2 * FFH, G, bx, WGM_GU);
          pg8::EpiSwiglu E{ssq_mid, (bf16*)(ws + WS_ACT)};
          pg8::gemm_phase<pg8::EpiSwiglu, pg8::StaticOrder, true, true>(ldsl, g, S, E); }
#endif
        if (BOTH(p0 + 4)) GRID_SEAM();
#ifndef NO_DN
        if (IN(p0 + 5)) { const bf16* A = (const bf16*)(ws + WS_ACT); const bf16* B = (const bf16*)(wl + WL_DN);
          pg8::Gemm g{A, A, A, B, B, B, MROWS, 1024, FFH}; pg8::StaticOrder S; S.init(MROWS, 1024, G, bx);
          pg8::EpiResid E{XB, ssq_end};
          pg8::gemm_phase<pg8::EpiResid, pg8::StaticOrder, true, true>(ldsl, g, S, E); }
#endif
        if (BOTH(p0 + 5)) GRID_SEAM();
    }
    if (IN(13)) { FRESH_IDS(); final_norm_phase(a, gw, NGW, lane); }
}

__global__ void ws_too_small_fill(float* out, int n) { for (int i = blockIdx.x * blockDim.x + threadIdx.x; i < n; i += gridDim.x * blockDim.x) out[i] = 7777.f; }

extern "C" void kernel_launch(void* const* d_in, const int* in_sizes, int n_in, void* d_out, int out_size, void* d_ws, size_t ws_size, hipStream_t stream) {
    static int grid = 0;
    if (grid == 0) {
        int dev = 0, cus = 0, per_cu = 0;
        if (hipGetDevice(&dev) != hipSuccess || hipDeviceGetAttribute(&cus, hipDeviceAttributeMultiprocessorCount, dev) != hipSuccess) { fprintf(stderr, "kernel_launch: device query failed\n"); grid = -1; return; }
        if (hipFuncSetAttribute((const void*)fwd_megakernel, hipFuncAttributeMaxDynamicSharedMemorySize, LDS_BYTES) != hipSuccess) { fprintf(stderr, "kernel_launch: hipFuncSetAttribute failed\n"); grid = -1; return; }
        if (hipOccupancyMaxActiveBlocksPerMultiprocessor(&per_cu, (const void*)fwd_megakernel, NWAVES * 64, LDS_BYTES) != hipSuccess || per_cu < 1) per_cu = 1;
        (void)hipGetLastError();
        grid = cus;
    }
    if (grid < 0) return;
    if (n_in != 16 || out_size != MROWS * DMODEL || ws_size < WS_END) { ws_too_small_fill<<<256, 256, 0, stream>>>((float*)d_out, out_size); return; }
    Args a{};
    for (int i = 0; i < 16; ++i) a.in[i] = (const float*)d_in[i];
    a.out = (float*)d_out; a.ws = (unsigned char*)d_ws;
#ifndef MK_LAUNCHES
#define MK_LAUNCHES 1
#endif
#if MK_LAUNCHES == 1
    a.ph_lo = 0; a.ph_hi = 14;
    if (hipMemsetAsync((unsigned char*)d_ws + WS_BAR, 0, XCD_BAR_WORDS * 4, stream) != hipSuccess) { fprintf(stderr, "kernel_launch: memset of the barrier words failed\n"); return; }
    void* args[] = {&a};
    hipError_t e = hipLaunchCooperativeKernel((const void*)fwd_megakernel, dim3(grid), dim3(NWAVES * 64), args, LDS_BYTES, stream);
    if (e != hipSuccess) fprintf(stderr, "kernel_launch: cooperative launch failed: %s (grid %d)\n", hipGetErrorString(e), grid);
#else
    for (int p = 0; p < 14; ++p) { a.ph_lo = p; a.ph_hi = p + 1; hipLaunchKernelGGL(fwd_megakernel, dim3(grid), dim3(NWAVES * 64), LDS_BYTES, stream, a); }
#endif
}
```
